# Optimizing an MI355X kernel written in HIP

```python
import jax, jax.numpy as jnp
from jax import lax
import numpy as np

D_MODEL = 1024
BATCH = 1
SEQ = 16384
DEPTH = 4
DEC_BATCH = 8
DEC_SEQ = 32
PAST_LEN = 4096

CHUNK = 64
N_MIXERS = 3
MIXER_OF_LAYER = tuple(i % N_MIXERS for i in range(DEPTH))
SLOT_OF_LAYER = tuple(i // N_MIXERS for i in range(DEPTH))
N_GLA = sum(1 for m in MIXER_OF_LAYER if m == 0)
N_SG = sum(1 for m in MIXER_OF_LAYER if m == 1)
N_CONV = sum(1 for m in MIXER_OF_LAYER if m == 2)
ALPHA = (2.0 * DEPTH) ** 0.25
BETA = (8.0 * DEPTH) ** -0.25
LN_EPS = 1e-5
D_FF = 2816
GLA_HEADS = 4
GLA_DK = (D_MODEL // 2) // GLA_HEADS
GLA_DV = D_MODEL // GLA_HEADS
GLA_RANK = 16
GLA_GATE_NORM = 16.0
SG_CHUNK = 128
SG_WIDTH = 2 * D_MODEL
SG_GROUPS = 8
SG_GROUP_DIM = SG_WIDTH // SG_GROUPS
CONV_K = 3

kernel_name = "hybrid_streaming_gla_gmlp_shortconv_step"


def _ln(x, g, b):
    x32 = x.astype(jnp.float32)
    mu = jnp.mean(x32, axis=-1, keepdims=True)
    var = jnp.mean(jnp.square(x32 - mu), axis=-1, keepdims=True)
    y = (x32 - mu) * lax.rsqrt(var + LN_EPS) * g.astype(jnp.float32) + b.astype(jnp.float32)
    return y.astype(x.dtype)


def _swiglu(x, w_in, w_out):
    a, u = jnp.split(x @ w_in, 2, axis=-1)
    return (jax.nn.silu(a) * u) @ w_out


def _gla_scan(S0, q, k, v, g):
    Bn, H, T, _ = q.shape
    blk = min(CHUNK, T)
    n = T // blk

    def to_blocks(t):
        return t.reshape(Bn, H, n, blk, t.shape[-1]).transpose(2, 0, 1, 3, 4)

    causal = jnp.tril(jnp.ones((blk, blk), dtype=bool))[:, :, None]

    def step(S, inp):
        qc, kc, vc, gc = inp
        b = jnp.cumsum(gc, axis=2)
        diff = b[:, :, :, None, :] - b[:, :, None, :, :]
        decay = jnp.exp(jnp.where(causal, diff, -jnp.inf))
        scores = jnp.einsum('bhtsk,bhtk,bhsk->bhts', decay, qc, kc)
        o = (jnp.einsum('bhts,bhsv->bhtv', scores, vc)
             + jnp.einsum('bhtk,bhkv->bhtv', qc * jnp.exp(b), S))
        b_last = b[:, :, -1, :]
        S = (jnp.exp(b_last)[..., None] * S
             + jnp.einsum('bhsk,bhsv->bhkv', kc * jnp.exp(b_last[:, :, None, :] - b), vc))
        return S, o

    S_fin, o = lax.scan(step, S0, (to_blocks(q), to_blocks(k), to_blocks(v), to_blocks(g)))
    o = o.transpose(1, 2, 0, 3, 4).reshape(Bn, H, T, GLA_DV)
    return S_fin, o


def _gla_mixer(x, S0, w_in, w_gk2, b_gk, g_norm, w_out):
    Bn, T, _ = x.shape
    qd, vd = GLA_HEADS * GLA_DK, GLA_HEADS * GLA_DV
    proj = x @ w_in
    q, k, v, r, gl = jnp.split(proj, [qd, 2 * qd, 2 * qd + vd, 2 * qd + 2 * vd], axis=-1)
    gk = jax.nn.log_sigmoid((gl @ w_gk2 + b_gk).astype(jnp.float32)) / GLA_GATE_NORM

    def heads(t, d):
        return t.reshape(Bn, T, GLA_HEADS, d).transpose(0, 2, 1, 3).astype(jnp.float32)

    S_new, o = _gla_scan(S0.astype(jnp.float32), heads(q, GLA_DK) * (GLA_DK ** -0.5),
                         heads(k, GLA_DK), heads(v, GLA_DV), heads(gk, GLA_DK))
    o = o * lax.rsqrt(jnp.mean(jnp.square(o), axis=-1, keepdims=True) + LN_EPS) * g_norm.astype(jnp.float32)
    o = o.transpose(0, 2, 1, 3).reshape(Bn, T, vd).astype(x.dtype)
    return (o * jax.nn.silu(r)) @ w_out, S_new.astype(S0.dtype)


def _sg_mixer(x, w_in, ln_g, ln_b, w_s, b_s, w_out):
    Bn, T, _ = x.shape
    u, v = jnp.split(jax.nn.gelu(x @ w_in), 2, axis=-1)
    v = _ln(v, ln_g, ln_b)
    blk = min(SG_CHUNK, T)
    n = T // blk
    vb = v.reshape(Bn, n, blk, SG_GROUPS, SG_GROUP_DIM)
    ws = jnp.tril(w_s[:, :blk, :blk])
    s = jnp.einsum('gts,bnsgd->bntgd', ws, vb) + b_s[:, :blk].T[:, :, None]
    y = u * s.reshape(Bn, T, SG_WIDTH)
    return y @ w_out, v


def _conv_mixer(x, buf, w_in, w_conv, w_out):
    T = x.shape[1]
    bg, cg, h = jnp.split(x @ w_in, 3, axis=-1)
    c_in = cg * h
    ext = jnp.concatenate([buf.astype(c_in.dtype), c_in], axis=1)
    conv = sum(w_conv[j] * ext[:, j:j + T] for j in range(CONV_K))
    return (bg * conv) @ w_out, ext[:, -(CONV_K - 1):]


def _trunk(x, gla_states, conv_bufs, ln_g, ln_b, ffn1_w_in, ffn1_w_out, ffn2_w_in, ffn2_w_out,
           gla_w_in, gla_w_gk2, gla_b_gk, gla_g_norm, gla_w_out,
           sg_w_in, sg_ln_g, sg_ln_b, sg_w_s, sg_b_s, sg_w_out,
           conv_w_in, conv_w_conv, conv_w_out):
    new_gla, new_conv, sg_rows = [], [], []
    for i in range(DEPTH):
        m, j = MIXER_OF_LAYER[i], SLOT_OF_LAYER[i]
        x = _ln(ALPHA * x + 0.5 * _swiglu(x, ffn1_w_in[i], ffn1_w_out[i]), ln_g[i, 0], ln_b[i, 0])
        if m == 0:
            h, s = _gla_mixer(x, gla_states[j], gla_w_in[j], gla_w_gk2[j], gla_b_gk[j], gla_g_norm[j], gla_w_out[j])
            new_gla.append(s)
        elif m == 1:
            h, vr = _sg_mixer(x, sg_w_in[j], sg_ln_g[j], sg_ln_b[j], sg_w_s[j], sg_b_s[j], sg_w_out[j])
            sg_rows.append(vr)
        else:
            h, c = _conv_mixer(x, conv_bufs[j], conv_w_in[j], conv_w_conv[j], conv_w_out[j])
            new_conv.append(c)
        x = _ln(ALPHA * x + h, ln_g[i, 1], ln_b[i, 1])
        x = _ln(ALPHA * x + 0.5 * _swiglu(x, ffn2_w_in[i], ffn2_w_out[i]), ln_g[i, 2], ln_b[i, 2])
    return x, jnp.stack(new_gla), jnp.stack(new_conv), jnp.stack(sg_rows)


def setup_inputs(seed: int = 0) -> dict:
    key = jax.random.key(seed)
    ks = jax.random.split(key, 26)
    f32 = jnp.float32

    def nrm(k, shape, scale=1.0):
        return jax.random.normal(k, shape, f32) * scale

    D = D_MODEL
    gla_in = 2 * GLA_HEADS * GLA_DK + 2 * GLA_HEADS * GLA_DV + GLA_RANK
    return {
        "x_prompt": nrm(ks[0], (BATCH, SEQ, D)),
        "x_sample": nrm(ks[1], (DEC_BATCH, DEC_SEQ, D)),
        "state_gla": nrm(ks[2], (N_GLA, DEC_BATCH, GLA_HEADS, GLA_DK, GLA_DV)),
        "state_conv": nrm(ks[3], (N_CONV, DEC_BATCH, CONV_K - 1, D)),
        "ln_g": 1.0 + nrm(ks[4], (DEPTH, 3, D), 0.02),
        "ln_b": nrm(ks[5], (DEPTH, 3, D), 0.02),
        "ffn1_w_in": nrm(ks[6], (DEPTH, D, 2 * D_FF), D ** -0.5),
        "ffn1_w_out": nrm(ks[7], (DEPTH, D_FF, D), BETA * D_FF ** -0.5),
        "ffn2_w_in": nrm(ks[8], (DEPTH, D, 2 * D_FF), D ** -0.5),
        "ffn2_w_out": nrm(ks[9], (DEPTH, D_FF, D), BETA * D_FF ** -0.5),
        "gla_w_in": nrm(ks[10], (N_GLA, D, gla_in), D ** -0.5),
        "gla_w_gk2": nrm(ks[11], (N_GLA, GLA_RANK, GLA_HEADS * GLA_DK), GLA_RANK ** -0.5),
        "gla_b_gk": nrm(ks[12], (N_GLA, GLA_HEADS * GLA_DK), 0.1),
        "gla_g_norm": 1.0 + nrm(ks[13], (N_GLA, GLA_DV), 0.02),
        "gla_w_out": nrm(ks[14], (N_GLA, GLA_HEADS * GLA_DV, D), BETA * (GLA_HEADS * GLA_DV) ** -0.5),
        "sg_w_in": nrm(ks[15], (N_SG, D, 2 * SG_WIDTH), D ** -0.5),
        "sg_ln_g": 1.0 + nrm(ks[16], (N_SG, SG_WIDTH), 0.02),
        "sg_ln_b": nrm(ks[17], (N_SG, SG_WIDTH), 0.02),
        "sg_w_s": nrm(ks[18], (N_SG, SG_GROUPS, SG_CHUNK, SG_CHUNK), SG_CHUNK ** -0.5),
        "sg_b_s": 1.0 + nrm(ks[19], (N_SG, SG_GROUPS, SG_CHUNK), 0.02),
        "sg_w_out": nrm(ks[20], (N_SG, SG_WIDTH, D), BETA * SG_WIDTH ** -0.5),
        "conv_w_in": nrm(ks[21], (N_CONV, D, 3 * D), D ** -0.5),
        "conv_w_conv": nrm(ks[22], (N_CONV, CONV_K, D), CONV_K ** -0.5),
        "conv_w_out": nrm(ks[23], (N_CONV, D, D), BETA * D ** -0.5),
    }


def reference(x_prompt, x_sample, state_gla, state_conv, ln_g, ln_b,
              ffn1_w_in, ffn1_w_out, ffn2_w_in, ffn2_w_out,
              gla_w_in, gla_w_gk2, gla_b_gk, gla_g_norm, gla_w_out,
              sg_w_in, sg_ln_g, sg_ln_b, sg_w_s, sg_b_s, sg_w_out,
              conv_w_in, conv_w_conv, conv_w_out):
    weights = (ln_g, ln_b, ffn1_w_in, ffn1_w_out, ffn2_w_in, ffn2_w_out,
               gla_w_in, gla_w_gk2, gla_b_gk, gla_g_norm, gla_w_out,
               sg_w_in, sg_ln_g, sg_ln_b, sg_w_s, sg_b_s, sg_w_out,
               conv_w_in, conv_w_conv, conv_w_out)
    gla0 = jnp.zeros((N_GLA, BATCH, GLA_HEADS, GLA_DK, GLA_DV), state_gla.dtype)
    conv0 = jnp.zeros((N_CONV, BATCH, CONV_K - 1, D_MODEL), state_conv.dtype)
    y_prompt, gla_p, conv_p, _ = _trunk(x_prompt, gla0, conv0, *weights)
    y_sample, gla_s, conv_s, sg_v_s = _trunk(x_sample, state_gla, state_conv, *weights)
    return (y_prompt, y_sample, gla_p, gla_s, conv_p, conv_s, sg_v_s)
```

```cpp
#include <hip/hip_runtime.h>
#include <hip/hip_cooperative_groups.h>
#include <cstdio>
namespace cg = cooperative_groups;
namespace pg8 {
#define PG8_LAS __attribute__((address_space(3)))
typedef unsigned short bf16_t;
typedef short bf16x8 __attribute__((ext_vector_type(8)));
typedef float f32x4 __attribute__((ext_vector_type(4)));
typedef unsigned u32x4 __attribute__((ext_vector_type(4)));
constexpr int BM = 256, BK = 64, HALF = 128, HTB = HALF * BK * 2  , STAGE_BYTES = 8 * HTB, NXCD = 8, WGM = 8;

__host__ __device__ __forceinline__ int lds_byte(int r, int c) { const int st = (r >> 4) * 2 + (c >> 5), rr = r & 15, cc = c & 31, ob = rr * 64 + cc * 2; return st * 1024 + (ob ^ (((ob >> 9) & 1) << 5)); }
__host__ __device__ __forceinline__ void stage_rc(int b, int& R, int& C) { const int st = b / 1024, sb = b % 1024, swz = sb ^ (((sb >> 9) & 1) << 5); R = (st >> 1) * 16 + swz / 64; C = (st & 1) * 32 + (swz % 64) / 2; }
__host__ __device__ __forceinline__ int perm32(int rho) { const int n = rho >> 4, i = rho & 15; return 8 * (i >> 2) + 4 * n + (i & 3); }

struct Unit { int pm, pn; };
struct Gemm { const bf16_t* A; const bf16_t* Bt; int M, N, K; };

struct StaticOrder {
    int nM, nN, nwg, G, c;
    __host__ __device__ void init(int M, int N, int G_, int c_) { nM = M / BM; nN = N / BM; nwg = nM * nN; G = G_; c = c_; }
    __host__ __device__ bool next(int i, Unit& u) const {
        const long L = (long)i * G + c; if (L >= nwg) return false;
        int wgid = (int)L; { const int q = nwg / NXCD, r = nwg % NXCD, xcd = wgid % NXCD, off = wgid / NXCD; wgid = (xcd < r ? xcd * (q + 1) : r * (q + 1) + (xcd - r) * q) + off; }
        const int nig = WGM * nN, gid = wgid / nig, fm = gid * WGM, gsz = (nM - fm) < WGM ? (nM - fm) : WGM;
        u.pm = fm + ((wgid % nig) % gsz); u.pn = (wgid % nig) / gsz; return true;
    }
    __device__ __forceinline__ void a_ready(const Unit&) const {}
    __device__ __forceinline__ void done(const Unit&) const {}
};
struct CountedOrder : StaticOrder {
    const unsigned* ready; unsigned need; unsigned* tmo;
    __device__ __forceinline__ void a_ready(const Unit& u) const {
        if (threadIdx.x < 64) {
            const unsigned long long t0 = __builtin_amdgcn_s_memrealtime(); unsigned polls = 0;
            while ((unsigned)__builtin_amdgcn_readfirstlane(__hip_atomic_load(ready + 64 * u.pm, __ATOMIC_RELAXED, __HIP_MEMORY_SCOPE_AGENT)) < need) {
                if ((++polls & 255u) == 0u && __builtin_amdgcn_readfirstlane(__hip_atomic_load(tmo, __ATOMIC_RELAXED, __HIP_MEMORY_SCOPE_AGENT)) != 0u) break;
                if (__builtin_amdgcn_s_memrealtime() - t0 > 2000000ull) {
                    if (threadIdx.x == 0) { unsigned expect = 0u; __hip_atomic_compare_exchange_strong(tmo + 1, &expect, 0x600u | (unsigned)(u.pm & 0xff), __ATOMIC_RELAXED, __ATOMIC_RELAXED, __HIP_MEMORY_SCOPE_AGENT); __hip_atomic_store(tmo, 1u, __ATOMIC_RELAXED, __HIP_MEMORY_SCOPE_AGENT); }
                    break; }
                __builtin_amdgcn_s_sleep(2); }
            __builtin_amdgcn_fence(__ATOMIC_ACQUIRE, "agent");
            asm volatile("s_waitcnt vmcnt(0)" ::: "memory");
        }
#if !defined(BROKEN_HOOK_NO_BARRIER)
        asm volatile("" ::: "memory"); __builtin_amdgcn_s_barrier(); asm volatile("" ::: "memory");
#endif
    }
};

__device__ __forceinline__ unsigned cvt_pk_bf16(float lo, float hi) { unsigned r; asm volatile("v_cvt_pk_bf16_f32 %0, %1, %2" : "=v"(r) : "v"(lo), "v"(hi)); return r; }
typedef float f32x2 __attribute__((ext_vector_type(2)));
__device__ __forceinline__ f32x2 gelu_pk(f32x2 v) {
    const f32x2 av = __builtin_elementwise_abs(v), d = av * 0.2316418882f + 1.0f;
    f32x2 t; t.x = __builtin_amdgcn_rcpf(d.x); t.y = __builtin_amdgcn_rcpf(d.y);
    f32x2 q = t * 0.5307027145f + (-0.7265760135f); q = q * t + 0.7107068705f; q = q * t + (-0.142248368f); q = q * t + 0.127414796f; q = q * t;
    const f32x2 s = (v * v) * (-0.72134752044f);
    f32x2 e; e.x = __builtin_amdgcn_exp2f(s.x); e.y = __builtin_amdgcn_exp2f(s.y);
    const f32x2 m = v * (q * e), r = v - m;
    f32x2 o; o.x = v.x < 0.f ? m.x : r.x; o.y = v.y < 0.f ? m.y : r.y; return o;
}

template <class Epi, class Sched, bool STAMP = false>
__device__ __forceinline__ void gemm_phase(PG8_LAS unsigned char* lds, const Gemm g, const Sched& S, const Epi& E, unsigned long long* stamps) {
    int tid_ = threadIdx.x; asm volatile("" : "+v"(tid_)); const int tid = tid_, wid = __builtin_amdgcn_readfirstlane(tid >> 6), lane = tid & 63, wr = wid >> 2, wc = wid & 3, fr = lane & 15, fq = lane >> 4;
    const int K = g.K, nt = K / BK;
    int ts_lo = 0, ts_hi = 0, nts = 0; const unsigned long long rt_entry = STAMP ? (unsigned long long)wall_clock64() : 0ull;
#define PG8_STAMP() do { if (STAMP && wid == 0 && nts < 64) { const unsigned long long _c = (unsigned long long)clock64(); \
        ts_lo = (lane == nts) ? (int)(unsigned)_c : ts_lo; ts_hi = (lane == nts) ? (int)(unsigned)(_c >> 32) : ts_hi; ++nts; } } while (0)
    PG8_STAMP();
    unsigned voffA[2], voffB[2];
#pragma unroll
    for (int i = 0; i < 2; ++i) { int R, C; stage_rc(tid * 16 + i * 8192, R, C); const int Rb = Epi::PERM ? ((R & ~31) + perm32(R & 31)) : R;
        voffA[i] = (unsigned)(R * K + C) * 2u; voffB[i] = (unsigned)(Rb * K + C) * 2u; }
    const size_t kstep = (size_t)(BK * 2);
    const size_t hstep = (size_t)HALF * K * 2;
    const size_t tstep = 2 * hstep;
    const unsigned ldsw = (unsigned)wid * 1024u;
    const int aoff = lds_byte(wr * 64 + fr, fq * 8), boff = lds_byte(wc * 32 + fr, fq * 8);
#define PG8_SA(b, h) (((b) * 2 + (h)) * HTB)
#define PG8_SB(b, h) ((4 + (b) * 2 + (h)) * HTB)
#define PG8_STAGE(bufoff, gbase, voff) do { _Pragma("unroll") for (int _i = 0; _i < 2; ++_i) \
        __builtin_amdgcn_global_load_lds((const unsigned*)((const char*)(gbase) + (voff)[_i]), (PG8_LAS unsigned*)(lds + (bufoff) + ldsw + _i * 8192), 16, 0, 0); } while (0)
#define PG8_LDA(dst, b, h) do { _Pragma("unroll") for (int m = 0; m < 4; ++m) _Pragma("unroll") for (int k = 0; k < 2; ++k) dst[m][k] = *(const PG8_LAS bf16x8*)(lds + PG8_SA(b, h) + aoff + m * 2048 + k * 1024); } while (0)
#define PG8_LDB(dst, b, h) do { _Pragma("unroll") for (int n = 0; n < 2; ++n) _Pragma("unroll") for (int k = 0; k < 2; ++k) dst[n][k] = *(const PG8_LAS bf16x8*)(lds + PG8_SB(b, h) + boff + n * 2048 + k * 1024); } while (0)
#define PG8_MMA(ai, bj, At, Bt) do { __builtin_amdgcn_s_setprio(1); _Pragma("unroll") for (int m = 0; m < 4; ++m) _Pragma("unroll") for (int n = 0; n < 2; ++n) _Pragma("unroll") for (int k = 0; k < 2; ++k) \
        acc[ai][bj][m][n] = __builtin_amdgcn_mfma_f32_16x16x32_bf16(Bt[n][k], At[m][k], acc[ai][bj][m][n], 0, 0, 0); __builtin_amdgcn_s_setprio(0); } while (0)
#define PG8_WAIT_V(n) asm volatile("s_waitcnt vmcnt(" #n ")" ::: "memory")
#define PG8_WAIT_L(n) asm volatile("s_waitcnt lgkmcnt(" #n ")" ::: "memory")
#define PG8_BAR __builtin_amdgcn_s_barrier()
#define PG8_SCHED __builtin_amdgcn_sched_barrier(0)
    Unit cur, nxt; int ui = 0;
    if (!S.next(0, cur)) return;
    f32x4 acc[2][2][4][2];
#pragma unroll
    for (int a = 0; a < 2; ++a)
#pragma unroll
        for (int b = 0; b < 2; ++b)
#pragma unroll
            for (int m = 0; m < 4; ++m)
#pragma unroll
                for (int n = 0; n < 2; ++n) acc[a][b][m][n] = (f32x4){0.f, 0.f, 0.f, 0.f};
    bf16x8 At[4][2], B0[2][2], B1[2][2];
    const char* cA = (const char*)g.A + (size_t)cur.pm * tstep; const char* cB = (const char*)g.Bt + (size_t)cur.pn * tstep;
    S.a_ready(cur);
    PG8_STAGE(PG8_SB(0, 0), cB, voffB); PG8_STAGE(PG8_SA(0, 0), cA, voffA); PG8_STAGE(PG8_SB(0, 1), cB + hstep, voffB); PG8_STAGE(PG8_SA(0, 1), cA + hstep, voffA);
    if (wr == 1) PG8_BAR;
    PG8_WAIT_V(4); PG8_BAR;
    PG8_STAGE(PG8_SB(1, 0), cB + kstep, voffB); PG8_STAGE(PG8_SA(1, 0), cA + kstep, voffA); PG8_STAGE(PG8_SB(1, 1), cB + hstep + kstep, voffB);
    PG8_WAIT_V(6); PG8_BAR;
    PG8_STAMP();
    for (;;) {
        const bool has_next = S.next(ui + 1, nxt);
        const char* nA = has_next ? (const char*)g.A + (size_t)nxt.pm * tstep : cA; const char* nB = has_next ? (const char*)g.Bt + (size_t)nxt.pn * tstep : cB;
        for (int t = 0; t < nt; t += 2) {
            const bool last = (t == nt - 2);
            const char* a1 = cA + (size_t)(t + 1) * kstep;
            const char* a2 = last ? nA : cA + (size_t)(t + 2) * kstep; const char* b2 = last ? nB : cB + (size_t)(t + 2) * kstep;
            const char* a3 = a2 + kstep; const char* b3 = b2 + kstep;
            if (last && has_next) S.a_ready(nxt);
            PG8_LDB(B0, 0, 0); PG8_SCHED; PG8_LDA(At, 0, 0); PG8_STAGE(PG8_SA(1, 1), a1 + hstep, voffA);
            PG8_WAIT_L(8); PG8_BAR; PG8_WAIT_L(0); PG8_MMA(0, 0, At, B0); PG8_BAR; PG8_SCHED;
            PG8_LDB(B1, 0, 1); PG8_STAGE(PG8_SB(0, 0), b2, voffB);
            PG8_BAR; PG8_WAIT_L(0); PG8_MMA(0, 1, At, B1); PG8_BAR;
            PG8_LDA(At, 0, 1); PG8_STAGE(PG8_SA(0, 0), a2, voffA);
            PG8_BAR; PG8_WAIT_L(0); PG8_MMA(1, 0, At, B0); PG8_BAR; PG8_SCHED;
            PG8_STAGE(PG8_SB(0, 1), b2 + hstep, voffB);
            PG8_WAIT_V(6); PG8_BAR; PG8_MMA(1, 1, At, B1); PG8_BAR;
            PG8_LDB(B0, 1, 0); PG8_SCHED; PG8_LDA(At, 1, 0); PG8_STAGE(PG8_SA(0, 1), a2 + hstep, voffA);
            PG8_WAIT_L(8); PG8_BAR; PG8_WAIT_L(0); PG8_MMA(0, 0, At, B0); PG8_BAR; PG8_SCHED;
            PG8_LDB(B1, 1, 1); PG8_STAGE(PG8_SB(1, 0), b3, voffB);
            PG8_BAR; PG8_WAIT_L(0); PG8_MMA(0, 1, At, B1); PG8_BAR;
            PG8_LDA(At, 1, 1); PG8_STAGE(PG8_SA(1, 0), a3, voffA);
            PG8_BAR; PG8_WAIT_L(0); PG8_MMA(1, 0, At, B0); PG8_BAR; PG8_SCHED;
            PG8_STAGE(PG8_SB(1, 1), b3 + hstep, voffB);
            PG8_WAIT_V(6); PG8_BAR; PG8_MMA(1, 1, At, B1); PG8_BAR;
        }
        PG8_STAMP();
        if constexpr (!Epi::AFTER_DRAIN) { E(acc, cur, wr, wc, fr, fq); S.done(cur); }
        PG8_STAMP();
        if (!has_next) break;
#pragma unroll
        for (int a = 0; a < 2; ++a)
#pragma unroll
            for (int b = 0; b < 2; ++b)
#pragma unroll
                for (int m = 0; m < 4; ++m)
#pragma unroll
                    for (int n = 0; n < 2; ++n) acc[a][b][m][n] = (f32x4){0.f, 0.f, 0.f, 0.f};
        cur = nxt; cA = nA; cB = nB; ++ui;
    }
    PG8_WAIT_V(0);
    if (wr == 0) PG8_BAR;
    PG8_BAR;
    if constexpr (Epi::AFTER_DRAIN) { E.fused(acc, cur, wr, wc, fr, fq, lds, wid, lane); S.done(cur); }
    PG8_STAMP();
    if (STAMP && wid == 0) { stamps[lane] = lane < nts ? (((unsigned long long)(unsigned)ts_hi << 32) | (unsigned)ts_lo) : 0ull;
        if (lane == 62) stamps[62] = rt_entry; if (lane == 63) stamps[63] = (unsigned long long)wall_clock64(); }
#undef PG8_STAMP
#undef PG8_SA
#undef PG8_SB
#undef PG8_STAGE
#undef PG8_LDA
#undef PG8_LDB
#undef PG8_MMA
#undef PG8_WAIT_V
#undef PG8_WAIT_L
#undef PG8_BAR
#undef PG8_SCHED
}
}

#define LAS __attribute__((address_space(3)))
using pg8::bf16_t; using pg8::bf16x8; using pg8::f32x4; using pg8::u32x4; using pg8::Unit;
typedef unsigned u32x2 __attribute__((ext_vector_type(2)));

constexpr int D = 1024, MP = 16384, MS = 256, MT = MP + MS, DFF = 2816;
constexpr int GLA_N = 3088, GLA_NP = 3328;
constexpr float ALPHA = 1.681792830507429f, LN_EPS = 1e-5f;
constexpr int NTHR = 512;
constexpr int LDS_BYTES = 136 * 1024;

constexpr size_t WT_BYTES = 48ull << 20;
constexpr size_t OFF_WT = 0;
constexpr size_t OFF_XB = OFF_WT + WT_BYTES;
constexpr size_t OFF_BIG = OFF_XB + (size_t)MT * D * 2;
constexpr int NSLOT = 1024 + 32;
constexpr size_t OFF_P = OFF_BIG;
constexpr size_t OFF_SB = OFF_P + (size_t)MT * GLA_NP * 2;
constexpr size_t OFF_BB = OFF_SB + (size_t)NSLOT * 32768 * 4;
constexpr size_t OFF_AB = OFF_BB + (size_t)MT * 512 * 4;
constexpr size_t OFF_DK = OFF_AB + (size_t)MT * D * 2;
constexpr size_t WS_END = OFF_DK + (size_t)NSLOT * 128 * 4;
constexpr size_t W_1IN = 0, W_1OUT = 5767168, W_2IN = 8650752, W_2OUT = 14417920, W_MIN = 17301504, W_MOUT = 21495808;
constexpr size_t O_Y = 0, O_GLAP = 17039360, O_GLAS = 17301504, O_CONVP = 19398656, O_CONVS = 19400704, O_SGV = 19417088;

struct Params { const float* in[24]; float* out; unsigned char* ws; };

__device__ __forceinline__ unsigned pk2(float lo, float hi) { return pg8::cvt_pk_bf16(lo, hi); }
__device__ __forceinline__ bf16_t f2bf(float f) { return (bf16_t)(pk2(f, 0.f) & 0xffffu); }
__device__ __forceinline__ float bf2f(bf16_t b) { return __uint_as_float(((unsigned)b) << 16); }
__device__ __forceinline__ float bflo(unsigned w) { return __uint_as_float(w << 16); }
__device__ __forceinline__ float bfhi(unsigned w) { return __uint_as_float(w & 0xffff0000u); }
__device__ __forceinline__ float silu_f(float x) { return x * __builtin_amdgcn_rcpf(1.0f + __expf(-x)); }
__device__ __forceinline__ float gelu_tanh_f(float x) { const float z = 1.5957691216057308f * (x + 0.044715f * x * x * x); return x * __builtin_amdgcn_rcpf(1.0f + __expf(-z)); }
__device__ __forceinline__ float logsigmoid_f(float z) { return fminf(z, 0.f) - log1pf(expf(-fabsf(z))); }

template <int ACT> struct EpiPair {
    static constexpr bool PERM = true, AFTER_DRAIN = false;
    bf16_t* O; int ldo;
    __device__ __forceinline__ void operator()(const f32x4 (&acc)[2][2][4][2], const Unit& u, int wr, int wc, int fr, int fq) const {
        const int row0 = u.pm * 256 + wr * 64 + fr, col0 = u.pn * 128 + wc * 32 + 8 * fq;
#pragma unroll
        for (int ai = 0; ai < 2; ++ai)
#pragma unroll
            for (int m = 0; m < 4; ++m) {
                bf16_t* rowp = O + (size_t)(row0 + ai * 128 + m * 16) * ldo + col0;
                f32x4 v0, v1;
#pragma unroll
                for (int j = 0; j < 4; ++j) {
                    const float a0 = acc[ai][0][m][0][j], a1 = acc[ai][0][m][1][j];
                    v0[j] = (ACT ? silu_f(a0) : a0) * acc[ai][1][m][0][j];
                    v1[j] = (ACT ? silu_f(a1) : a1) * acc[ai][1][m][1][j];
                }
                u32x4 w; w.x = pk2(v0[0], v0[1]); w.y = pk2(v0[2], v0[3]); w.z = pk2(v1[0], v1[1]); w.w = pk2(v1[2], v1[3]);
                *(u32x4*)rowp = w;
            }
    }
};
template <int ACT> struct EpiBf {
    static constexpr bool PERM = true, AFTER_DRAIN = false;
    bf16_t* O; int ldc; int split_cols; size_t split_stride;
    __device__ __forceinline__ void operator()(const f32x4 (&acc)[2][2][4][2], const Unit& u, int wr, int wc, int fr, int fq) const {
        const int row0 = u.pm * 256 + wr * 64 + fr; int colt = u.pn * 256; bf16_t* base = O;
        if (split_cols) { const int t = colt / split_cols; base += (size_t)t * split_stride; colt -= t * split_cols; }
        const int col0 = colt + wc * 32 + 8 * fq;
#pragma unroll
        for (int ai = 0; ai < 2; ++ai)
#pragma unroll
            for (int m = 0; m < 4; ++m) {
                bf16_t* rowp = base + (size_t)(row0 + ai * 128 + m * 16) * ldc + col0;
#pragma unroll
                for (int bj = 0; bj < 2; ++bj) {
                    f32x4 v0 = acc[ai][bj][m][0], v1 = acc[ai][bj][m][1];
                    if (ACT == 1) {
#pragma unroll
                        for (int j = 0; j < 4; ++j) { v0[j] = gelu_tanh_f(v0[j]); v1[j] = gelu_tanh_f(v1[j]); }
                    }
                    u32x4 w; w.x = pk2(v0[0], v0[1]); w.y = pk2(v0[2], v0[3]); w.z = pk2(v1[0], v1[1]); w.w = pk2(v1[2], v1[3]);
                    *(u32x4*)(rowp + bj * 128) = w;
                }
            }
    }
};
struct EpiConv {
    static constexpr bool PERM = true, AFTER_DRAIN = false;
    bf16_t* CIN; bf16_t* BG;
    __device__ __forceinline__ void operator()(const f32x4 (&acc)[2][2][4][2], const Unit& u, int wr, int wc, int fr, int fq) const {
        if (u.pn < 8) { EpiPair<0> e{CIN, D}; e(acc, u, wr, wc, fr, fq); }
        else { EpiBf<0> e{BG, D, 0, 0}; Unit v = u; v.pn = u.pn - 8; e(acc, v, wr, wc, fr, fq); }
    }
};
struct EpiRes {
    static constexpr bool PERM = false, AFTER_DRAIN = false;
    float* X; float alpha, scale;
    __device__ __forceinline__ void operator()(const f32x4 (&acc)[2][2][4][2], const Unit& u, int wr, int wc, int fr, int fq) const {
        const int row0 = u.pm * 256 + wr * 64 + fr, col0 = u.pn * 256 + wc * 32 + 4 * fq;
#pragma unroll
        for (int ai = 0; ai < 2; ++ai)
#pragma unroll
            for (int m = 0; m < 4; ++m) {
                float* rowp = X + (size_t)(row0 + ai * 128 + m * 16) * D + col0;
#pragma unroll
                for (int bj = 0; bj < 2; ++bj)
#pragma unroll
                    for (int n = 0; n < 2; ++n) { f32x4* p = (f32x4*)(rowp + bj * 128 + n * 16); const f32x4 x = *p; *p = x * alpha + acc[ai][bj][m][n] * scale; }
            }
    }
};

__device__ __forceinline__ int srccol(int mode, int n) {
    if (mode == 1) { const int pn = n >> 8, c = n & 255; return (c >> 7) * DFF + pn * 128 + (c & 127); }
    if (mode == 2) { if (n < 2048) { const int pn = n >> 8, c = n & 255; return 1024 + (c >> 7) * 1024 + pn * 128 + (c & 127); } return n - 2048; }
    return n;
}
__device__ __forceinline__ void convert_matrix(LAS unsigned char* lds, const float* __restrict__ W, bf16_t* __restrict__ Wt, int K, int Nsrc, int Ndst, int Nvalid, int mode, int G, int bid) {
    LAS bf16_t* tile = (LAS bf16_t*)lds;
    int tid_ = threadIdx.x; asm volatile("" : "+v"(tid_)); const int tid = tid_, ntn = Ndst >> 6, ntk = K >> 6, ntot = ntn * ntk;
    for (int t = bid; t < ntot; t += G) {
        const int tn = t % ntn, tk = t / ntn, n0 = tn * 64, k0 = tk * 64, sc0 = srccol(mode, n0);
        const int kk = tid >> 3, cc = (tid & 7) * 8;
        float4 v0 = make_float4(0.f, 0.f, 0.f, 0.f), v1 = v0;
        if (n0 + cc < Nvalid) { const float* s = W + (size_t)(k0 + kk) * Nsrc + sc0 + cc; v0 = *(const float4*)s; v1 = *(const float4*)(s + 4); }
        tile[(cc + 0) * 72 + kk] = f2bf(v0.x); tile[(cc + 1) * 72 + kk] = f2bf(v0.y); tile[(cc + 2) * 72 + kk] = f2bf(v0.z); tile[(cc + 3) * 72 + kk] = f2bf(v0.w);
        tile[(cc + 4) * 72 + kk] = f2bf(v1.x); tile[(cc + 5) * 72 + kk] = f2bf(v1.y); tile[(cc + 6) * 72 + kk] = f2bf(v1.z); tile[(cc + 7) * 72 + kk] = f2bf(v1.w);
        __syncthreads();
        const int nl = tid >> 3, kc = (tid & 7) * 8;
        const u32x4 w = *(const LAS u32x4*)(tile + nl * 72 + kc);
        *(u32x4*)(Wt + (size_t)(n0 + nl) * K + k0 + kc) = w;
        __syncthreads();
    }
}
__device__ __forceinline__ void convert_layer(LAS unsigned char* lds, const Params& p, int l, int G, int bid) {
    bf16_t* WT = (bf16_t*)(p.ws + OFF_WT);
    convert_matrix(lds, p.in[6] + (size_t)l * D * 2 * DFF, WT + W_1IN, D, 2 * DFF, 2 * DFF, 2 * DFF, 1, G, bid);
    convert_matrix(lds, p.in[7] + (size_t)l * DFF * D, WT + W_1OUT, DFF, D, D, D, 0, G, bid);
    convert_matrix(lds, p.in[8] + (size_t)l * D * 2 * DFF, WT + W_2IN, D, 2 * DFF, 2 * DFF, 2 * DFF, 1, G, bid);
    convert_matrix(lds, p.in[9] + (size_t)l * DFF * D, WT + W_2OUT, DFF, D, D, D, 0, G, bid);
    const int mixer = l % 3, j = l / 3;
    if (mixer == 0) {
        convert_matrix(lds, p.in[10] + (size_t)j * D * GLA_N, WT + W_MIN, D, GLA_N, GLA_NP, GLA_N, 0, G, bid);
        convert_matrix(lds, p.in[14] + (size_t)j * D * D, WT + W_MOUT, D, D, D, D, 0, G, bid);
    } else if (mixer == 1) {
        convert_matrix(lds, p.in[15] + (size_t)j * D * 4096, WT + W_MIN, D, 4096, 4096, 4096, 0, G, bid);
        convert_matrix(lds, p.in[20] + (size_t)j * 2048 * D, WT + W_MOUT, 2048, D, D, D, 0, G, bid);
    } else {
        convert_matrix(lds, p.in[21] + (size_t)j * D * 3072, WT + W_MIN, D, 3072, 3072, 3072, 2, G, bid);
        convert_matrix(lds, p.in[23] + (size_t)j * D * D, WT + W_MOUT, D, D, D, D, 0, G, bid);
    }
}

__device__ __forceinline__ void init_phase(const Params& p, int G, int bid) {
    float* X = p.out + O_Y; bf16_t* XB = (bf16_t*)(p.ws + OFF_XB);
    const size_t n4 = (size_t)MT * D / 4, np4 = (size_t)MP * D / 4;
    for (size_t i = (size_t)bid * NTHR + threadIdx.x; i < n4; i += (size_t)G * NTHR) {
        const float4 v = (i < np4) ? ((const float4*)p.in[0])[i] : ((const float4*)p.in[1])[i - np4];
        ((float4*)X)[i] = v;
        u32x2 w; w.x = pk2(v.x, v.y); w.y = pk2(v.z, v.w);
        ((u32x2*)XB)[i] = w;
    }
}

__device__ __forceinline__ void ln_phase(float* X, bf16_t* XB, const float* __restrict__ g, const float* __restrict__ b, int G, int bid) {
    int tid_ = threadIdx.x; asm volatile("" : "+v"(tid_)); const int tid = tid_, wid = tid >> 6, lane = tid & 63;
    float4 gv[4], bv[4];
#pragma unroll
    for (int i = 0; i < 4; ++i) { gv[i] = *(const float4*)(g + (i * 64 + lane) * 4); bv[i] = *(const float4*)(b + (i * 64 + lane) * 4); }
    for (int row = bid * 8 + wid; row < MT; row += G * 8) {
        float* xr = X + (size_t)row * D;
        float4 v[4];
#pragma unroll
        for (int i = 0; i < 4; ++i) v[i] = *(const float4*)(xr + (i * 64 + lane) * 4);
        float s = 0.f;
#pragma unroll
        for (int i = 0; i < 4; ++i) s += (v[i].x + v[i].y) + (v[i].z + v[i].w);
#pragma unroll
        for (int o = 32; o >= 1; o >>= 1) s += __shfl_xor(s, o);
        const float mean = s * (1.0f / D);
        float q = 0.f;
#pragma unroll
        for (int i = 0; i < 4; ++i) { const float a = v[i].x - mean, b2 = v[i].y - mean, c = v[i].z - mean, d = v[i].w - mean; q += (a * a + b2 * b2) + (c * c + d * d); }
#pragma unroll
        for (int o = 32; o >= 1; o >>= 1) q += __shfl_xor(q, o);
        const float rstd = 1.0f / sqrtf(q * (1.0f / D) + LN_EPS);
#pragma unroll
        for (int i = 0; i < 4; ++i) {
            float4 y;
            y.x = (v[i].x - mean) * rstd * gv[i].x + bv[i].x; y.y = (v[i].y - mean) * rstd * gv[i].y + bv[i].y;
            y.z = (v[i].z - mean) * rstd * gv[i].z + bv[i].z; y.w = (v[i].w - mean) * rstd * gv[i].w + bv[i].w;
            *(float4*)(xr + (i * 64 + lane) * 4) = y;
            u32x2 w; w.x = pk2(y.x, y.y); w.y = pk2(y.z, y.w);
            *(u32x2*)(XB + (size_t)row * D + (i * 64 + lane) * 4) = w;
        }
    }
}

__device__ __forceinline__ void unpack8(const u32x4 w, float (&f)[8]) { f[0] = bflo(w.x); f[1] = bfhi(w.x); f[2] = bflo(w.y); f[3] = bfhi(w.y); f[4] = bflo(w.z); f[5] = bfhi(w.z); f[6] = bflo(w.w); f[7] = bfhi(w.w); }
__device__ __forceinline__ void conv_phase(const Params& p, int j, int G, int bid) {
    const bf16_t* CIN = (const bf16_t*)(p.ws + OFF_BIG); bf16_t* BG = (bf16_t*)(p.ws + OFF_BIG + (size_t)MT * D * 2);
    const float* wc = p.in[22] + (size_t)j * 3 * D; const float* st = p.in[3] + (size_t)j * 8 * 2 * D;
    float* outp = p.out + O_CONVP + (size_t)j * 2 * D; float* outs = p.out + O_CONVS + (size_t)j * 8 * 2 * D;
    const int total = MT * 128;
    for (int idx = bid * NTHR + threadIdx.x; idx < total; idx += G * NTHR) {
        const int r = idx >> 7, c8 = (idx & 127) * 8;
        const bool samp = r >= MP; const int t = samp ? ((r - MP) & 31) : r, b = samp ? ((r - MP) >> 5) : 0, T = samp ? 32 : MP;
        float c0[8], c1[8], c2[8], bg[8];
        unpack8(*(const u32x4*)(CIN + (size_t)r * D + c8), c0);
        if (t >= 1) unpack8(*(const u32x4*)(CIN + (size_t)(r - 1) * D + c8), c1);
        else if (samp) { const float4 a = *(const float4*)(st + (size_t)(b * 2 + 1) * D + c8), a2 = *(const float4*)(st + (size_t)(b * 2 + 1) * D + c8 + 4); c1[0] = a.x; c1[1] = a.y; c1[2] = a.z; c1[3] = a.w; c1[4] = a2.x; c1[5] = a2.y; c1[6] = a2.z; c1[7] = a2.w; }
        else { for (int i = 0; i < 8; ++i) c1[i] = 0.f; }
        if (t >= 2) unpack8(*(const u32x4*)(CIN + (size_t)(r - 2) * D + c8), c2);
        else if (samp) { const float4 a = *(const float4*)(st + (size_t)(b * 2 + t) * D + c8), a2 = *(const float4*)(st + (size_t)(b * 2 + t) * D + c8 + 4); c2[0] = a.x; c2[1] = a.y; c2[2] = a.z; c2[3] = a.w; c2[4] = a2.x; c2[5] = a2.y; c2[6] = a2.z; c2[7] = a2.w; }
        else { for (int i = 0; i < 8; ++i) c2[i] = 0.f; }
        unpack8(*(const u32x4*)(BG + (size_t)r * D + c8), bg);
        float z[8];
#pragma unroll
        for (int i = 0; i < 8; ++i) z[i] = bg[i] * (wc[c8 + i] * c2[i] + wc[D + c8 + i] * c1[i] + wc[2 * D + c8 + i] * c0[i]);
        u32x4 w; w.x = pk2(z[0], z[1]); w.y = pk2(z[2], z[3]); w.z = pk2(z[4], z[5]); w.w = pk2(z[6], z[7]);
        *(u32x4*)(BG + (size_t)r * D + c8) = w;
        if (t >= T - 2) {
            float* o = (samp ? outs + (size_t)(b * 2 + (t - (T - 2))) * D : outp + (size_t)(t - (T - 2)) * D) + c8;
            *(float4*)o = make_float4(c0[0], c0[1], c0[2], c0[3]); *(float4*)(o + 4) = make_float4(c0[4], c0[5], c0[6], c0[7]);
        }
    }
}

__device__ __forceinline__ void gla_item(int slot, int& row0, int& len, int& h) { h = slot & 3; if (slot < 1024) { row0 = (slot >> 2) * 64; len = 64; } else { row0 = MP + ((slot - 1024) >> 2) * 32; len = 32; } }
__device__ __forceinline__ f32x4 mfma16(const bf16x8 a, const bf16x8 b, const f32x4 c) { return __builtin_amdgcn_mfma_f32_16x16x32_bf16(a, b, c, 0, 0, 0); }

__device__ __forceinline__ void gla_g1(LAS unsigned char* lds, const Params& p, int j, int G, int bid) {
    const bf16_t* P = (const bf16_t*)(p.ws + OFF_P); float* SB = (float*)(p.ws + OFF_SB); float* BB = (float*)(p.ws + OFF_BB); float* DK = (float*)(p.ws + OFF_DK);
    const float* wgk = p.in[11] + (size_t)j * 16 * 512; const float* bgk = p.in[12] + (size_t)j * 512;
    LAS float* gls = (LAS float*)lds;
    LAS float* wg = (LAS float*)(lds + 4096);
    LAS float* bb = (LAS float*)(lds + 12288);
    LAS bf16_t* khT = (LAS bf16_t*)(lds + 45056);
    LAS bf16_t* vT = (LAS bf16_t*)(lds + 63488);
    int tid_ = threadIdx.x; asm volatile("" : "+v"(tid_)); const int tid = tid_, wid = tid >> 6, lane = tid & 63, fr = lane & 15, fq = lane >> 4;
    for (int slot = bid; slot < NSLOT; slot += G) {
        int row0, len, h; gla_item(slot, row0, len, h);
        for (int idx = tid; idx < 1024; idx += NTHR) { const int t = idx >> 4, r = idx & 15; gls[idx] = t < len ? bf2f(P[(size_t)(row0 + t) * GLA_NP + 3072 + r]) : 0.f; }
        for (int idx = tid; idx < 2048; idx += NTHR) { const int r = idx >> 7, c = idx & 127; wg[idx] = wgk[r * 512 + h * 128 + c]; }
        __syncthreads();
        {
            const int kd = tid & 127; float wr_[16];
#pragma unroll
            for (int r = 0; r < 16; ++r) wr_[r] = wg[r * 128 + kd];
            const float bias = bgk[h * 128 + kd];
            for (int t = tid >> 7; t < 64; t += 4) {
                float z = bias;
#pragma unroll
                for (int r = 0; r < 16; ++r) z += gls[t * 16 + r] * wr_[r];
                bb[t * 128 + kd] = logsigmoid_f(z) * (1.0f / 16.0f);
            }
        }
        __syncthreads();
        if (tid < 128) { float run = 0.f; for (int t = 0; t < len; ++t) { run += bb[t * 128 + tid]; bb[t * 128 + tid] = run; } }
        __syncthreads();
        if (tid < 128) DK[(size_t)slot * 128 + tid] = expf(bb[(len - 1) * 128 + tid]);
        for (int idx = tid; idx < 8192; idx += NTHR) {
            const int t = idx >> 7, kd = idx & 127; float kh = 0.f;
            if (t < len) { const float bt = bb[idx]; BB[(size_t)(row0 + t) * 512 + h * 128 + kd] = bt;
                kh = bf2f(P[(size_t)(row0 + t) * GLA_NP + 512 + h * 128 + kd]) * expf(bb[(len - 1) * 128 + kd] - bt); }
            khT[kd * 72 + t] = f2bf(kh);
        }
        for (int idx = tid; idx < 16384; idx += NTHR) {
            const int t = idx >> 8, vd = idx & 255;
            vT[vd * 72 + t] = t < len ? P[(size_t)(row0 + t) * GLA_NP + 1024 + h * 256 + vd] : (bf16_t)0;
        }
        __syncthreads();
        f32x4 acc[2][8];
#pragma unroll
        for (int r = 0; r < 2; ++r)
#pragma unroll
            for (int c = 0; c < 8; ++c) acc[r][c] = (f32x4){0.f, 0.f, 0.f, 0.f};
#pragma unroll
        for (int ks = 0; ks < 2; ++ks) {
            bf16x8 a[2];
#pragma unroll
            for (int r = 0; r < 2; ++r) a[r] = *(const LAS bf16x8*)(vT + ((wid * 2 + r) * 16 + fr) * 72 + ks * 32 + fq * 8);
#pragma unroll
            for (int c = 0; c < 8; ++c) {
                const bf16x8 bfr = *(const LAS bf16x8*)(khT + (c * 16 + fr) * 72 + ks * 32 + fq * 8);
#pragma unroll
                for (int r = 0; r < 2; ++r) acc[r][c] = mfma16(a[r], bfr, acc[r][c]);
            }
        }
        float* sb = SB + (size_t)slot * 32768;
#pragma unroll
        for (int r = 0; r < 2; ++r)
#pragma unroll
            for (int c = 0; c < 8; ++c)
#pragma unroll
                for (int jj = 0; jj < 4; ++jj) sb[((wid * 2 + r) * 16 + fq * 4 + jj) * 128 + c * 16 + fr] = acc[r][c][jj];
        __syncthreads();
    }
}

__device__ __forceinline__ void gla_g2(const Params& p, int j, int G, int bid) {
    float* SB = (float*)(p.ws + OFF_SB); const float* DK = (const float*)(p.ws + OFF_DK);
    for (int e = bid * NTHR + threadIdx.x; e < 131072; e += G * NTHR) {
        const int h = e >> 15, vd = (e >> 7) & 255, kd = e & 127;
        float* ps = SB + (size_t)h * 32768 + vd * 128 + kd; const float* pd = DK + h * 128 + kd;
        float S = 0.f;
        for (int c0 = 0; c0 < 256; c0 += 8) {
            float ds[8], dd[8];
#pragma unroll
            for (int i = 0; i < 8; ++i) { ds[i] = ps[(size_t)(c0 + i) * 131072]; dd[i] = pd[(c0 + i) * 512]; }
#pragma unroll
            for (int i = 0; i < 8; ++i) { ps[(size_t)(c0 + i) * 131072] = S; S = dd[i] * S + ds[i]; }
        }
        p.out[O_GLAP + (size_t)j * 131072 + h * 32768 + kd * 256 + vd] = S;
    }
    const float* st = p.in[2] + (size_t)j * 8 * 131072;
    for (int e = bid * NTHR + threadIdx.x; e < 8 * 131072; e += G * NTHR) {
        const int b = e >> 17, h = (e >> 15) & 3, vd = (e >> 7) & 255, kd = e & 127, slot = 1024 + b * 4 + h;
        float* ps = SB + (size_t)slot * 32768 + vd * 128 + kd;
        const size_t so = (size_t)(b * 4 + h) * 32768 + kd * 256 + vd;
        const float S0 = st[so], ds = *ps, dd = DK[slot * 128 + kd];
        *ps = S0;
        p.out[O_GLAS + (size_t)j * 8 * 131072 + so] = dd * S0 + ds;
    }
}

__device__ __forceinline__ void gla_g3(LAS unsigned char* lds, const Params& p, int j, int G, int bid) {
    const bf16_t* P = (const bf16_t*)(p.ws + OFF_P); const float* SB = (const float*)(p.ws + OFF_SB); const float* BB = (const float*)(p.ws + OFF_BB);
    bf16_t* AB = (bf16_t*)(p.ws + OFF_AB); const float* gn = p.in[13] + (size_t)j * 256;
    LAS bf16_t* qt = (LAS bf16_t*)lds;
    LAS bf16_t* kt = (LAS bf16_t*)(lds + 17408);
    LAS bf16_t* sc = (LAS bf16_t*)(lds + 34816);
    LAS bf16_t* vT = (LAS bf16_t*)(lds + 44032);
    LAS float* part = (LAS float*)(lds + 80896);
    int tid_ = threadIdx.x; asm volatile("" : "+v"(tid_)); const int tid = tid_, wid = tid >> 6, lane = tid & 63, fr = lane & 15, fq = lane >> 4;
    for (int slot = bid; slot < NSLOT; slot += G) {
        int row0, len, h; gla_item(slot, row0, len, h);
        for (int idx = tid; idx < 8192; idx += NTHR) {
            const int t = idx >> 7, kd = idx & 127; float qv = 0.f, kv = 0.f;
            if (t < len) { const float bt = BB[(size_t)(row0 + t) * 512 + h * 128 + kd]; const bf16_t* pr = P + (size_t)(row0 + t) * GLA_NP + h * 128 + kd;
                qv = bf2f(pr[0]) * 0.08838834764831845f * expf(bt); kv = bf2f(pr[512]) * expf(-bt); }
            qt[t * 136 + kd] = f2bf(qv); kt[t * 136 + kd] = f2bf(kv);
        }
        for (int idx = tid; idx < 16384; idx += NTHR) {
            const int t = idx >> 8, vd = idx & 255;
            vT[vd * 72 + t] = t < len ? P[(size_t)(row0 + t) * GLA_NP + 1024 + h * 256 + vd] : (bf16_t)0;
        }
        __syncthreads();
#pragma unroll
        for (int i = 0; i < 2; ++i) {
            const int ti = wid * 2 + i, rt = ti >> 2, ct = ti & 3;
            f32x4 a4 = (f32x4){0.f, 0.f, 0.f, 0.f};
            if (ct <= rt) {
#pragma unroll
                for (int ks = 0; ks < 4; ++ks) {
                    const bf16x8 a = *(const LAS bf16x8*)(qt + (rt * 16 + fr) * 136 + ks * 32 + fq * 8);
                    const bf16x8 b = *(const LAS bf16x8*)(kt + (ct * 16 + fr) * 136 + ks * 32 + fq * 8);
                    a4 = mfma16(a, b, a4);
                }
            }
#pragma unroll
            for (int jj = 0; jj < 4; ++jj) { const int t = rt * 16 + fq * 4 + jj, s = ct * 16 + fr; sc[t * 72 + s] = f2bf(s <= t ? a4[jj] : 0.f); }
        }
        __syncthreads();
        f32x4 acc[4][2];
#pragma unroll
        for (int r = 0; r < 4; ++r)
#pragma unroll
            for (int c = 0; c < 2; ++c) acc[r][c] = (f32x4){0.f, 0.f, 0.f, 0.f};
#pragma unroll
        for (int ks = 0; ks < 2; ++ks) {
            bf16x8 b[2];
#pragma unroll
            for (int c = 0; c < 2; ++c) b[c] = *(const LAS bf16x8*)(vT + (wid * 32 + c * 16 + fr) * 72 + ks * 32 + fq * 8);
#pragma unroll
            for (int r = 0; r < 4; ++r) {
                const bf16x8 a = *(const LAS bf16x8*)(sc + (r * 16 + fr) * 72 + ks * 32 + fq * 8);
#pragma unroll
                for (int c = 0; c < 2; ++c) acc[r][c] = mfma16(a, b[c], acc[r][c]);
            }
        }
        const float* sp = SB + (size_t)slot * 32768;
#pragma unroll
        for (int ks = 0; ks < 4; ++ks) {
            bf16x8 b[2];
#pragma unroll
            for (int c = 0; c < 2; ++c) {
                const float* q = sp + (size_t)(wid * 32 + c * 16 + fr) * 128 + ks * 32 + fq * 8;
                const float4 x0 = *(const float4*)q, x1 = *(const float4*)(q + 4);
                u32x4 w; w.x = pk2(x0.x, x0.y); w.y = pk2(x0.z, x0.w); w.z = pk2(x1.x, x1.y); w.w = pk2(x1.z, x1.w);
                b[c] = __builtin_bit_cast(bf16x8, w);
            }
#pragma unroll
            for (int r = 0; r < 4; ++r) {
                const bf16x8 a = *(const LAS bf16x8*)(qt + (r * 16 + fr) * 136 + ks * 32 + fq * 8);
#pragma unroll
                for (int c = 0; c < 2; ++c) acc[r][c] = mfma16(a, b[c], acc[r][c]);
            }
        }
#pragma unroll
        for (int r = 0; r < 4; ++r)
#pragma unroll
            for (int jj = 0; jj < 4; ++jj) {
                float ss = acc[r][0][jj] * acc[r][0][jj] + acc[r][1][jj] * acc[r][1][jj];
                ss += __shfl_xor(ss, 1); ss += __shfl_xor(ss, 2); ss += __shfl_xor(ss, 4); ss += __shfl_xor(ss, 8);
                if (fr == 0) part[(r * 16 + fq * 4 + jj) * 8 + wid] = ss;
            }
        __syncthreads();
#pragma unroll
        for (int r = 0; r < 4; ++r)
#pragma unroll
            for (int jj = 0; jj < 4; ++jj) {
                const int t = r * 16 + fq * 4 + jj;
                if (t < len) {
                    float tot = 0.f;
#pragma unroll
                    for (int w = 0; w < 8; ++w) tot += part[t * 8 + w];
                    const float rinv = 1.0f / sqrtf(tot * (1.0f / 256.0f) + LN_EPS);
#pragma unroll
                    for (int c = 0; c < 2; ++c) {
                        const int vd = wid * 32 + c * 16 + fr;
                        const float rr = bf2f(P[(size_t)(row0 + t) * GLA_NP + 2048 + h * 256 + vd]);
                        AB[(size_t)(row0 + t) * D + h * 256 + vd] = f2bf(acc[r][c][jj] * rinv * gn[vd] * silu_f(rr));
                    }
                }
            }
        __syncthreads();
    }
}

__device__ __forceinline__ void sg_phase(LAS unsigned char* lds, const Params& p, int j, int G, int bid) {
    bf16_t* U = (bf16_t*)(p.ws + OFF_BIG); const bf16_t* V = (const bf16_t*)(p.ws + OFF_BIG + (size_t)MT * 2048 * 2);
    const float* lg = p.in[16] + (size_t)j * 2048; const float* lb = p.in[17] + (size_t)j * 2048;
    const float* wsp = p.in[18] + (size_t)j * 8 * 128 * 128; const float* bsp = p.in[19] + (size_t)j * 8 * 128;
    float* sgv = p.out + O_SGV + (size_t)j * 8 * 32 * 2048;
    LAS bf16_t* vnT = (LAS bf16_t*)lds;
    LAS bf16_t* wsA = (LAS bf16_t*)(lds + 69632);
    LAS float* stat = (LAS float*)(lds + 104448);
    int tid_ = threadIdx.x; asm volatile("" : "+v"(tid_)); const int tid = tid_, wid = tid >> 6, lane = tid & 63, fr = lane & 15, fq = lane >> 4;
    const int NIT = (128 + 8) * 8;
    for (int it = bid; it < NIT; it += G) {
        const int ci = it >> 3, g = it & 7; const bool samp = ci >= 128;
        const int row0 = samp ? MP + (ci - 128) * 32 : ci * 128, len = samp ? 32 : 128;
        for (int t = wid; t < len; t += 8) {
            const bf16_t* vr = V + (size_t)(row0 + t) * 2048;
            float x[32];
#pragma unroll
            for (int i = 0; i < 4; ++i) { const u32x4 w = *(const u32x4*)(vr + (i * 64 + lane) * 8); float f[8]; unpack8(w, f);
#pragma unroll
                for (int k = 0; k < 8; ++k) x[i * 8 + k] = f[k]; }
            float s = 0.f;
#pragma unroll
            for (int i = 0; i < 32; ++i) s += x[i];
#pragma unroll
            for (int o = 32; o >= 1; o >>= 1) s += __shfl_xor(s, o);
            const float mean = s * (1.0f / 2048.0f);
            float q = 0.f;
#pragma unroll
            for (int i = 0; i < 32; ++i) { const float d = x[i] - mean; q += d * d; }
#pragma unroll
            for (int o = 32; o >= 1; o >>= 1) q += __shfl_xor(q, o);
            if (lane == 0) { stat[t * 2] = mean; stat[t * 2 + 1] = 1.0f / sqrtf(q * (1.0f / 2048.0f) + LN_EPS); }
        }
        for (int idx = tid; idx < 16384; idx += NTHR) { const int t = idx >> 7, s = idx & 127; wsA[t * 136 + s] = f2bf(s <= t ? wsp[(size_t)g * 16384 + idx] : 0.f); }
        __syncthreads();
        for (int idx = tid; idx < 32768; idx += NTHR) {
            const int s = idx >> 8, d = idx & 255; float vn = 0.f;
            if (s < len) {
                vn = (bf2f(V[(size_t)(row0 + s) * 2048 + g * 256 + d]) - stat[s * 2]) * stat[s * 2 + 1] * lg[g * 256 + d] + lb[g * 256 + d];
                if (samp) sgv[(size_t)(row0 - MP + s) * 2048 + g * 256 + d] = vn;
            }
            vnT[d * 136 + s] = f2bf(vn);
        }
        __syncthreads();
        f32x4 acc[8][2];
#pragma unroll
        for (int r = 0; r < 8; ++r)
#pragma unroll
            for (int c = 0; c < 2; ++c) acc[r][c] = (f32x4){0.f, 0.f, 0.f, 0.f};
#pragma unroll
        for (int ks = 0; ks < 4; ++ks) {
            bf16x8 b[2];
#pragma unroll
            for (int c = 0; c < 2; ++c) b[c] = *(const LAS bf16x8*)(vnT + (wid * 32 + c * 16 + fr) * 136 + ks * 32 + fq * 8);
#pragma unroll
            for (int r = 0; r < 8; ++r) {
                if (ks * 32 <= r * 16 + 15) {
                    const bf16x8 a = *(const LAS bf16x8*)(wsA + (r * 16 + fr) * 136 + ks * 32 + fq * 8);
#pragma unroll
                    for (int c = 0; c < 2; ++c) acc[r][c] = mfma16(a, b[c], acc[r][c]);
                }
            }
        }
#pragma unroll
        for (int r = 0; r < 8; ++r)
#pragma unroll
            for (int jj = 0; jj < 4; ++jj) {
                const int t = r * 16 + fq * 4 + jj;
                if (t < len) {
                    const float bsv = bsp[g * 128 + t];
#pragma unroll
                    for (int c = 0; c < 2; ++c) {
                        bf16_t* up = U + (size_t)(row0 + t) * 2048 + g * 256 + wid * 32 + c * 16 + fr;
                        *up = f2bf(bf2f(*up) * (acc[r][c][jj] + bsv));
                    }
                }
            }
        __syncthreads();
    }
}

__global__ void __launch_bounds__(NTHR, 2) mega(Params p) {
    extern __shared__ __attribute__((aligned(16))) unsigned char lds_raw[];
    LAS unsigned char* lds = (LAS unsigned char*)lds_raw;
    cg::grid_group grid = cg::this_grid();
    const int G = gridDim.x, bid = blockIdx.x;
    float* X = p.out + O_Y; bf16_t* XB = (bf16_t*)(p.ws + OFF_XB); bf16_t* WT = (bf16_t*)(p.ws + OFF_WT);
    bf16_t* BIG = (bf16_t*)(p.ws + OFF_BIG);

    init_phase(p, G, bid);
    convert_layer(lds, p, 0, G, bid);
    grid.sync();

    for (int l = 0; l < 4; ++l) {
        const int mixer = l % 3, j = l / 3;
        for (int sub = 0; sub < 3; ++sub) {
            const bf16_t* Aout; const bf16_t* Wout; int Kout; float scale;
            if (sub != 1) {
                pg8::Gemm g{XB, WT + (sub == 0 ? W_1IN : W_2IN), MT, 2 * DFF, D}; pg8::StaticOrder S; S.init(MT, 2 * DFF, G, bid);
                EpiPair<1> E{BIG, DFF};
                pg8::gemm_phase<EpiPair<1>, pg8::StaticOrder>(lds, g, S, E, nullptr);
                Aout = BIG; Wout = WT + (sub == 0 ? W_1OUT : W_2OUT); Kout = DFF; scale = 0.5f;
                grid.sync();
            } else if (mixer == 0) {
                { pg8::Gemm g{XB, WT + W_MIN, MT, GLA_NP, D}; pg8::StaticOrder S; S.init(MT, GLA_NP, G, bid);
                  EpiBf<0> E{(bf16_t*)(p.ws + OFF_P), GLA_NP, 0, 0};
                  pg8::gemm_phase<EpiBf<0>, pg8::StaticOrder>(lds, g, S, E, nullptr); }
                grid.sync();
                gla_g1(lds, p, j, G, bid);
                grid.sync();
                gla_g2(p, j, G, bid);
                grid.sync();
                gla_g3(lds, p, j, G, bid);
                grid.sync();
                Aout = (const bf16_t*)(p.ws + OFF_AB); Wout = WT + W_MOUT; Kout = D; scale = 1.0f;
            } else if (mixer == 1) {
                { pg8::Gemm g{XB, WT + W_MIN, MT, 4096, D}; pg8::StaticOrder S; S.init(MT, 4096, G, bid);
                  EpiBf<1> E{BIG, 2048, 2048, (size_t)MT * 2048};
                  pg8::gemm_phase<EpiBf<1>, pg8::StaticOrder>(lds, g, S, E, nullptr); }
                grid.sync();
                sg_phase(lds, p, j, G, bid);
                grid.sync();
                Aout = BIG; Wout = WT + W_MOUT; Kout = 2048; scale = 1.0f;
            } else {
                { pg8::Gemm g{XB, WT + W_MIN, MT, 3072, D}; pg8::StaticOrder S; S.init(MT, 3072, G, bid);
                  EpiConv E{BIG, BIG + (size_t)MT * D};
                  pg8::gemm_phase<EpiConv, pg8::StaticOrder>(lds, g, S, E, nullptr); }
                grid.sync();
                conv_phase(p, j, G, bid);
                grid.sync();
                Aout = BIG + (size_t)MT * D; Wout = WT + W_MOUT; Kout = D; scale = 1.0f;
            }
            { pg8::Gemm g{Aout, Wout, MT, D, Kout}; pg8::StaticOrder S; S.init(MT, D, G, bid);
              EpiRes E{X, ALPHA, scale};
              pg8::gemm_phase<EpiRes, pg8::StaticOrder>(lds, g, S, E, nullptr); }
            grid.sync();
            ln_phase(X, XB, p.in[4] + (size_t)(l * 3 + sub) * D, p.in[5] + (size_t)(l * 3 + sub) * D, G, bid);
            if (sub == 2 && l < 3) convert_layer(lds, p, l + 1, G, bid);
            if (!(sub == 2 && l == 3)) grid.sync();
        }
    }
}

extern "C" void kernel_launch(void* const* d_in, const int* in_sizes, int n_in, void* d_out, int out_size, void* d_ws, size_t ws_size, hipStream_t stream) {
    static int grid_blocks = 0;
    if (grid_blocks == 0) {
        if (n_in != 24 || ws_size < WS_END) { fprintf(stderr, "kernel_launch: unexpected n_in %d or ws_size %zu (< %zu)\n", n_in, ws_size, (size_t)WS_END); grid_blocks = -1; return; }
        int dev = 0, cus = 0, per_cu = 0;
        hipGetDevice(&dev);
        hipDeviceGetAttribute(&cus, hipDeviceAttributeMultiprocessorCount, dev);
        if (hipFuncSetAttribute((const void*)mega, hipFuncAttributeMaxDynamicSharedMemorySize, LDS_BYTES) != hipSuccess) { fprintf(stderr, "kernel_launch: hipFuncSetAttribute failed\n"); grid_blocks = -1; return; }
        if (hipOccupancyMaxActiveBlocksPerMultiprocessor(&per_cu, (const void*)mega, NTHR, LDS_BYTES) != hipSuccess || per_cu < 1) { fprintf(stderr, "kernel_launch: occupancy query says %d\n", per_cu); per_cu = 1; }
        (void)hipGetLastError();
        grid_blocks = cus * 1;
    }
    if (grid_blocks < 0) return;
    Params p{};
    for (int i = 0; i < 24; ++i) p.in[i] = (const float*)d_in[i];
    p.out = (float*)d_out; p.ws = (unsigned char*)d_ws;
    void* args[] = {&p};
    hipError_t e = hipLaunchCooperativeKernel((const void*)mega, dim3(grid_blocks), dim3(NTHR), args, LDS_BYTES, stream);
    if (e != hipSuccess) fprintf(stderr, "cooperative launch failed: %s (grid %d)\n", hipGetErrorString(e), grid_blocks);
}
```

```cpp
#include <hip/hip_runtime.h>
#include <hip/hip_cooperative_groups.h>
#include <cstdio>
namespace cg = cooperative_groups;
namespace pg8 {
#define PG8_LAS __attribute__((address_space(3)))
typedef unsigned short bf16_t;
typedef short bf16x8 __attribute__((ext_vector_type(8)));
typedef float f32x4 __attribute__((ext_vector_type(4)));
typedef unsigned u32x4 __attribute__((ext_vector_type(4)));
constexpr int BM = 256, BK = 64, HALF = 128, HTB = HALF * BK * 2  , STAGE_BYTES = 8 * HTB, NXCD = 8, WGM = 8;

__host__ __device__ __forceinline__ int lds_byte(int r, int c) { const int st = (r >> 4) * 2 + (c >> 5), rr = r & 15, cc = c & 31, ob = rr * 64 + cc * 2; return st * 1024 + (ob ^ (((ob >> 9) & 1) << 5)); }
__host__ __device__ __forceinline__ void stage_rc(int b, int& R, int& C) { const int st = b / 1024, sb = b % 1024, swz = sb ^ (((sb >> 9) & 1) << 5); R = (st >> 1) * 16 + swz / 64; C = (st & 1) * 32 + (swz % 64) / 2; }
__host__ __device__ __forceinline__ int perm32(int rho) { const int n = rho >> 4, i = rho & 15; return 8 * (i >> 2) + 4 * n + (i & 3); }

struct Unit { int pm, pn; };
struct Gemm { const bf16_t* A; const bf16_t* Bt; int M, N, K; };

struct StaticOrder {
    int nM, nN, nwg, G, c;
    __host__ __device__ void init(int M, int N, int G_, int c_) { nM = M / BM; nN = N / BM; nwg = nM * nN; G = G_; c = c_; }
    __host__ __device__ bool next(int i, Unit& u) const {
        const long L = (long)i * G + c; if (L >= nwg) return false;
        int wgid = (int)L; { const int q = nwg / NXCD, r = nwg % NXCD, xcd = wgid % NXCD, off = wgid / NXCD; wgid = (xcd < r ? xcd * (q + 1) : r * (q + 1) + (xcd - r) * q) + off; }
        const int nig = WGM * nN, gid = wgid / nig, fm = gid * WGM, gsz = (nM - fm) < WGM ? (nM - fm) : WGM;
        u.pm = fm + ((wgid % nig) % gsz); u.pn = (wgid % nig) / gsz; return true;
    }
    __device__ __forceinline__ void a_ready(const Unit&) const {}
    __device__ __forceinline__ void done(const Unit&) const {}
};
struct CountedOrder : StaticOrder {
    const unsigned* ready; unsigned need; unsigned* tmo;
    __device__ __forceinline__ void a_ready(const Unit& u) const {
        if (threadIdx.x < 64) {
            const unsigned long long t0 = __builtin_amdgcn_s_memrealtime(); unsigned polls = 0;
            while ((unsigned)__builtin_amdgcn_readfirstlane(__hip_atomic_load(ready + 64 * u.pm, __ATOMIC_RELAXED, __HIP_MEMORY_SCOPE_AGENT)) < need) {
                if ((++polls & 255u) == 0u && __builtin_amdgcn_readfirstlane(__hip_atomic_load(tmo, __ATOMIC_RELAXED, __HIP_MEMORY_SCOPE_AGENT)) != 0u) break;
                if (__builtin_amdgcn_s_memrealtime() - t0 > 2000000ull) {
                    if (threadIdx.x == 0) { unsigned expect = 0u; __hip_atomic_compare_exchange_strong(tmo + 1, &expect, 0x600u | (unsigned)(u.pm & 0xff), __ATOMIC_RELAXED, __ATOMIC_RELAXED, __HIP_MEMORY_SCOPE_AGENT); __hip_atomic_store(tmo, 1u, __ATOMIC_RELAXED, __HIP_MEMORY_SCOPE_AGENT); }
                    break; }
                __builtin_amdgcn_s_sleep(2); }
            __builtin_amdgcn_fence(__ATOMIC_ACQUIRE, "agent");
            asm volatile("s_waitcnt vmcnt(0)" ::: "memory");
        }
#if !defined(BROKEN_HOOK_NO_BARRIER)
        asm volatile("" ::: "memory"); __builtin_amdgcn_s_barrier(); asm volatile("" ::: "memory");
#endif
    }
};

__device__ __forceinline__ unsigned cvt_pk_bf16(float lo, float hi) { unsigned r; asm volatile("v_cvt_pk_bf16_f32 %0, %1, %2" : "=v"(r) : "v"(lo), "v"(hi)); return r; }
typedef float f32x2 __attribute__((ext_vector_type(2)));
__device__ __forceinline__ f32x2 gelu_pk(f32x2 v) {
    const f32x2 av = __builtin_elementwise_abs(v), d = av * 0.2316418882f + 1.0f;
    f32x2 t; t.x = __builtin_amdgcn_rcpf(d.x); t.y = __builtin_amdgcn_rcpf(d.y);
    f32x2 q = t * 0.5307027145f + (-0.7265760135f); q = q * t + 0.7107068705f; q = q * t + (-0.142248368f); q = q * t + 0.127414796f; q = q * t;
    const f32x2 s = (v * v) * (-0.72134752044f);
    f32x2 e; e.x = __builtin_amdgcn_exp2f(s.x); e.y = __builtin_amdgcn_exp2f(s.y);
    const f32x2 m = v * (q * e), r = v - m;
    f32x2 o; o.x = v.x < 0.f ? m.x : r.x; o.y = v.y < 0.f ? m.y : r.y; return o;
}

template <class Epi, class Sched, bool STAMP = false>
__device__ __forceinline__ void gemm_phase(PG8_LAS unsigned char* lds, const Gemm g, const Sched& S, const Epi& E, unsigned long long* stamps) {
    int tid_ = threadIdx.x; asm volatile("" : "+v"(tid_)); const int tid = tid_, wid = __builtin_amdgcn_readfirstlane(tid >> 6), lane = tid & 63, wr = wid >> 2, wc = wid & 3, fr = lane & 15, fq = lane >> 4;
    const int K = g.K, nt = K / BK;
    int ts_lo = 0, ts_hi = 0, nts = 0; const unsigned long long rt_entry = STAMP ? (unsigned long long)wall_clock64() : 0ull;
#define PG8_STAMP() do { if (STAMP && wid == 0 && nts < 64) { const unsigned long long _c = (unsigned long long)clock64(); \
        ts_lo = (lane == nts) ? (int)(unsigned)_c : ts_lo; ts_hi = (lane == nts) ? (int)(unsigned)(_c >> 32) : ts_hi; ++nts; } } while (0)
    PG8_STAMP();
    unsigned voffA[2], voffB[2];
#pragma unroll
    for (int i = 0; i < 2; ++i) { int R, C; stage_rc(tid * 16 + i * 8192, R, C); const int Rb = Epi::PERM ? ((R & ~31) + perm32(R & 31)) : R;
        voffA[i] = (unsigned)(R * K + C) * 2u; voffB[i] = (unsigned)(Rb * K + C) * 2u; }
    const size_t kstep = (size_t)(BK * 2);
    const size_t hstep = (size_t)HALF * K * 2;
    const size_t tstep = 2 * hstep;
    const unsigned ldsw = (unsigned)wid * 1024u;
    const int aoff = lds_byte(wr * 64 + fr, fq * 8), boff = lds_byte(wc * 32 + fr, fq * 8);
#define PG8_SA(b, h) (((b) * 2 + (h)) * HTB)
#define PG8_SB(b, h) ((4 + (b) * 2 + (h)) * HTB)
#define PG8_STAGE(bufoff, gbase, voff) do { _Pragma("unroll") for (int _i = 0; _i < 2; ++_i) \
        __builtin_amdgcn_global_load_lds((const unsigned*)((const char*)(gbase) + (voff)[_i]), (PG8_LAS unsigned*)(lds + (bufoff) + ldsw + _i * 8192), 16, 0, 0); } while (0)
#define PG8_LDA(dst, b, h) do { _Pragma("unroll") for (int m = 0; m < 4; ++m) _Pragma("unroll") for (int k = 0; k < 2; ++k) dst[m][k] = *(const PG8_LAS bf16x8*)(lds + PG8_SA(b, h) + aoff + m * 2048 + k * 1024); } while (0)
#define PG8_LDB(dst, b, h) do { _Pragma("unroll") for (int n = 0; n < 2; ++n) _Pragma("unroll") for (int k = 0; k < 2; ++k) dst[n][k] = *(const PG8_LAS bf16x8*)(lds + PG8_SB(b, h) + boff + n * 2048 + k * 1024); } while (0)
#define PG8_MMA(ai, bj, At, Bt) do { __builtin_amdgcn_s_setprio(1); _Pragma("unroll") for (int m = 0; m < 4; ++m) _Pragma("unroll") for (int n = 0; n < 2; ++n) _Pragma("unroll") for (int k = 0; k < 2; ++k) \
        acc[ai][bj][m][n] = __builtin_amdgcn_mfma_f32_16x16x32_bf16(Bt[n][k], At[m][k], acc[ai][bj][m][n], 0, 0, 0); __builtin_amdgcn_s_setprio(0); } while (0)
#define PG8_WAIT_V(n) asm volatile("s_waitcnt vmcnt(" #n ")" ::: "memory")
#define PG8_WAIT_L(n) asm volatile("s_waitcnt lgkmcnt(" #n ")" ::: "memory")
#define PG8_BAR __builtin_amdgcn_s_barrier()
#define PG8_SCHED __builtin_amdgcn_sched_barrier(0)
    Unit cur, nxt; int ui = 0;
    if (!S.next(0, cur)) return;
    f32x4 acc[2][2][4][2];
#pragma unroll
    for (int a = 0; a < 2; ++a)
#pragma unroll
        for (int b = 0; b < 2; ++b)
#pragma unroll
            for (int m = 0; m < 4; ++m)
#pragma unroll
                for (int n = 0; n < 2; ++n) acc[a][b][m][n] = (f32x4){0.f, 0.f, 0.f, 0.f};
    bf16x8 At[4][2], B0[2][2], B1[2][2];
    const char* cA = (const char*)g.A + (size_t)cur.pm * tstep; const char* cB = (const char*)g.Bt + (size_t)cur.pn * tstep;
    S.a_ready(cur);
    PG8_STAGE(PG8_SB(0, 0), cB, voffB); PG8_STAGE(PG8_SA(0, 0), cA, voffA); PG8_STAGE(PG8_SB(0, 1), cB + hstep, voffB); PG8_STAGE(PG8_SA(0, 1), cA + hstep, voffA);
    if (wr == 1) PG8_BAR;
    PG8_WAIT_V(4); PG8_BAR;
    PG8_STAGE(PG8_SB(1, 0), cB + kstep, voffB); PG8_STAGE(PG8_SA(1, 0), cA + kstep, voffA); PG8_STAGE(PG8_SB(1, 1), cB + hstep + kstep, voffB);
    PG8_WAIT_V(6); PG8_BAR;
    PG8_STAMP();
    for (;;) {
        const bool has_next = S.next(ui + 1, nxt);
        const char* nA = has_next ? (const char*)g.A + (size_t)nxt.pm * tstep : cA; const char* nB = has_next ? (const char*)g.Bt + (size_t)nxt.pn * tstep : cB;
        for (int t = 0; t < nt; t += 2) {
            const bool last = (t == nt - 2);
            const char* a1 = cA + (size_t)(t + 1) * kstep;
            const char* a2 = last ? nA : cA + (size_t)(t + 2) * kstep; const char* b2 = last ? nB : cB + (size_t)(t + 2) * kstep;
            const char* a3 = a2 + kstep; const char* b3 = b2 + kstep;
            if (last && has_next) S.a_ready(nxt);
            PG8_LDB(B0, 0, 0); PG8_SCHED; PG8_LDA(At, 0, 0); PG8_STAGE(PG8_SA(1, 1), a1 + hstep, voffA);
            PG8_WAIT_L(8); PG8_BAR; PG8_WAIT_L(0); PG8_MMA(0, 0, At, B0); PG8_BAR; PG8_SCHED;
            PG8_LDB(B1, 0, 1); PG8_STAGE(PG8_SB(0, 0), b2, voffB);
            PG8_BAR; PG8_WAIT_L(0); PG8_MMA(0, 1, At, B1); PG8_BAR;
            PG8_LDA(At, 0, 1); PG8_STAGE(PG8_SA(0, 0), a2, voffA);
            PG8_BAR; PG8_WAIT_L(0); PG8_MMA(1, 0, At, B0); PG8_BAR; PG8_SCHED;
            PG8_STAGE(PG8_SB(0, 1), b2 + hstep, voffB);
            PG8_WAIT_V(6); PG8_BAR; PG8_MMA(1, 1, At, B1); PG8_BAR;
            PG8_LDB(B0, 1, 0); PG8_SCHED; PG8_LDA(At, 1, 0); PG8_STAGE(PG8_SA(0, 1), a2 + hstep, voffA);
            PG8_WAIT_L(8); PG8_BAR; PG8_WAIT_L(0); PG8_MMA(0, 0, At, B0); PG8_BAR; PG8_SCHED;
            PG8_LDB(B1, 1, 1); PG8_STAGE(PG8_SB(1, 0), b3, voffB);
            PG8_BAR; PG8_WAIT_L(0); PG8_MMA(0, 1, At, B1); PG8_BAR;
            PG8_LDA(At, 1, 1); PG8_STAGE(PG8_SA(1, 0), a3, voffA);
            PG8_BAR; PG8_WAIT_L(0); PG8_MMA(1, 0, At, B0); PG8_BAR; PG8_SCHED;
            PG8_STAGE(PG8_SB(1, 1), b3 + hstep, voffB);
            PG8_WAIT_V(6); PG8_BAR; PG8_MMA(1, 1, At, B1); PG8_BAR;
        }
        PG8_STAMP();
        if constexpr (!Epi::AFTER_DRAIN) { E(acc, cur, wr, wc, fr, fq); S.done(cur); }
        PG8_STAMP();
        if (!has_next) break;
#pragma unroll
        for (int a = 0; a < 2; ++a)
#pragma unroll
            for (int b = 0; b < 2; ++b)
#pragma unroll
                for (int m = 0; m < 4; ++m)
#pragma unroll
                    for (int n = 0; n < 2; ++n) acc[a][b][m][n] = (f32x4){0.f, 0.f, 0.f, 0.f};
        cur = nxt; cA = nA; cB = nB; ++ui;
    }
    PG8_WAIT_V(0);
    if (wr == 0) PG8_BAR;
    PG8_BAR;
    if constexpr (Epi::AFTER_DRAIN) { E.fused(acc, cur, wr, wc, fr, fq, lds, wid, lane); S.done(cur); }
    PG8_STAMP();
    if (STAMP && wid == 0) { stamps[lane] = lane < nts ? (((unsigned long long)(unsigned)ts_hi << 32) | (unsigned)ts_lo) : 0ull;
        if (lane == 62) stamps[62] = rt_entry; if (lane == 63) stamps[63] = (unsigned long long)wall_clock64(); }
#undef PG8_STAMP
#undef PG8_SA
#undef PG8_SB
#undef PG8_STAGE
#undef PG8_LDA
#undef PG8_LDB
#undef PG8_MMA
#undef PG8_WAIT_V
#undef PG8_WAIT_L
#undef PG8_BAR
#undef PG8_SCHED
}
}

#define LAS __attribute__((address_space(3)))
using pg8::bf16_t; using pg8::bf16x8; using pg8::f32x4; using pg8::u32x4; using pg8::Unit;
typedef unsigned u32x2 __attribute__((ext_vector_type(2)));

constexpr int D = 1024, MP = 16384, MS = 256, MT = MP + MS, DFF = 2816;
constexpr int GLA_N = 3088, GLA_NP = 3328;
constexpr float ALPHA = 1.681792830507429f, LN_EPS = 1e-5f;
constexpr int NTHR = 512;
constexpr int LDS_BYTES = 136 * 1024;

constexpr size_t WT_BYTES = 48ull << 20;
constexpr size_t OFF_WT = 0;
constexpr size_t OFF_XB = OFF_WT + WT_BYTES;
constexpr size_t OFF_BIG = OFF_XB + (size_t)MT * D * 2;
constexpr int NSLOT = 1024 + 32;
constexpr size_t OFF_P = OFF_BIG;
constexpr size_t OFF_SB = OFF_P + (size_t)MT * GLA_NP * 2;
constexpr size_t OFF_BB = OFF_SB + (size_t)NSLOT * 32768 * 4;
constexpr size_t OFF_AB = OFF_BB + (size_t)MT * 512 * 4;
constexpr size_t OFF_DK = OFF_AB + (size_t)MT * D * 2;
constexpr size_t WS_END = OFF_DK + (size_t)NSLOT * 128 * 4;
constexpr size_t W_1IN = 0, W_1OUT = 5767168, W_2IN = 8650752, W_2OUT = 14417920, W_MIN = 17301504, W_MOUT = 21495808;
constexpr size_t O_Y = 0, O_GLAP = 17039360, O_GLAS = 17301504, O_CONVP = 19398656, O_CONVS = 19400704, O_SGV = 19417088;

struct Params { const float* in[24]; float* out; unsigned char* ws; };

__device__ __forceinline__ unsigned pk2(float lo, float hi) { return pg8::cvt_pk_bf16(lo, hi); }
__device__ __forceinline__ bf16_t f2bf(float f) { return (bf16_t)(pk2(f, 0.f) & 0xffffu); }
__device__ __forceinline__ float bf2f(bf16_t b) { return __uint_as_float(((unsigned)b) << 16); }
__device__ __forceinline__ float bflo(unsigned w) { return __uint_as_float(w << 16); }
__device__ __forceinline__ float bfhi(unsigned w) { return __uint_as_float(w & 0xffff0000u); }
__device__ __forceinline__ float silu_f(float x) { return x * __builtin_amdgcn_rcpf(1.0f + __expf(-x)); }
__device__ __forceinline__ float gelu_tanh_f(float x) { const float z = 1.5957691216057308f * (x + 0.044715f * x * x * x); return x * __builtin_amdgcn_rcpf(1.0f + __expf(-z)); }
__device__ __forceinline__ float logsigmoid_f(float z) { return fminf(z, 0.f) - log1pf(expf(-fabsf(z))); }

template <int ACT> struct EpiPair {
    static constexpr bool PERM = true, AFTER_DRAIN = false;
    bf16_t* O; int ldo;
    __device__ __forceinline__ void operator()(const f32x4 (&acc)[2][2][4][2], const Unit& u, int wr, int wc, int fr, int fq) const {
        const int row0 = u.pm * 256 + wr * 64 + fr, col0 = u.pn * 128 + wc * 32 + 8 * fq;
#pragma unroll
        for (int ai = 0; ai < 2; ++ai)
#pragma unroll
            for (int m = 0; m < 4; ++m) {
                bf16_t* rowp = O + (size_t)(row0 + ai * 128 + m * 16) * ldo + col0;
                f32x4 v0, v1;
#pragma unroll
                for (int j = 0; j < 4; ++j) {
                    const float a0 = acc[ai][0][m][0][j], a1 = acc[ai][0][m][1][j];
                    v0[j] = (ACT ? silu_f(a0) : a0) * acc[ai][1][m][0][j];
                    v1[j] = (ACT ? silu_f(a1) : a1) * acc[ai][1][m][1][j];
                }
                u32x4 w; w.x = pk2(v0[0], v0[1]); w.y = pk2(v0[2], v0[3]); w.z = pk2(v1[0], v1[1]); w.w = pk2(v1[2], v1[3]);
                *(u32x4*)rowp = w;
            }
    }
};
template <int ACT> struct EpiBf {
    static constexpr bool PERM = true, AFTER_DRAIN = false;
    bf16_t* O; int ldc; int split_cols; size_t split_stride;
    __device__ __forceinline__ void operator()(const f32x4 (&acc)[2][2][4][2], const Unit& u, int wr, int wc, int fr, int fq) const {
        const int row0 = u.pm * 256 + wr * 64 + fr; int colt = u.pn * 256; bf16_t* base = O;
        if (split_cols) { const int t = colt / split_cols; base += (size_t)t * split_stride; colt -= t * split_cols; }
        const int col0 = colt + wc * 32 + 8 * fq;
#pragma unroll
        for (int ai = 0; ai < 2; ++ai)
#pragma unroll
            for (int m = 0; m < 4; ++m) {
                bf16_t* rowp = base + (size_t)(row0 + ai * 128 + m * 16) * ldc + col0;
#pragma unroll
                for (int bj = 0; bj < 2; ++bj) {
                    f32x4 v0 = acc[ai][bj][m][0], v1 = acc[ai][bj][m][1];
                    if (ACT == 1) {
#pragma unroll
                        for (int j = 0; j < 4; ++j) { v0[j] = gelu_tanh_f(v0[j]); v1[j] = gelu_tanh_f(v1[j]); }
                    }
                    u32x4 w; w.x = pk2(v0[0], v0[1]); w.y = pk2(v0[2], v0[3]); w.z = pk2(v1[0], v1[1]); w.w = pk2(v1[2], v1[3]);
                    *(u32x4*)(rowp + bj * 128) = w;
                }
            }
    }
};
struct EpiConv {
    static constexpr bool PERM = true, AFTER_DRAIN = false;
    bf16_t* CIN; bf16_t* BG;
    __device__ __forceinline__ void operator()(const f32x4 (&acc)[2][2][4][2], const Unit& u, int wr, int wc, int fr, int fq) const {
        if (u.pn < 8) { EpiPair<0> e{CIN, D}; e(acc, u, wr, wc, fr, fq); }
        else { EpiBf<0> e{BG, D, 0, 0}; Unit v = u; v.pn = u.pn - 8; e(acc, v, wr, wc, fr, fq); }
    }
};
struct EpiRes {
    static constexpr bool PERM = false, AFTER_DRAIN = false;
    float* X; float alpha, scale;
    __device__ __forceinline__ void operator()(const f32x4 (&acc)[2][2][4][2], const Unit& u, int wr, int wc, int fr, int fq) const {
        const int row0 = u.pm * 256 + wr * 64 + fr, col0 = u.pn * 256 + wc * 32 + 4 * fq;
#pragma unroll
        for (int ai = 0; ai < 2; ++ai)
#pragma unroll
            for (int m = 0; m < 4; ++m) {
                float* rowp = X + (size_t)(row0 + ai * 128 + m * 16) * D + col0;
#pragma unroll
                for (int bj = 0; bj < 2; ++bj)
#pragma unroll
                    for (int n = 0; n < 2; ++n) { f32x4* p = (f32x4*)(rowp + bj * 128 + n * 16); const f32x4 x = *p; *p = x * alpha + acc[ai][bj][m][n] * scale; }
            }
    }
};

__device__ __forceinline__ int srccol(int mode, int n) {
    if (mode == 1) { const int pn = n >> 8, c = n & 255; return (c >> 7) * DFF + pn * 128 + (c & 127); }
    if (mode == 2) { if (n < 2048) { const int pn = n >> 8, c = n & 255; return 1024 + (c >> 7) * 1024 + pn * 128 + (c & 127); } return n - 2048; }
    return n;
}
__device__ __forceinline__ void convert_matrix(LAS unsigned char* lds, const float* __restrict__ W, bf16_t* __restrict__ Wt, int K, int Nsrc, int Ndst, int Nvalid, int mode, int G, int bid) {
    LAS bf16_t* tile = (LAS bf16_t*)lds;
    int tid_ = threadIdx.x; asm volatile("" : "+v"(tid_)); const int tid = tid_, ntn = Ndst >> 6, ntk = K >> 6, ntot = ntn * ntk;
    for (int t = bid; t < ntot; t += G) {
        const int tn = t % ntn, tk = t / ntn, n0 = tn * 64, k0 = tk * 64, sc0 = srccol(mode, n0);
        const int kk = tid >> 3, cc = (tid & 7) * 8;
        float4 v0 = make_float4(0.f, 0.f, 0.f, 0.f), v1 = v0;
        if (n0 + cc < Nvalid) { const float* s = W + (size_t)(k0 + kk) * Nsrc + sc0 + cc; v0 = *(const float4*)s; v1 = *(const float4*)(s + 4); }
        tile[(cc + 0) * 72 + kk] = f2bf(v0.x); tile[(cc + 1) * 72 + kk] = f2bf(v0.y); tile[(cc + 2) * 72 + kk] = f2bf(v0.z); tile[(cc + 3) * 72 + kk] = f2bf(v0.w);
        tile[(cc + 4) * 72 + kk] = f2bf(v1.x); tile[(cc + 5) * 72 + kk] = f2bf(v1.y); tile[(cc + 6) * 72 + kk] = f2bf(v1.z); tile[(cc + 7) * 72 + kk] = f2bf(v1.w);
        __syncthreads();
        const int nl = tid >> 3, kc = (tid & 7) * 8;
        const u32x4 w = *(const LAS u32x4*)(tile + nl * 72 + kc);
        *(u32x4*)(Wt + (size_t)(n0 + nl) * K + k0 + kc) = w;
        __syncthreads();
    }
}
__device__ __forceinline__ void convert_layer(LAS unsigned char* lds, const Params& p, int l, int G, int bid) {
    bf16_t* WT = (bf16_t*)(p.ws + OFF_WT);
    convert_matrix(lds, p.in[6] + (size_t)l * D * 2 * DFF, WT + W_1IN, D, 2 * DFF, 2 * DFF, 2 * DFF, 1, G, bid);
    convert_matrix(lds, p.in[7] + (size_t)l * DFF * D, WT + W_1OUT, DFF, D, D, D, 0, G, bid);
    convert_matrix(lds, p.in[8] + (size_t)l * D * 2 * DFF, WT + W_2IN, D, 2 * DFF, 2 * DFF, 2 * DFF, 1, G, bid);
    convert_matrix(lds, p.in[9] + (size_t)l * DFF * D, WT + W_2OUT, DFF, D, D, D, 0, G, bid);
    const int mixer = l % 3, j = l / 3;
    if (mixer == 0) {
        convert_matrix(lds, p.in[10] + (size_t)j * D * GLA_N, WT + W_MIN, D, GLA_N, GLA_NP, GLA_N, 0, G, bid);
        convert_matrix(lds, p.in[14] + (size_t)j * D * D, WT + W_MOUT, D, D, D, D, 0, G, bid);
    } else if (mixer == 1) {
        convert_matrix(lds, p.in[15] + (size_t)j * D * 4096, WT + W_MIN, D, 4096, 4096, 4096, 0, G, bid);
        convert_matrix(lds, p.in[20] + (size_t)j * 2048 * D, WT + W_MOUT, 2048, D, D, D, 0, G, bid);
    } else {
        convert_matrix(lds, p.in[21] + (size_t)j * D * 3072, WT + W_MIN, D, 3072, 3072, 3072, 2, G, bid);
        convert_matrix(lds, p.in[23] + (size_t)j * D * D, WT + W_MOUT, D, D, D, D, 0, G, bid);
    }
}

__device__ __forceinline__ void init_phase(const Params& p, int G, int bid) {
    float* X = p.out + O_Y; bf16_t* XB = (bf16_t*)(p.ws + OFF_XB);
    const size_t n4 = (size_t)MT * D / 4, np4 = (size_t)MP * D / 4;
    for (size_t i = (size_t)bid * NTHR + threadIdx.x; i < n4; i += (size_t)G * NTHR) {
        const float4 v = (i < np4) ? ((const float4*)p.in[0])[i] : ((const float4*)p.in[1])[i - np4];
        ((float4*)X)[i] = v;
        u32x2 w; w.x = pk2(v.x, v.y); w.y = pk2(v.z, v.w);
        ((u32x2*)XB)[i] = w;
    }
}

__device__ __forceinline__ void ln_phase(float* X, bf16_t* XB, const float* __restrict__ g, const float* __restrict__ b, int G, int bid) {
    int tid_ = threadIdx.x; asm volatile("" : "+v"(tid_)); const int tid = tid_, wid = tid >> 6, lane = tid & 63;
    float4 gv[4], bv[4];
#pragma unroll
    for (int i = 0; i < 4; ++i) { gv[i] = *(const float4*)(g + (i * 64 + lane) * 4); bv[i] = *(const float4*)(b + (i * 64 + lane) * 4); }
    for (int row = bid * 8 + wid; row < MT; row += G * 8) {
        float* xr = X + (size_t)row * D;
        float4 v[4];
#pragma unroll
        for (int i = 0; i < 4; ++i) v[i] = *(const float4*)(xr + (i * 64 + lane) * 4);
        float s = 0.f;
#pragma unroll
        for (int i = 0; i < 4; ++i) s += (v[i].x + v[i].y) + (v[i].z + v[i].w);
#pragma unroll
        for (int o = 32; o >= 1; o >>= 1) s += __shfl_xor(s, o);
        const float mean = s * (1.0f / D);
        float q = 0.f;
#pragma unroll
        for (int i = 0; i < 4; ++i) { const float a = v[i].x - mean, b2 = v[i].y - mean, c = v[i].z - mean, d = v[i].w - mean; q += (a * a + b2 * b2) + (c * c + d * d); }
#pragma unroll
        for (int o = 32; o >= 1; o >>= 1) q += __shfl_xor(q, o);
        const float rstd = 1.0f / sqrtf(q * (1.0f / D) + LN_EPS);
#pragma unroll
        for (int i = 0; i < 4; ++i) {
            float4 y;
            y.x = (v[i].x - mean) * rstd * gv[i].x + bv[i].x; y.y = (v[i].y - mean) * rstd * gv[i].y + bv[i].y;
            y.z = (v[i].z - mean) * rstd * gv[i].z + bv[i].z; y.w = (v[i].w - mean) * rstd * gv[i].w + bv[i].w;
            *(float4*)(xr + (i * 64 + lane) * 4) = y;
            u32x2 w; w.x = pk2(y.x, y.y); w.y = pk2(y.z, y.w);
            *(u32x2*)(XB + (size_t)row * D + (i * 64 + lane) * 4) = w;
        }
    }
}

__device__ __forceinline__ void unpack8(const u32x4 w, float (&f)[8]) { f[0] = bflo(w.x); f[1] = bfhi(w.x); f[2] = bflo(w.y); f[3] = bfhi(w.y); f[4] = bflo(w.z); f[5] = bfhi(w.z); f[6] = bflo(w.w); f[7] = bfhi(w.w); }
__device__ __forceinline__ void conv_phase(const Params& p, int j, int G, int bid) {
    const bf16_t* CIN = (const bf16_t*)(p.ws + OFF_BIG); bf16_t* BG = (bf16_t*)(p.ws + OFF_BIG + (size_t)MT * D * 2);
    const float* wc = p.in[22] + (size_t)j * 3 * D; const float* st = p.in[3] + (size_t)j * 8 * 2 * D;
    float* outp = p.out + O_CONVP + (size_t)j * 2 * D; float* outs = p.out + O_CONVS + (size_t)j * 8 * 2 * D;
    const int total = MT * 128;
    for (int idx = bid * NTHR + threadIdx.x; idx < total; idx += G * NTHR) {
        const int r = idx >> 7, c8 = (idx & 127) * 8;
        const bool samp = r >= MP; const int t = samp ? ((r - MP) & 31) : r, b = samp ? ((r - MP) >> 5) : 0, T = samp ? 32 : MP;
        float c0[8], c1[8], c2[8], bg[8];
        unpack8(*(const u32x4*)(CIN + (size_t)r * D + c8), c0);
        if (t >= 1) unpack8(*(const u32x4*)(CIN + (size_t)(r - 1) * D + c8), c1);
        else if (samp) { const float4 a = *(const float4*)(st + (size_t)(b * 2 + 1) * D + c8), a2 = *(const float4*)(st + (size_t)(b * 2 + 1) * D + c8 + 4); c1[0] = a.x; c1[1] = a.y; c1[2] = a.z; c1[3] = a.w; c1[4] = a2.x; c1[5] = a2.y; c1[6] = a2.z; c1[7] = a2.w; }
        else { for (int i = 0; i < 8; ++i) c1[i] = 0.f; }
        if (t >= 2) unpack8(*(const u32x4*)(CIN + (size_t)(r - 2) * D + c8), c2);
        else if (samp) { const float4 a = *(const float4*)(st + (size_t)(b * 2 + t) * D + c8), a2 = *(const float4*)(st + (size_t)(b * 2 + t) * D + c8 + 4); c2[0] = a.x; c2[1] = a.y; c2[2] = a.z; c2[3] = a.w; c2[4] = a2.x; c2[5] = a2.y; c2[6] = a2.z; c2[7] = a2.w; }
        else { for (int i = 0; i < 8; ++i) c2[i] = 0.f; }
        unpack8(*(const u32x4*)(BG + (size_t)r * D + c8), bg);
        float z[8];
#pragma unroll
        for (int i = 0; i < 8; ++i) z[i] = bg[i] * (wc[c8 + i] * c2[i] + wc[D + c8 + i] * c1[i] + wc[2 * D + c8 + i] * c0[i]);
        u32x4 w; w.x = pk2(z[0], z[1]); w.y = pk2(z[2], z[3]); w.z = pk2(z[4], z[5]); w.w = pk2(z[6], z[7]);
        *(u32x4*)(BG + (size_t)r * D + c8) = w;
        if (t >= T - 2) {
            float* o = (samp ? outs + (size_t)(b * 2 + (t - (T - 2))) * D : outp + (size_t)(t - (T - 2)) * D) + c8;
            *(float4*)o = make_float4(c0[0], c0[1], c0[2], c0[3]); *(float4*)(o + 4) = make_float4(c0[4], c0[5], c0[6], c0[7]);
        }
    }
}

__device__ __forceinline__ void gla_item(int slot, int& row0, int& len, int& h) { h = slot & 3; if (slot < 1024) { row0 = (slot >> 2) * 64; len = 64; } else { row0 = MP + ((slot - 1024) >> 2) * 32; len = 32; } }
__device__ __forceinline__ f32x4 mfma16(const bf16x8 a, const bf16x8 b, const f32x4 c) { return __builtin_amdgcn_mfma_f32_16x16x32_bf16(a, b, c, 0, 0, 0); }

__device__ __forceinline__ void gla_g1(LAS unsigned char* lds, const Params& p, int j, int G, int bid) {
    const bf16_t* P = (const bf16_t*)(p.ws + OFF_P); float* SB = (float*)(p.ws + OFF_SB); float* BB = (float*)(p.ws + OFF_BB); float* DK = (float*)(p.ws + OFF_DK);
    const float* wgk = p.in[11] + (size_t)j * 16 * 512; const float* bgk = p.in[12] + (size_t)j * 512;
    LAS float* gls = (LAS float*)lds;
    LAS float* wg = (LAS float*)(lds + 4096);
    LAS float* bb = (LAS float*)(lds + 12288);
    LAS bf16_t* khT = (LAS bf16_t*)(lds + 45056);
    LAS bf16_t* vT = (LAS bf16_t*)(lds + 63488);
    int tid_ = threadIdx.x; asm volatile("" : "+v"(tid_)); const int tid = tid_, wid = tid >> 6, lane = tid & 63, fr = lane & 15, fq = lane >> 4;
    for (int slot = bid; slot < NSLOT; slot += G) {
        int row0, len, h; gla_item(slot, row0, len, h);
        for (int idx = tid; idx < 1024; idx += NTHR) { const int t = idx >> 4, r = idx & 15; gls[idx] = t < len ? bf2f(P[(size_t)(row0 + t) * GLA_NP + 3072 + r]) : 0.f; }
        for (int idx = tid; idx < 2048; idx += NTHR) { const int r = idx >> 7, c = idx & 127; wg[idx] = wgk[r * 512 + h * 128 + c]; }
        __syncthreads();
        {
            const int kd = tid & 127; float wr_[16];
#pragma unroll
            for (int r = 0; r < 16; ++r) wr_[r] = wg[r * 128 + kd];
            const float bias = bgk[h * 128 + kd];
            for (int t = tid >> 7; t < 64; t += 4) {
                float z = bias;
#pragma unroll
                for (int r = 0; r < 16; ++r) z += gls[t * 16 + r] * wr_[r];
                bb[t * 128 + kd] = logsigmoid_f(z) * (1.0f / 16.0f);
            }
        }
        __syncthreads();
        if (tid < 128) { float run = 0.f; for (int t = 0; t < len; ++t) { run += bb[t * 128 + tid]; bb[t * 128 + tid] = run; } }
        __syncthreads();
        if (tid < 128) DK[(size_t)slot * 128 + tid] = expf(bb[(len - 1) * 128 + tid]);
        for (int idx = tid; idx < 8192; idx += NTHR) {
            const int t = idx >> 7, kd = idx & 127; float kh = 0.f;
            if (t < len) { const float bt = bb[idx]; BB[(size_t)(row0 + t) * 512 + h * 128 + kd] = bt;
                kh = bf2f(P[(size_t)(row0 + t) * GLA_NP + 512 + h * 128 + kd]) * expf(bb[(len - 1) * 128 + kd] - bt); }
            khT[kd * 72 + t] = f2bf(kh);
        }
        for (int idx = tid; idx < 16384; idx += NTHR) {
            const int t = idx >> 8, vd = idx & 255;
            vT[vd * 72 + t] = t < len ? P[(size_t)(row0 + t) * GLA_NP + 1024 + h * 256 + vd] : (bf16_t)0;
        }
        __syncthreads();
        f32x4 acc[2][8];
#pragma unroll
        for (int r = 0; r < 2; ++r)
#pragma unroll
            for (int c = 0; c < 8; ++c) acc[r][c] = (f32x4){0.f, 0.f, 0.f, 0.f};
#pragma unroll
        for (int ks = 0; ks < 2; ++ks) {
            bf16x8 a[2];
#pragma unroll
            for (int r = 0; r < 2; ++r) a[r] = *(const LAS bf16x8*)(vT + ((wid * 2 + r) * 16 + fr) * 72 + ks * 32 + fq * 8);
#pragma unroll
            for (int c = 0; c < 8; ++c) {
                const bf16x8 bfr = *(const LAS bf16x8*)(khT + (c * 16 + fr) * 72 + ks * 32 + fq * 8);
#pragma unroll
                for (int r = 0; r < 2; ++r) acc[r][c] = mfma16(a[r], bfr, acc[r][c]);
            }
        }
        float* sb = SB + (size_t)slot * 32768;
#pragma unroll
        for (int r = 0; r < 2; ++r)
#pragma unroll
            for (int c = 0; c < 8; ++c)
#pragma unroll
                for (int jj = 0; jj < 4; ++jj) sb[((wid * 2 + r) * 16 + fq * 4 + jj) * 128 + c * 16 + fr] = acc[r][c][jj];
        __syncthreads();
    }
}

__device__ __forceinline__ void gla_g2(const Params& p, int j, int G, int bid) {
    float* SB = (float*)(p.ws + OFF_SB); const float* DK = (const float*)(p.ws + OFF_DK);
    for (int e = bid * NTHR + threadIdx.x; e < 131072; e += G * NTHR) {
        const int h = e >> 15, vd = (e >> 7) & 255, kd = e & 127;
        float* ps = SB + (size_t)h * 32768 + vd * 128 + kd; const float* pd = DK + h * 128 + kd;
        float S = 0.f;
        for (int c0 = 0; c0 < 256; c0 += 8) {
            float ds[8], dd[8];
#pragma unroll
            for (int i = 0; i < 8; ++i) { ds[i] = ps[(size_t)(c0 + i) * 131072]; dd[i] = pd[(c0 + i) * 512]; }
#pragma unroll
            for (int i = 0; i < 8; ++i) { ps[(size_t)(c0 + i) * 131072] = S; S = dd[i] * S + ds[i]; }
        }
        p.out[O_GLAP + (size_t)j * 131072 + h * 32768 + kd * 256 + vd] = S;
    }
    const float* st = p.in[2] + (size_t)j * 8 * 131072;
    for (int e = bid * NTHR + threadIdx.x; e < 8 * 131072; e += G * NTHR) {
        const int b = e >> 17, h = (e >> 15) & 3, vd = (e >> 7) & 255, kd = e & 127, slot = 1024 + b * 4 + h;
        float* ps = SB + (size_t)slot * 32768 + vd * 128 + kd;
        const size_t so = (size_t)(b * 4 + h) * 32768 + kd * 256 + vd;
        const float S0 = st[so], ds = *ps, dd = DK[slot * 128 + kd];
        *ps = S0;
        p.out[O_GLAS + (size_t)j * 8 * 131072 + so] = dd * S0 + ds;
    }
}

__device__ __forceinline__ void gla_g3(LAS unsigned char* lds, const Params& p, int j, int G, int bid) {
    const bf16_t* P = (const bf16_t*)(p.ws + OFF_P); const float* SB = (const float*)(p.ws + OFF_SB); const float* BB = (const float*)(p.ws + OFF_BB);
    bf16_t* AB = (bf16_t*)(p.ws + OFF_AB); const float* gn = p.in[13] + (size_t)j * 256;
    LAS bf16_t* qt = (LAS bf16_t*)lds;
    LAS bf16_t* kt = (LAS bf16_t*)(lds + 17408);
    LAS bf16_t* sc = (LAS bf16_t*)(lds + 34816);
    LAS bf16_t* vT = (LAS bf16_t*)(lds + 44032);
    LAS float* part = (LAS float*)(lds + 80896);
    int tid_ = threadIdx.x; asm volatile("" : "+v"(tid_)); const int tid = tid_, wid = tid >> 6, lane = tid & 63, fr = lane & 15, fq = lane >> 4;
    for (int slot = bid; slot < NSLOT; slot += G) {
        int row0, len, h; gla_item(slot, row0, len, h);
        for (int idx = tid; idx < 8192; idx += NTHR) {
            const int t = idx >> 7, kd = idx & 127; float qv = 0.f, kv = 0.f;
            if (t < len) { const float bt = BB[(size_t)(row0 + t) * 512 + h * 128 + kd]; const bf16_t* pr = P + (size_t)(row0 + t) * GLA_NP + h * 128 + kd;
                qv = bf2f(pr[0]) * 0.08838834764831845f * expf(bt); kv = bf2f(pr[512]) * expf(-bt); }
            qt[t * 136 + kd] = f2bf(qv); kt[t * 136 + kd] = f2bf(kv);
        }
        for (int idx = tid; idx < 16384; idx += NTHR) {
            const int t = idx >> 8, vd = idx & 255;
            vT[vd * 72 + t] = t < len ? P[(size_t)(row0 + t) * GLA_NP + 1024 + h * 256 + vd] : (bf16_t)0;
        }
        __syncthreads();
#pragma unroll
        for (int i = 0; i < 2; ++i) {
            const int ti = wid * 2 + i, rt = ti >> 2, ct = ti & 3;
            f32x4 a4 = (f32x4){0.f, 0.f, 0.f, 0.f};
            if (ct <= rt) {
#pragma unroll
                for (int ks = 0; ks < 4; ++ks) {
                    const bf16x8 a = *(const LAS bf16x8*)(qt + (rt * 16 + fr) * 136 + ks * 32 + fq * 8);
                    const bf16x8 b = *(const LAS bf16x8*)(kt + (ct * 16 + fr) * 136 + ks * 32 + fq * 8);
                    a4 = mfma16(a, b, a4);
                }
            }
#pragma unroll
            for (int jj = 0; jj < 4; ++jj) { const int t = rt * 16 + fq * 4 + jj, s = ct * 16 + fr; sc[t * 72 + s] = f2bf(s <= t ? a4[jj] : 0.f); }
        }
        __syncthreads();
        f32x4 acc[4][2];
#pragma unroll
        for (int r = 0; r < 4; ++r)
#pragma unroll
            for (int c = 0; c < 2; ++c) acc[r][c] = (f32x4){0.f, 0.f, 0.f, 0.f};
#pragma unroll
        for (int ks = 0; ks < 2; ++ks) {
            bf16x8 b[2];
#pragma unroll
            for (int c = 0; c < 2; ++c) b[c] = *(const LAS bf16x8*)(vT + (wid * 32 + c * 16 + fr) * 72 + ks * 32 + fq * 8);
#pragma unroll
            for (int r = 0; r < 4; ++r) {
                const bf16x8 a = *(const LAS bf16x8*)(sc + (r * 16 + fr) * 72 + ks * 32 + fq * 8);
#pragma unroll
                for (int c = 0; c < 2; ++c) acc[r][c] = mfma16(a, b[c], acc[r][c]);
            }
        }
        const float* sp = SB + (size_t)slot * 32768;
#pragma unroll
        for (int ks = 0; ks < 4; ++ks) {
            bf16x8 b[2];
#pragma unroll
            for (int c = 0; c < 2; ++c) {
                const float* q = sp + (size_t)(wid * 32 + c * 16 + fr) * 128 + ks * 32 + fq * 8;
                const float4 x0 = *(const float4*)q, x1 = *(const float4*)(q + 4);
                u32x4 w; w.x = pk2(x0.x, x0.y); w.y = pk2(x0.z, x0.w); w.z = pk2(x1.x, x1.y); w.w = pk2(x1.z, x1.w);
                b[c] = __builtin_bit_cast(bf16x8, w);
            }
#pragma unroll
            for (int r = 0; r < 4; ++r) {
                const bf16x8 a = *(const LAS bf16x8*)(qt + (r * 16 + fr) * 136 + ks * 32 + fq * 8);
#pragma unroll
                for (int c = 0; c < 2; ++c) acc[r][c] = mfma16(a, b[c], acc[r][c]);
            }
        }
#pragma unroll
        for (int r = 0; r < 4; ++r)
#pragma unroll
            for (int jj = 0; jj < 4; ++jj) {
                float ss = acc[r][0][jj] * acc[r][0][jj] + acc[r][1][jj] * acc[r][1][jj];
                ss += __shfl_xor(ss, 1); ss += __shfl_xor(ss, 2); ss += __shfl_xor(ss, 4); ss += __shfl_xor(ss, 8);
                if (fr == 0) part[(r * 16 + fq * 4 + jj) * 8 + wid] = ss;
            }
        __syncthreads();
#pragma unroll
        for (int r = 0; r < 4; ++r)
#pragma unroll
            for (int jj = 0; jj < 4; ++jj) {
                const int t = r * 16 + fq * 4 + jj;
                if (t < len) {
                    float tot = 0.f;
#pragma unroll
                    for (int w = 0; w < 8; ++w) tot += part[t * 8 + w];
                    const float rinv = 1.0f / sqrtf(tot * (1.0f / 256.0f) + LN_EPS);
#pragma unroll
                    for (int c = 0; c < 2; ++c) {
                        const int vd = wid * 32 + c * 16 + fr;
                        const float rr = bf2f(P[(size_t)(row0 + t) * GLA_NP + 2048 + h * 256 + vd]);
                        AB[(size_t)(row0 + t) * D + h * 256 + vd] = f2bf(acc[r][c][jj] * rinv * gn[vd] * silu_f(rr));
                    }
                }
            }
        __syncthreads();
    }
}

__device__ __forceinline__ void sg_phase(LAS unsigned char* lds, const Params& p, int j, int G, int bid) {
    bf16_t* U = (bf16_t*)(p.ws + OFF_BIG); const bf16_t* V = (const bf16_t*)(p.ws + OFF_BIG + (size_t)MT * 2048 * 2);
    const float* lg = p.in[16] + (size_t)j * 2048; const float* lb = p.in[17] + (size_t)j * 2048;
    const float* wsp = p.in[18] + (size_t)j * 8 * 128 * 128; const float* bsp = p.in[19] + (size_t)j * 8 * 128;
    float* sgv = p.out + O_SGV + (size_t)j * 8 * 32 * 2048;
    LAS bf16_t* vnT = (LAS bf16_t*)lds;
    LAS bf16_t* wsA = (LAS bf16_t*)(lds + 69632);
    LAS float* stat = (LAS float*)(lds + 104448);
    int tid_ = threadIdx.x; asm volatile("" : "+v"(tid_)); const int tid = tid_, wid = tid >> 6, lane = tid & 63, fr = lane & 15, fq = lane >> 4;
    const int NIT = (128 + 8) * 8;
    for (int it = bid; it < NIT; it += G) {
        const int ci = it >> 3, g = it & 7; const bool samp = ci >= 128;
        const int row0 = samp ? MP + (ci - 128) * 32 : ci * 128, len = samp ? 32 : 128;
        for (int t = wid; t < len; t += 8) {
            const bf16_t* vr = V + (size_t)(row0 + t) * 2048;
            float x[32];
#pragma unroll
            for (int i = 0; i < 4; ++i) { const u32x4 w = *(const u32x4*)(vr + (i * 64 + lane) * 8); float f[8]; unpack8(w, f);
#pragma unroll
                for (int k = 0; k < 8; ++k) x[i * 8 + k] = f[k]; }
            float s = 0.f;
#pragma unroll
            for (int i = 0; i < 32; ++i) s += x[i];
#pragma unroll
            for (int o = 32; o >= 1; o >>= 1) s += __shfl_xor(s, o);
            const float mean = s * (1.0f / 2048.0f);
            float q = 0.f;
#pragma unroll
            for (int i = 0; i < 32; ++i) { const float d = x[i] - mean; q += d * d; }
#pragma unroll
            for (int o = 32; o >= 1; o >>= 1) q += __shfl_xor(q, o);
            if (lane == 0) { stat[t * 2] = mean; stat[t * 2 + 1] = 1.0f / sqrtf(q * (1.0f / 2048.0f) + LN_EPS); }
        }
        for (int idx = tid; idx < 16384; idx += NTHR) { const int t = idx >> 7, s = idx & 127; wsA[t * 136 + s] = f2bf(s <= t ? wsp[(size_t)g * 16384 + idx] : 0.f); }
        __syncthreads();
        for (int idx = tid; idx < 32768; idx += NTHR) {
            const int s = idx >> 8, d = idx & 255; float vn = 0.f;
            if (s < len) {
                vn = (bf2f(V[(size_t)(row0 + s) * 2048 + g * 256 + d]) - stat[s * 2]) * stat[s * 2 + 1] * lg[g * 256 + d] + lb[g * 256 + d];
                if (samp) sgv[(size_t)(row0 - MP + s) * 2048 + g * 256 + d] = vn;
            }
            vnT[d * 136 + s] = f2bf(vn);
        }
        __syncthreads();
        f32x4 acc[8][2];
#pragma unroll
        for (int r = 0; r < 8; ++r)
#pragma unroll
            for (int c = 0; c < 2; ++c) acc[r][c] = (f32x4){0.f, 0.f, 0.f, 0.f};
#pragma unroll
        for (int ks = 0; ks < 4; ++ks) {
            bf16x8 b[2];
#pragma unroll
            for (int c = 0; c < 2; ++c) b[c] = *(const LAS bf16x8*)(vnT + (wid * 32 + c * 16 + fr) * 136 + ks * 32 + fq * 8);
#pragma unroll
            for (int r = 0; r < 8; ++r) {
                if (ks * 32 <= r * 16 + 15) {
                    const bf16x8 a = *(const LAS bf16x8*)(wsA + (r * 16 + fr) * 136 + ks * 32 + fq * 8);
#pragma unroll
                    for (int c = 0; c < 2; ++c) acc[r][c] = mfma16(a, b[c], acc[r][c]);
                }
            }
        }
#pragma unroll
        for (int r = 0; r < 8; ++r)
#pragma unroll
            for (int jj = 0; jj < 4; ++jj) {
                const int t = r * 16 + fq * 4 + jj;
                if (t < len) {
                    const float bsv = bsp[g * 128 + t];
#pragma unroll
                    for (int c = 0; c < 2; ++c) {
                        bf16_t* up = U + (size_t)(row0 + t) * 2048 + g * 256 + wid * 32 + c * 16 + fr;
                        *up = f2bf(bf2f(*up) * (acc[r][c][jj] + bsv));
                    }
                }
            }
        __syncthreads();
    }
}

template <int K> __device__ __forceinline__ void skinny_out(LAS unsigned char* lds, const bf16_t* __restrict__ A, const bf16_t* __restrict__ Bt, float* X, float alpha, float scale, int G, int bid) {
    int tid_ = threadIdx.x; asm volatile("" : "+v"(tid_)); const int tid = tid_, wid = tid >> 6, lane = tid & 63, fr = lane & 15, fq = lane >> 4;
    LAS float* part = (LAS float*)lds;
    constexpr int KW = K / 8;
    for (int it = bid; it < 256; it += G) {
        const int rf = it >> 4, cc = it & 15;
        const bf16_t* ap = A + (size_t)(MP + rf * 16 + fr) * K + wid * KW + fq * 8;
        const bf16_t* bp = Bt + (size_t)(cc * 64 + fr) * K + wid * KW + fq * 8;
        f32x4 acc[4];
#pragma unroll
        for (int c = 0; c < 4; ++c) acc[c] = (f32x4){0.f, 0.f, 0.f, 0.f};
#pragma unroll
        for (int k = 0; k < KW; k += 32) {
            const bf16x8 a = *(const bf16x8*)(ap + k);
#pragma unroll
            for (int c = 0; c < 4; ++c) { const bf16x8 b = *(const bf16x8*)(bp + (size_t)c * 16 * K + k); acc[c] = mfma16(a, b, acc[c]); }
        }
#pragma unroll
        for (int c = 0; c < 4; ++c)
#pragma unroll
            for (int jj = 0; jj < 4; ++jj) part[(wid * 16 + fq * 4 + jj) * 64 + c * 16 + fr] = acc[c][jj];
        __syncthreads();
        for (int e = tid; e < 1024; e += NTHR) {
            const int r = e >> 6, c = e & 63; float s = 0.f;
#pragma unroll
            for (int w = 0; w < 8; ++w) s += part[(w * 16 + r) * 64 + c];
            float* xp = X + (size_t)(MP + rf * 16 + r) * D + cc * 64 + c;
            *xp = alpha * (*xp) + scale * s;
        }
        __syncthreads();
    }
}

#ifndef PROBE_CLASS
#define PROBE_CLASS 0
#endif
#define PB(c) do { if (PROBE_CLASS && ((PROBE_MASK >> (c)) & 1)) t0_ = wall_clock64(); } while (0)
#define PE(c) do { if (PROBE_CLASS && ((PROBE_MASK >> (c)) & 1)) t_acc += wall_clock64() - t0_; } while (0)
#ifndef PROBE_MASK
#define PROBE_MASK 0
#endif
__global__ void __launch_bounds__(NTHR, 2) mega(Params p) {
    extern __shared__ __attribute__((aligned(16))) unsigned char lds_raw[];
    LAS unsigned char* lds = (LAS unsigned char*)lds_raw;
    cg::grid_group grid = cg::this_grid();
    const int G = gridDim.x, bid = blockIdx.x;
    float* X = p.out + O_Y; bf16_t* XB = (bf16_t*)(p.ws + OFF_XB); bf16_t* WT = (bf16_t*)(p.ws + OFF_WT);
    bf16_t* BIG = (bf16_t*)(p.ws + OFF_BIG);

    unsigned long long t_acc = 0, t0_ = 0;
    PB(9);
    init_phase(p, G, bid);
    convert_layer(lds, p, 0, G, bid);
    grid.sync();
    PE(9);

    for (int l = 0; l < 4; ++l) {
        const int mixer = l % 3, j = l / 3;
        for (int sub = 0; sub < 3; ++sub) {
            const bf16_t* Aout; const bf16_t* Wout; int Kout; float scale;
            if (sub != 1) {
                PB(1);
                pg8::Gemm g{XB, WT + (sub == 0 ? W_1IN : W_2IN), MT, 2 * DFF, D}; pg8::StaticOrder S; S.init(MT, 2 * DFF, G, bid);
                EpiPair<1> E{BIG, DFF};
                pg8::gemm_phase<EpiPair<1>, pg8::StaticOrder>(lds, g, S, E, nullptr);
                Aout = BIG; Wout = WT + (sub == 0 ? W_1OUT : W_2OUT); Kout = DFF; scale = 0.5f;
                grid.sync();
                PE(1);
            } else if (mixer == 0) {
                PB(1);
                { pg8::Gemm g{XB, WT + W_MIN, MT, GLA_NP, D}; pg8::StaticOrder S; S.init(MT, GLA_NP, G, bid);
                  EpiBf<0> E{(bf16_t*)(p.ws + OFF_P), GLA_NP, 0, 0};
                  pg8::gemm_phase<EpiBf<0>, pg8::StaticOrder>(lds, g, S, E, nullptr); }
                grid.sync();
                PE(1);
                PB(4);
                gla_g1(lds, p, j, G, bid);
                grid.sync();
                PE(4);
                PB(5);
                gla_g2(p, j, G, bid);
                grid.sync();
                PE(5);
                PB(6);
                gla_g3(lds, p, j, G, bid);
                grid.sync();
                PE(6);
                Aout = (const bf16_t*)(p.ws + OFF_AB); Wout = WT + W_MOUT; Kout = D; scale = 1.0f;
            } else if (mixer == 1) {
                PB(1);
                { pg8::Gemm g{XB, WT + W_MIN, MT, 4096, D}; pg8::StaticOrder S; S.init(MT, 4096, G, bid);
                  EpiBf<1> E{BIG, 2048, 2048, (size_t)MT * 2048};
                  pg8::gemm_phase<EpiBf<1>, pg8::StaticOrder>(lds, g, S, E, nullptr); }
                grid.sync();
                PE(1);
                PB(7);
                sg_phase(lds, p, j, G, bid);
                grid.sync();
                PE(7);
                Aout = BIG; Wout = WT + W_MOUT; Kout = 2048; scale = 1.0f;
            } else {
                PB(1);
                { pg8::Gemm g{XB, WT + W_MIN, MT, 3072, D}; pg8::StaticOrder S; S.init(MT, 3072, G, bid);
                  EpiConv E{BIG, BIG + (size_t)MT * D};
                  pg8::gemm_phase<EpiConv, pg8::StaticOrder>(lds, g, S, E, nullptr); }
                grid.sync();
                PE(1);
                PB(8);
                conv_phase(p, j, G, bid);
                grid.sync();
                PE(8);
                Aout = BIG + (size_t)MT * D; Wout = WT + W_MOUT; Kout = D; scale = 1.0f;
            }
            PB(2);
            { pg8::Gemm g{Aout, Wout, MP, D, Kout}; pg8::StaticOrder S; S.init(MP, D, G, bid);
              EpiRes E{X, ALPHA, scale};
              pg8::gemm_phase<EpiRes, pg8::StaticOrder>(lds, g, S, E, nullptr); }
            if (Kout == DFF) skinny_out<DFF>(lds, Aout, Wout, X, ALPHA, scale, G, bid);
            else if (Kout == 2048) skinny_out<2048>(lds, Aout, Wout, X, ALPHA, scale, G, bid);
            else skinny_out<1024>(lds, Aout, Wout, X, ALPHA, scale, G, bid);
            grid.sync();
            PE(2);
            PB(3);
            ln_phase(X, XB, p.in[4] + (size_t)(l * 3 + sub) * D, p.in[5] + (size_t)(l * 3 + sub) * D, G, bid);
            if (sub == 2 && l < 3) convert_layer(lds, p, l + 1, G, bid);
            if (!(sub == 2 && l == 3)) grid.sync();
            PE(3);
        }
    }
    if (PROBE_CLASS) { __syncthreads(); if (bid == 0 && threadIdx.x == 0) X[0] += (float)t_acc * (0.01f / 256.0f); }
}

extern "C" void kernel_launch(void* const* d_in, const int* in_sizes, int n_in, void* d_out, int out_size, void* d_ws, size_t ws_size, hipStream_t stream) {
    static int grid_blocks = 0;
    if (grid_blocks == 0) {
        if (n_in != 24 || ws_size < WS_END) { fprintf(stderr, "kernel_launch: unexpected n_in %d or ws_size %zu (< %zu)\n", n_in, ws_size, (size_t)WS_END); grid_blocks = -1; return; }
        int dev = 0, cus = 0, per_cu = 0;
        hipGetDevice(&dev);
        hipDeviceGetAttribute(&cus, hipDeviceAttributeMultiprocessorCount, dev);
        if (hipFuncSetAttribute((const void*)mega, hipFuncAttributeMaxDynamicSharedMemorySize, LDS_BYTES) != hipSuccess) { fprintf(stderr, "kernel_launch: hipFuncSetAttribute failed\n"); grid_blocks = -1; return; }
        if (hipOccupancyMaxActiveBlocksPerMultiprocessor(&per_cu, (const void*)mega, NTHR, LDS_BYTES) != hipSuccess || per_cu < 1) { fprintf(stderr, "kernel_launch: occupancy query says %d\n", per_cu); per_cu = 1; }
        (void)hipGetLastError();
        grid_blocks = cus * 1;
    }
    if (grid_blocks < 0) return;
    Params p{};
    for (int i = 0; i < 24; ++i) p.in[i] = (const float*)d_in[i];
    p.out = (float*)d_out; p.ws = (unsigned char*)d_ws;
    void* args[] = {&p};
    hipError_t e = hipLaunchCooperativeKernel((const void*)mega, dim3(grid_blocks), dim3(NTHR), args, LDS_BYTES, stream);
    if (e != hipSuccess) fprintf(stderr, "cooperative launch failed: %s (grid %d)\n", hipGetErrorString(e), grid_blocks);
}
```

```cpp
#include <hip/hip_runtime.h>
#include <hip/hip_cooperative_groups.h>
#include <cstdio>
namespace cg = cooperative_groups;
namespace pg8 {
#define PG8_LAS __attribute__((address_space(3)))
typedef unsigned short bf16_t;
typedef short bf16x8 __attribute__((ext_vector_type(8)));
typedef float f32x4 __attribute__((ext_vector_type(4)));
typedef unsigned u32x4 __attribute__((ext_vector_type(4)));
constexpr int BM = 256, BK = 64, HALF = 128, HTB = HALF * BK * 2  , STAGE_BYTES = 8 * HTB, NXCD = 8, WGM = 8;

__host__ __device__ __forceinline__ int lds_byte(int r, int c) { const int st = (r >> 4) * 2 + (c >> 5), rr = r & 15, cc = c & 31, ob = rr * 64 + cc * 2; return st * 1024 + (ob ^ (((ob >> 9) & 1) << 5)); }
__host__ __device__ __forceinline__ void stage_rc(int b, int& R, int& C) { const int st = b / 1024, sb = b % 1024, swz = sb ^ (((sb >> 9) & 1) << 5); R = (st >> 1) * 16 + swz / 64; C = (st & 1) * 32 + (swz % 64) / 2; }
__host__ __device__ __forceinline__ int perm32(int rho) { const int n = rho >> 4, i = rho & 15; return 8 * (i >> 2) + 4 * n + (i & 3); }

struct Unit { int pm, pn; };
struct Gemm { const bf16_t* A; const bf16_t* Bt; int M, N, K; };

struct StaticOrder {
    int nM, nN, nwg, G, c;
    __host__ __device__ void init(int M, int N, int G_, int c_) { nM = M / BM; nN = N / BM; nwg = nM * nN; G = G_; c = c_; }
    __host__ __device__ bool next(int i, Unit& u) const {
        const long L = (long)i * G + c; if (L >= nwg) return false;
        int wgid = (int)L; { const int q = nwg / NXCD, r = nwg % NXCD, xcd = wgid % NXCD, off = wgid / NXCD; wgid = (xcd < r ? xcd * (q + 1) : r * (q + 1) + (xcd - r) * q) + off; }
        const int nig = WGM * nN, gid = wgid / nig, fm = gid * WGM, gsz = (nM - fm) < WGM ? (nM - fm) : WGM;
        u.pm = fm + ((wgid % nig) % gsz); u.pn = (wgid % nig) / gsz; return true;
    }
    __device__ __forceinline__ void a_ready(const Unit&) const {}
    __device__ __forceinline__ void done(const Unit&) const {}
};
struct CountedOrder : StaticOrder {
    const unsigned* ready; unsigned need; unsigned* tmo;
    __device__ __forceinline__ void a_ready(const Unit& u) const {
        if (threadIdx.x < 64) {
            const unsigned long long t0 = __builtin_amdgcn_s_memrealtime(); unsigned polls = 0;
            while ((unsigned)__builtin_amdgcn_readfirstlane(__hip_atomic_load(ready + 64 * u.pm, __ATOMIC_RELAXED, __HIP_MEMORY_SCOPE_AGENT)) < need) {
                if ((++polls & 255u) == 0u && __builtin_amdgcn_readfirstlane(__hip_atomic_load(tmo, __ATOMIC_RELAXED, __HIP_MEMORY_SCOPE_AGENT)) != 0u) break;
                if (__builtin_amdgcn_s_memrealtime() - t0 > 2000000ull) {
                    if (threadIdx.x == 0) { unsigned expect = 0u; __hip_atomic_compare_exchange_strong(tmo + 1, &expect, 0x600u | (unsigned)(u.pm & 0xff), __ATOMIC_RELAXED, __ATOMIC_RELAXED, __HIP_MEMORY_SCOPE_AGENT); __hip_atomic_store(tmo, 1u, __ATOMIC_RELAXED, __HIP_MEMORY_SCOPE_AGENT); }
                    break; }
                __builtin_amdgcn_s_sleep(2); }
            __builtin_amdgcn_fence(__ATOMIC_ACQUIRE, "agent");
            asm volatile("s_waitcnt vmcnt(0)" ::: "memory");
        }
#if !defined(BROKEN_HOOK_NO_BARRIER)
        asm volatile("" ::: "memory"); __builtin_amdgcn_s_barrier(); asm volatile("" ::: "memory");
#endif
    }
};

__device__ __forceinline__ unsigned cvt_pk_bf16(float lo, float hi) { unsigned r; asm volatile("v_cvt_pk_bf16_f32 %0, %1, %2" : "=v"(r) : "v"(lo), "v"(hi)); return r; }
typedef float f32x2 __attribute__((ext_vector_type(2)));
__device__ __forceinline__ f32x2 gelu_pk(f32x2 v) {
    const f32x2 av = __builtin_elementwise_abs(v), d = av * 0.2316418882f + 1.0f;
    f32x2 t; t.x = __builtin_amdgcn_rcpf(d.x); t.y = __builtin_amdgcn_rcpf(d.y);
    f32x2 q = t * 0.5307027145f + (-0.7265760135f); q = q * t + 0.7107068705f; q = q * t + (-0.142248368f); q = q * t + 0.127414796f; q = q * t;
    const f32x2 s = (v * v) * (-0.72134752044f);
    f32x2 e; e.x = __builtin_amdgcn_exp2f(s.x); e.y = __builtin_amdgcn_exp2f(s.y);
    const f32x2 m = v * (q * e), r = v - m;
    f32x2 o; o.x = v.x < 0.f ? m.x : r.x; o.y = v.y < 0.f ? m.y : r.y; return o;
}

template <class Epi, class Sched, bool STAMP = false>
__device__ __forceinline__ void gemm_phase(PG8_LAS unsigned char* lds, const Gemm g, const Sched& S, const Epi& E, unsigned long long* stamps) {
    int tid_ = threadIdx.x; asm volatile("" : "+v"(tid_)); const int tid = tid_, wid = __builtin_amdgcn_readfirstlane(tid >> 6), lane = tid & 63, wr = wid >> 2, wc = wid & 3, fr = lane & 15, fq = lane >> 4;
    const int K = g.K, nt = K / BK;
    int ts_lo = 0, ts_hi = 0, nts = 0; const unsigned long long rt_entry = STAMP ? (unsigned long long)wall_clock64() : 0ull;
#define PG8_STAMP() do { if (STAMP && wid == 0 && nts < 64) { const unsigned long long _c = (unsigned long long)clock64(); \
        ts_lo = (lane == nts) ? (int)(unsigned)_c : ts_lo; ts_hi = (lane == nts) ? (int)(unsigned)(_c >> 32) : ts_hi; ++nts; } } while (0)
    PG8_STAMP();
    unsigned voffA[2], voffB[2];
#pragma unroll
    for (int i = 0; i < 2; ++i) { int R, C; stage_rc(tid * 16 + i * 8192, R, C); const int Rb = Epi::PERM ? ((R & ~31) + perm32(R & 31)) : R;
        voffA[i] = (unsigned)(R * K + C) * 2u; voffB[i] = (unsigned)(Rb * K + C) * 2u; }
    const size_t kstep = (size_t)(BK * 2);
    const size_t hstep = (size_t)HALF * K * 2;
    const size_t tstep = 2 * hstep;
    const unsigned ldsw = (unsigned)wid * 1024u;
    const int aoff = lds_byte(wr * 64 + fr, fq * 8), boff = lds_byte(wc * 32 + fr, fq * 8);
#define PG8_SA(b, h) (((b) * 2 + (h)) * HTB)
#define PG8_SB(b, h) ((4 + (b) * 2 + (h)) * HTB)
#define PG8_STAGE(bufoff, gbase, voff) do { _Pragma("unroll") for (int _i = 0; _i < 2; ++_i) \
        __builtin_amdgcn_global_load_lds((const unsigned*)((const char*)(gbase) + (voff)[_i]), (PG8_LAS unsigned*)(lds + (bufoff) + ldsw + _i * 8192), 16, 0, 0); } while (0)
#define PG8_LDA(dst, b, h) do { _Pragma("unroll") for (int m = 0; m < 4; ++m) _Pragma("unroll") for (int k = 0; k < 2; ++k) dst[m][k] = *(const PG8_LAS bf16x8*)(lds + PG8_SA(b, h) + aoff + m * 2048 + k * 1024); } while (0)
#define PG8_LDB(dst, b, h) do { _Pragma("unroll") for (int n = 0; n < 2; ++n) _Pragma("unroll") for (int k = 0; k < 2; ++k) dst[n][k] = *(const PG8_LAS bf16x8*)(lds + PG8_SB(b, h) + boff + n * 2048 + k * 1024); } while (0)
#define PG8_MMA(ai, bj, At, Bt) do { __builtin_amdgcn_s_setprio(1); _Pragma("unroll") for (int m = 0; m < 4; ++m) _Pragma("unroll") for (int n = 0; n < 2; ++n) _Pragma("unroll") for (int k = 0; k < 2; ++k) \
        acc[ai][bj][m][n] = __builtin_amdgcn_mfma_f32_16x16x32_bf16(Bt[n][k], At[m][k], acc[ai][bj][m][n], 0, 0, 0); __builtin_amdgcn_s_setprio(0); } while (0)
#define PG8_WAIT_V(n) asm volatile("s_waitcnt vmcnt(" #n ")" ::: "memory")
#define PG8_WAIT_L(n) asm volatile("s_waitcnt lgkmcnt(" #n ")" ::: "memory")
#define PG8_BAR __builtin_amdgcn_s_barrier()
#define PG8_SCHED __builtin_amdgcn_sched_barrier(0)
    Unit cur, nxt; int ui = 0;
    if (!S.next(0, cur)) return;
    f32x4 acc[2][2][4][2];
#pragma unroll
    for (int a = 0; a < 2; ++a)
#pragma unroll
        for (int b = 0; b < 2; ++b)
#pragma unroll
            for (int m = 0; m < 4; ++m)
#pragma unroll
                for (int n = 0; n < 2; ++n) acc[a][b][m][n] = (f32x4){0.f, 0.f, 0.f, 0.f};
    bf16x8 At[4][2], B0[2][2], B1[2][2];
    const char* cA = (const char*)g.A + (size_t)cur.pm * tstep; const char* cB = (const char*)g.Bt + (size_t)cur.pn * tstep;
    S.a_ready(cur);
    PG8_STAGE(PG8_SB(0, 0), cB, voffB); PG8_STAGE(PG8_SA(0, 0), cA, voffA); PG8_STAGE(PG8_SB(0, 1), cB + hstep, voffB); PG8_STAGE(PG8_SA(0, 1), cA + hstep, voffA);
    if (wr == 1) PG8_BAR;
    PG8_WAIT_V(4); PG8_BAR;
    PG8_STAGE(PG8_SB(1, 0), cB + kstep, voffB); PG8_STAGE(PG8_SA(1, 0), cA + kstep, voffA); PG8_STAGE(PG8_SB(1, 1), cB + hstep + kstep, voffB);
    PG8_WAIT_V(6); PG8_BAR;
    PG8_STAMP();
    for (;;) {
        const bool has_next = S.next(ui + 1, nxt);
        const char* nA = has_next ? (const char*)g.A + (size_t)nxt.pm * tstep : cA; const char* nB = has_next ? (const char*)g.Bt + (size_t)nxt.pn * tstep : cB;
        for (int t = 0; t < nt; t += 2) {
            const bool last = (t == nt - 2);
            const char* a1 = cA + (size_t)(t + 1) * kstep;
            const char* a2 = last ? nA : cA + (size_t)(t + 2) * kstep; const char* b2 = last ? nB : cB + (size_t)(t + 2) * kstep;
            const char* a3 = a2 + kstep; const char* b3 = b2 + kstep;
            if (last && has_next) S.a_ready(nxt);
            PG8_LDB(B0, 0, 0); PG8_SCHED; PG8_LDA(At, 0, 0); PG8_STAGE(PG8_SA(1, 1), a1 + hstep, voffA);
            PG8_WAIT_L(8); PG8_BAR; PG8_WAIT_L(0); PG8_MMA(0, 0, At, B0); PG8_BAR; PG8_SCHED;
            PG8_LDB(B1, 0, 1); PG8_STAGE(PG8_SB(0, 0), b2, voffB);
            PG8_BAR; PG8_WAIT_L(0); PG8_MMA(0, 1, At, B1); PG8_BAR;
            PG8_LDA(At, 0, 1); PG8_STAGE(PG8_SA(0, 0), a2, voffA);
            PG8_BAR; PG8_WAIT_L(0); PG8_MMA(1, 0, At, B0); PG8_BAR; PG8_SCHED;
            PG8_STAGE(PG8_SB(0, 1), b2 + hstep, voffB);
            PG8_WAIT_V(6); PG8_BAR; PG8_MMA(1, 1, At, B1); PG8_BAR;
            PG8_LDB(B0, 1, 0); PG8_SCHED; PG8_LDA(At, 1, 0); PG8_STAGE(PG8_SA(0, 1), a2 + hstep, voffA);
            PG8_WAIT_L(8); PG8_BAR; PG8_WAIT_L(0); PG8_MMA(0, 0, At, B0); PG8_BAR; PG8_SCHED;
            PG8_LDB(B1, 1, 1); PG8_STAGE(PG8_SB(1, 0), b3, voffB);
            PG8_BAR; PG8_WAIT_L(0); PG8_MMA(0, 1, At, B1); PG8_BAR;
            PG8_LDA(At, 1, 1); PG8_STAGE(PG8_SA(1, 0), a3, voffA);
            PG8_BAR; PG8_WAIT_L(0); PG8_MMA(1, 0, At, B0); PG8_BAR; PG8_SCHED;
            PG8_STAGE(PG8_SB(1, 1), b3 + hstep, voffB);
            PG8_WAIT_V(6); PG8_BAR; PG8_MMA(1, 1, At, B1); PG8_BAR;
        }
        PG8_STAMP();
        if constexpr (!Epi::AFTER_DRAIN) { E(acc, cur, wr, wc, fr, fq); S.done(cur); }
        PG8_STAMP();
        if (!has_next) break;
#pragma unroll
        for (int a = 0; a < 2; ++a)
#pragma unroll
            for (int b = 0; b < 2; ++b)
#pragma unroll
                for (int m = 0; m < 4; ++m)
#pragma unroll
                    for (int n = 0; n < 2; ++n) acc[a][b][m][n] = (f32x4){0.f, 0.f, 0.f, 0.f};
        cur = nxt; cA = nA; cB = nB; ++ui;
    }
    PG8_WAIT_V(0);
    if (wr == 0) PG8_BAR;
    PG8_BAR;
    if constexpr (Epi::AFTER_DRAIN) { E.fused(acc, cur, wr, wc, fr, fq, lds, wid, lane); S.done(cur); }
    PG8_STAMP();
    if (STAMP && wid == 0) { stamps[lane] = lane < nts ? (((unsigned long long)(unsigned)ts_hi << 32) | (unsigned)ts_lo) : 0ull;
        if (lane == 62) stamps[62] = rt_entry; if (lane == 63) stamps[63] = (unsigned long long)wall_clock64(); }
#undef PG8_STAMP
#undef PG8_SA
#undef PG8_SB
#undef PG8_STAGE
#undef PG8_LDA
#undef PG8_LDB
#undef PG8_MMA
#undef PG8_WAIT_V
#undef PG8_WAIT_L
#undef PG8_BAR
#undef PG8_SCHED
}
}

#define LAS __attribute__((address_space(3)))
using pg8::bf16_t; using pg8::bf16x8; using pg8::f32x4; using pg8::u32x4; using pg8::Unit;
typedef unsigned u32x2 __attribute__((ext_vector_type(2)));

constexpr int D = 1024, MP = 16384, MS = 256, MT = MP + MS, DFF = 2816;
constexpr int GLA_N = 3088, GLA_NP = 3328;
constexpr float ALPHA = 1.681792830507429f, LN_EPS = 1e-5f;
constexpr int NTHR = 512;
constexpr int LDS_BYTES = 136 * 1024;

constexpr size_t WT_BYTES = 48ull << 20;
constexpr size_t OFF_WT = 0;
constexpr size_t OFF_XB = OFF_WT + WT_BYTES;
constexpr size_t OFF_BIG = OFF_XB + (size_t)MT * D * 2;
constexpr int NSLOT = 1024 + 32;
constexpr size_t OFF_P = OFF_BIG;
constexpr size_t OFF_SB = OFF_P + (size_t)MT * GLA_NP * 2;
constexpr size_t OFF_BB = OFF_SB + (size_t)NSLOT * 32768 * 4;
constexpr size_t OFF_AB = OFF_BB + (size_t)MT * 512 * 4;
constexpr size_t OFF_DK = OFF_AB + (size_t)MT * D * 2;
constexpr size_t OFF_CTR = OFF_DK + (size_t)NSLOT * 128 * 4;
constexpr size_t WS_END = OFF_CTR + 16384;
constexpr size_t W_1IN = 0, W_1OUT = 5767168, W_2IN = 8650752, W_2OUT = 14417920, W_MIN = 17301504, W_MOUT = 21495808;
constexpr size_t O_Y = 0, O_GLAP = 17039360, O_GLAS = 17301504, O_CONVP = 19398656, O_CONVS = 19400704, O_SGV = 19417088;

struct Params { const float* in[24]; float* out; unsigned char* ws; };

__device__ __forceinline__ unsigned pk2(float lo, float hi) { return pg8::cvt_pk_bf16(lo, hi); }
__device__ __forceinline__ bf16_t f2bf(float f) { return (bf16_t)(pk2(f, 0.f) & 0xffffu); }
__device__ __forceinline__ float bf2f(bf16_t b) { return __uint_as_float(((unsigned)b) << 16); }
__device__ __forceinline__ float bflo(unsigned w) { return __uint_as_float(w << 16); }
__device__ __forceinline__ float bfhi(unsigned w) { return __uint_as_float(w & 0xffff0000u); }
__device__ __forceinline__ float silu_f(float x) { return x * __builtin_amdgcn_rcpf(1.0f + __expf(-x)); }
__device__ __forceinline__ float gelu_tanh_f(float x) { const float z = 1.5957691216057308f * (x + 0.044715f * x * x * x); return x * __builtin_amdgcn_rcpf(1.0f + __expf(-z)); }
__device__ __forceinline__ float logsigmoid_f(float z) { return fminf(z, 0.f) - log1pf(expf(-fabsf(z))); }

template <int ACT> struct EpiPair {
    static constexpr bool PERM = true, AFTER_DRAIN = false;
    bf16_t* O; int ldo;
    __device__ __forceinline__ void operator()(const f32x4 (&acc)[2][2][4][2], const Unit& u, int wr, int wc, int fr, int fq) const {
        const int row0 = u.pm * 256 + wr * 64 + fr, col0 = u.pn * 128 + wc * 32 + 8 * fq;
#pragma unroll
        for (int ai = 0; ai < 2; ++ai)
#pragma unroll
            for (int m = 0; m < 4; ++m) {
                bf16_t* rowp = O + (size_t)(row0 + ai * 128 + m * 16) * ldo + col0;
                f32x4 v0, v1;
#pragma unroll
                for (int j = 0; j < 4; ++j) {
                    const float a0 = acc[ai][0][m][0][j], a1 = acc[ai][0][m][1][j];
                    v0[j] = (ACT ? silu_f(a0) : a0) * acc[ai][1][m][0][j];
                    v1[j] = (ACT ? silu_f(a1) : a1) * acc[ai][1][m][1][j];
                }
                u32x4 w; w.x = pk2(v0[0], v0[1]); w.y = pk2(v0[2], v0[3]); w.z = pk2(v1[0], v1[1]); w.w = pk2(v1[2], v1[3]);
                *(u32x4*)rowp = w;
            }
    }
};
template <int ACT> struct EpiBf {
    static constexpr bool PERM = true, AFTER_DRAIN = false;
    bf16_t* O; int ldc; int split_cols; size_t split_stride; float* vstat = nullptr;
    __device__ __forceinline__ void operator()(const f32x4 (&acc)[2][2][4][2], const Unit& u, int wr, int wc, int fr, int fq) const {
        const int row0 = u.pm * 256 + wr * 64 + fr; int colt = u.pn * 256; bf16_t* base = O;
        if (split_cols) { const int t = colt / split_cols; base += (size_t)t * split_stride; colt -= t * split_cols; }
        const int col0 = colt + wc * 32 + 8 * fq;
#pragma unroll
        for (int ai = 0; ai < 2; ++ai)
#pragma unroll
            for (int m = 0; m < 4; ++m) {
                bf16_t* rowp = base + (size_t)(row0 + ai * 128 + m * 16) * ldc + col0;
                float ssum = 0.f, qsum = 0.f;
#pragma unroll
                for (int bj = 0; bj < 2; ++bj) {
                    f32x4 v0 = acc[ai][bj][m][0], v1 = acc[ai][bj][m][1];
                    if (ACT == 1) {
#pragma unroll
                        for (int j = 0; j < 4; ++j) { v0[j] = gelu_tanh_f(v0[j]); v1[j] = gelu_tanh_f(v1[j]); }
                    }
                    u32x4 w; w.x = pk2(v0[0], v0[1]); w.y = pk2(v0[2], v0[3]); w.z = pk2(v1[0], v1[1]); w.w = pk2(v1[2], v1[3]);
                    *(u32x4*)(rowp + bj * 128) = w;
                    if (ACT == 1) {
                        const float f0 = bflo(w.x), f1 = bfhi(w.x), f2 = bflo(w.y), f3 = bfhi(w.y), f4 = bflo(w.z), f5 = bfhi(w.z), f6 = bflo(w.w), f7 = bfhi(w.w);
                        ssum += ((f0 + f1) + (f2 + f3)) + ((f4 + f5) + (f6 + f7));
                        qsum += ((f0 * f0 + f1 * f1) + (f2 * f2 + f3 * f3)) + ((f4 * f4 + f5 * f5) + (f6 * f6 + f7 * f7));
                    }
                }
                if (ACT == 1) {
                    if (vstat != nullptr && u.pn >= 8) {
                        ssum += __shfl_xor(ssum, 16); ssum += __shfl_xor(ssum, 32); qsum += __shfl_xor(qsum, 16); qsum += __shfl_xor(qsum, 32);
                        if (fq == 0) { float* sp = vstat + ((size_t)(row0 + ai * 128 + m * 16) * 32 + (u.pn - 8) * 4 + wc) * 2; sp[0] = ssum; sp[1] = qsum; }
                    }
                }
            }
    }
};
struct EpiConv {
    static constexpr bool PERM = true, AFTER_DRAIN = false;
    bf16_t* CIN; bf16_t* BG;
    __device__ __forceinline__ void operator()(const f32x4 (&acc)[2][2][4][2], const Unit& u, int wr, int wc, int fr, int fq) const {
        if (u.pn < 8) { EpiPair<0> e{CIN, D}; e(acc, u, wr, wc, fr, fq); }
        else { EpiBf<0> e{BG, D, 0, 0}; Unit v = u; v.pn = u.pn - 8; e(acc, v, wr, wc, fr, fq); }
    }
};
struct EpiRes {
    static constexpr bool PERM = false, AFTER_DRAIN = false;
    float* X; float alpha, scale;
    __device__ __forceinline__ void operator()(const f32x4 (&acc)[2][2][4][2], const Unit& u, int wr, int wc, int fr, int fq) const {
        const int row0 = u.pm * 256 + wr * 64 + fr, col0 = u.pn * 256 + wc * 32 + 4 * fq;
#pragma unroll
        for (int ai = 0; ai < 2; ++ai) {
            float* base = X + (size_t)(row0 + ai * 128) * D + col0;
            f32x4 xv[4][2][2];
#pragma unroll
            for (int m = 0; m < 4; ++m)
#pragma unroll
                for (int bj = 0; bj < 2; ++bj)
#pragma unroll
                    for (int n = 0; n < 2; ++n) xv[m][bj][n] = *(const f32x4*)(base + m * 16 * D + bj * 128 + n * 16);
            __builtin_amdgcn_sched_barrier(0);
#pragma unroll
            for (int m = 0; m < 4; ++m)
#pragma unroll
                for (int bj = 0; bj < 2; ++bj)
#pragma unroll
                    for (int n = 0; n < 2; ++n) *(f32x4*)(base + m * 16 * D + bj * 128 + n * 16) = xv[m][bj][n] * alpha + acc[ai][bj][m][n] * scale;
            __builtin_amdgcn_sched_barrier(0);
        }
    }
};

__device__ __forceinline__ int srccol(int mode, int n) {
    if (mode == 1) { const int pn = n >> 8, c = n & 255; return (c >> 7) * DFF + pn * 128 + (c & 127); }
    if (mode == 2) { if (n < 2048) { const int pn = n >> 8, c = n & 255; return 1024 + (c >> 7) * 1024 + pn * 128 + (c & 127); } return n - 2048; }
    return n;
}
__device__ __forceinline__ void convert_matrix(LAS unsigned char* lds, const float* __restrict__ W, bf16_t* __restrict__ Wt, int K, int Nsrc, int Ndst, int Nvalid, int mode, int G, int bid) {
    LAS bf16_t* tile = (LAS bf16_t*)lds;
    int tid_ = threadIdx.x; asm volatile("" : "+v"(tid_)); const int tid = tid_, ntn = Ndst >> 6, ntk = K >> 8, ntot = ntn * ntk;
    for (int t = bid; t < ntot; t += G) {
        const int tn = t % ntn, tk = t / ntn, n0 = tn * 64, k0 = tk * 256, sc0 = srccol(mode, n0);
        const int kk = tid >> 3, cc = (tid & 7) * 8;
        float4 v0[4], v1[4];
        const bool ok = n0 + cc < Nvalid;
#pragma unroll
        for (int q = 0; q < 4; ++q) {
            v0[q] = make_float4(0.f, 0.f, 0.f, 0.f); v1[q] = v0[q];
            if (ok) { const float* s = W + (size_t)(k0 + q * 64 + kk) * Nsrc + sc0 + cc; v0[q] = *(const float4*)s; v1[q] = *(const float4*)(s + 4); }
        }
        __builtin_amdgcn_sched_barrier(0);
#pragma unroll
        for (int q = 0; q < 4; ++q) {
            LAS bf16_t* tp = tile + cc * 264 + q * 64 + kk;
            tp[0] = f2bf(v0[q].x); tp[264] = f2bf(v0[q].y); tp[528] = f2bf(v0[q].z); tp[792] = f2bf(v0[q].w);
            tp[1056] = f2bf(v1[q].x); tp[1320] = f2bf(v1[q].y); tp[1584] = f2bf(v1[q].z); tp[1848] = f2bf(v1[q].w);
        }
        __syncthreads();
#pragma unroll
        for (int i = 0; i < 4; ++i) {
            const int id = tid + i * NTHR, nl = id >> 5, kc = (id & 31) * 8;
            const u32x4 w = *(const LAS u32x4*)(tile + nl * 264 + kc);
            *(u32x4*)(Wt + (size_t)(n0 + nl) * K + k0 + kc) = w;
        }
        __syncthreads();
    }
}
__device__ __forceinline__ void convert_layer(LAS unsigned char* lds, const Params& p, int l, int G, int bid) {
    bf16_t* WT = (bf16_t*)(p.ws + OFF_WT);
    convert_matrix(lds, p.in[6] + (size_t)l * D * 2 * DFF, WT + W_1IN, D, 2 * DFF, 2 * DFF, 2 * DFF, 1, G, bid);
    convert_matrix(lds, p.in[7] + (size_t)l * DFF * D, WT + W_1OUT, DFF, D, D, D, 0, G, bid);
    convert_matrix(lds, p.in[8] + (size_t)l * D * 2 * DFF, WT + W_2IN, D, 2 * DFF, 2 * DFF, 2 * DFF, 1, G, bid);
    convert_matrix(lds, p.in[9] + (size_t)l * DFF * D, WT + W_2OUT, DFF, D, D, D, 0, G, bid);
    const int mixer = l % 3, j = l / 3;
    if (mixer == 0) {
        convert_matrix(lds, p.in[10] + (size_t)j * D * GLA_N, WT + W_MIN, D, GLA_N, GLA_NP, GLA_N, 0, G, bid);
        convert_matrix(lds, p.in[14] + (size_t)j * D * D, WT + W_MOUT, D, D, D, D, 0, G, bid);
    } else if (mixer == 1) {
        convert_matrix(lds, p.in[15] + (size_t)j * D * 4096, WT + W_MIN, D, 4096, 4096, 4096, 0, G, bid);
        convert_matrix(lds, p.in[20] + (size_t)j * 2048 * D, WT + W_MOUT, 2048, D, D, D, 0, G, bid);
    } else {
        convert_matrix(lds, p.in[21] + (size_t)j * D * 3072, WT + W_MIN, D, 3072, 3072, 3072, 2, G, bid);
        convert_matrix(lds, p.in[23] + (size_t)j * D * D, WT + W_MOUT, D, D, D, D, 0, G, bid);
    }
}

__device__ __forceinline__ void init_phase(const Params& p, int G, int bid) {
    float* X = p.out + O_Y; bf16_t* XB = (bf16_t*)(p.ws + OFF_XB);
    const size_t n4 = (size_t)MT * D / 4, np4 = (size_t)MP * D / 4;
    int tid_ = threadIdx.x; asm volatile("" : "+v"(tid_));
    for (size_t i = (size_t)bid * NTHR + tid_; i < n4; i += (size_t)G * NTHR) {
        const float4 v = (i < np4) ? ((const float4*)p.in[0])[i] : ((const float4*)p.in[1])[i - np4];
        ((float4*)X)[i] = v;
        u32x2 w; w.x = pk2(v.x, v.y); w.y = pk2(v.z, v.w);
        ((u32x2*)XB)[i] = w;
    }
}

__device__ __forceinline__ void ln_row(float* xr, bf16_t* xb, const float4 (&v)[4], const float4 (&gv)[4], const float4 (&bv)[4], int lane) {
    float s = 0.f;
#pragma unroll
    for (int i = 0; i < 4; ++i) s += (v[i].x + v[i].y) + (v[i].z + v[i].w);
#pragma unroll
    for (int o = 32; o >= 1; o >>= 1) s += __shfl_xor(s, o);
    const float mean = s * (1.0f / D);
    float q = 0.f;
#pragma unroll
    for (int i = 0; i < 4; ++i) { const float a = v[i].x - mean, b2 = v[i].y - mean, c = v[i].z - mean, d = v[i].w - mean; q += (a * a + b2 * b2) + (c * c + d * d); }
#pragma unroll
    for (int o = 32; o >= 1; o >>= 1) q += __shfl_xor(q, o);
    const float rstd = 1.0f / sqrtf(q * (1.0f / D) + LN_EPS);
#pragma unroll
    for (int i = 0; i < 4; ++i) {
        float4 y;
        y.x = (v[i].x - mean) * rstd * gv[i].x + bv[i].x; y.y = (v[i].y - mean) * rstd * gv[i].y + bv[i].y;
        y.z = (v[i].z - mean) * rstd * gv[i].z + bv[i].z; y.w = (v[i].w - mean) * rstd * gv[i].w + bv[i].w;
        *(float4*)(xr + (i * 64 + lane) * 4) = y;
        u32x2 w; w.x = pk2(y.x, y.y); w.y = pk2(y.z, y.w);
        *(u32x2*)(xb + (i * 64 + lane) * 4) = w;
    }
}
__device__ __forceinline__ void ln_phase(float* X, bf16_t* XB, const float* __restrict__ g, const float* __restrict__ b, int G, int bid) {
    int tid_ = threadIdx.x; asm volatile("" : "+v"(tid_)); const int tid = tid_, wid = tid >> 6, lane = tid & 63;
    float4 gv[4], bv[4];
#pragma unroll
    for (int i = 0; i < 4; ++i) { gv[i] = *(const float4*)(g + (i * 64 + lane) * 4); bv[i] = *(const float4*)(b + (i * 64 + lane) * 4); }
    for (int row = bid * 8 + wid; row < MT; row += 2 * G * 8) {
        const int rowB = row + G * 8; const bool hasB = rowB < MT; const int rb = hasB ? rowB : row;
        float* xr = X + (size_t)row * D; float* xrb = X + (size_t)rb * D;
        float4 va[4], vb[4];
#pragma unroll
        for (int i = 0; i < 4; ++i) { va[i] = *(const float4*)(xr + (i * 64 + lane) * 4); vb[i] = *(const float4*)(xrb + (i * 64 + lane) * 4); }
        __builtin_amdgcn_sched_barrier(0);
        ln_row(xr, XB + (size_t)row * D, va, gv, bv, lane);
        if (hasB) ln_row(xrb, XB + (size_t)rb * D, vb, gv, bv, lane);
    }
}

__device__ __forceinline__ void unpack8(const u32x4 w, float (&f)[8]) { f[0] = bflo(w.x); f[1] = bfhi(w.x); f[2] = bflo(w.y); f[3] = bfhi(w.y); f[4] = bflo(w.z); f[5] = bfhi(w.z); f[6] = bflo(w.w); f[7] = bfhi(w.w); }
__device__ __forceinline__ void conv_phase(const Params& p, int j, int G, int bid) {
    const bf16_t* CIN = (const bf16_t*)(p.ws + OFF_BIG); bf16_t* BG = (bf16_t*)(p.ws + OFF_BIG + (size_t)MT * D * 2);
    const float* wc = p.in[22] + (size_t)j * 3 * D; const float* st = p.in[3] + (size_t)j * 8 * 2 * D;
    float* outp = p.out + O_CONVP + (size_t)j * 2 * D; float* outs = p.out + O_CONVS + (size_t)j * 8 * 2 * D;
    const int total = MT * 128;
    int tid_ = threadIdx.x; asm volatile("" : "+v"(tid_));
    for (int idx = bid * NTHR + tid_; idx < total; idx += G * NTHR) {
        const int r = idx >> 7, c8 = (idx & 127) * 8;
        const bool samp = r >= MP; const int t = samp ? ((r - MP) & 31) : r, b = samp ? ((r - MP) >> 5) : 0, T = samp ? 32 : MP;
        float c0[8], c1[8], c2[8], bg[8];
        unpack8(*(const u32x4*)(CIN + (size_t)r * D + c8), c0);
        if (t >= 1) unpack8(*(const u32x4*)(CIN + (size_t)(r - 1) * D + c8), c1);
        else if (samp) { const float4 a = *(const float4*)(st + (size_t)(b * 2 + 1) * D + c8), a2 = *(const float4*)(st + (size_t)(b * 2 + 1) * D + c8 + 4); c1[0] = a.x; c1[1] = a.y; c1[2] = a.z; c1[3] = a.w; c1[4] = a2.x; c1[5] = a2.y; c1[6] = a2.z; c1[7] = a2.w; }
        else { for (int i = 0; i < 8; ++i) c1[i] = 0.f; }
        if (t >= 2) unpack8(*(const u32x4*)(CIN + (size_t)(r - 2) * D + c8), c2);
        else if (samp) { const float4 a = *(const float4*)(st + (size_t)(b * 2 + t) * D + c8), a2 = *(const float4*)(st + (size_t)(b * 2 + t) * D + c8 + 4); c2[0] = a.x; c2[1] = a.y; c2[2] = a.z; c2[3] = a.w; c2[4] = a2.x; c2[5] = a2.y; c2[6] = a2.z; c2[7] = a2.w; }
        else { for (int i = 0; i < 8; ++i) c2[i] = 0.f; }
        unpack8(*(const u32x4*)(BG + (size_t)r * D + c8), bg);
        float z[8];
#pragma unroll
        for (int i = 0; i < 8; ++i) z[i] = bg[i] * (wc[c8 + i] * c2[i] + wc[D + c8 + i] * c1[i] + wc[2 * D + c8 + i] * c0[i]);
        u32x4 w; w.x = pk2(z[0], z[1]); w.y = pk2(z[2], z[3]); w.z = pk2(z[4], z[5]); w.w = pk2(z[6], z[7]);
        *(u32x4*)(BG + (size_t)r * D + c8) = w;
        if (t >= T - 2) {
            float* o = (samp ? outs + (size_t)(b * 2 + (t - (T - 2))) * D : outp + (size_t)(t - (T - 2)) * D) + c8;
            *(float4*)o = make_float4(c0[0], c0[1], c0[2], c0[3]); *(float4*)(o + 4) = make_float4(c0[4], c0[5], c0[6], c0[7]);
        }
    }
}

__device__ __forceinline__ void gla_item(int slot, int& row0, int& len, int& h) { h = slot & 3; if (slot < 1024) { row0 = (slot >> 2) * 64; len = 64; } else { row0 = MP + ((slot - 1024) >> 2) * 32; len = 32; } }
__device__ __forceinline__ f32x4 mfma16(const bf16x8 a, const bf16x8 b, const f32x4 c) { return __builtin_amdgcn_mfma_f32_16x16x32_bf16(a, b, c, 0, 0, 0); }

__device__ __forceinline__ void gla_g1(LAS unsigned char* lds, const Params& p, int j, int G, int bid) {
    const bf16_t* P = (const bf16_t*)(p.ws + OFF_P); float* SB = (float*)(p.ws + OFF_SB); float* BB = (float*)(p.ws + OFF_BB); float* DK = (float*)(p.ws + OFF_DK);
    const float* wgk = p.in[11] + (size_t)j * 16 * 512; const float* bgk = p.in[12] + (size_t)j * 512;
    LAS float* gls = (LAS float*)lds;
    LAS float* wg = (LAS float*)(lds + 4096);
    LAS float* tot = (LAS float*)(lds + 12288);
    LAS bf16_t* khT = (LAS bf16_t*)(lds + 16384);
    LAS bf16_t* vT = (LAS bf16_t*)(lds + 34816);
    int tid_ = threadIdx.x; asm volatile("" : "+v"(tid_)); const int tid = tid_, wid = tid >> 6, lane = tid & 63, fr = lane & 15, fq = lane >> 4;
    const int kd = tid & 127, q4 = tid >> 7, vdv = tid & 255, hv = tid >> 8;
    for (int slot = bid; slot < NSLOT; slot += G) {
        int row0, len, h; gla_item(slot, row0, len, h);
        const bf16_t* Pr = P + (size_t)row0 * GLA_NP;
        float kf[16];
#pragma unroll
        for (int i = 0; i < 16; ++i) { const unsigned tt = 16u * q4 + i, tc = tt < (unsigned)len ? tt : 0u; const float kx = bf2f(Pr[tc * (unsigned)GLA_NP + 512u + h * 128 + kd]); kf[i] = tt < (unsigned)len ? kx : 0.f; }
        for (int idx = tid; idx < 1024; idx += NTHR) { const int t = idx >> 4, r = idx & 15; gls[idx] = t < len ? bf2f(Pr[(size_t)t * GLA_NP + 3072 + r]) : 0.f; }
        for (int idx = tid; idx < 2048; idx += NTHR) { const int r = idx >> 7, c = idx & 127; wg[idx] = wgk[r * 512 + h * 128 + c]; }
        __syncthreads();
        float bl[16];
        {
            float wr_[16];
#pragma unroll
            for (int r = 0; r < 16; ++r) wr_[r] = wg[r * 128 + kd];
            const float bias = bgk[h * 128 + kd]; float run = 0.f;
#pragma unroll
            for (int i = 0; i < 16; ++i) {
                const int t = 16 * q4 + i; float z = bias;
#pragma unroll
                for (int r = 0; r < 16; ++r) z += gls[t * 16 + r] * wr_[r];
                run += t < len ? logsigmoid_f(z) * (1.0f / 16.0f) : 0.f; bl[i] = run;
            }
            tot[q4 * 128 + kd] = run;
        }
        __syncthreads();
        {
            const float t0 = tot[kd], t1 = tot[128 + kd], t2 = tot[256 + kd], t3 = tot[384 + kd];
            const float off = (q4 > 0 ? t0 : 0.f) + (q4 > 1 ? t1 : 0.f) + (q4 > 2 ? t2 : 0.f), blast = (t0 + t1) + (t2 + t3);
            if (q4 == 0) DK[(size_t)slot * 128 + kd] = expf(blast);
            float kh[16];
#pragma unroll
            for (int i = 0; i < 16; ++i) {
                const int t = 16 * q4 + i; const float bt = off + bl[i];
                if (t < len) BB[(size_t)(row0 + t) * 512 + h * 128 + kd] = bt;
                kh[i] = kf[i] * expf(blast - bt);
            }
            u32x4 w0, w1;
            w0.x = pk2(kh[0], kh[1]); w0.y = pk2(kh[2], kh[3]); w0.z = pk2(kh[4], kh[5]); w0.w = pk2(kh[6], kh[7]);
            w1.x = pk2(kh[8], kh[9]); w1.y = pk2(kh[10], kh[11]); w1.z = pk2(kh[12], kh[13]); w1.w = pk2(kh[14], kh[15]);
            *(LAS u32x4*)(khT + kd * 72 + 16 * q4) = w0; *(LAS u32x4*)(khT + kd * 72 + 16 * q4 + 8) = w1;
        }
        {
            const bf16_t* vb = Pr + 1024 + h * 256;
#pragma nounroll
            for (int bt = 0; bt < 2; ++bt) {
                const unsigned tb = 32u * hv + 16u * bt; unsigned vr[8];
#pragma unroll
                for (int i = 0; i < 8; ++i) {
                    const unsigned ta = tb + 2u * i, ca = ta < (unsigned)len ? ta : 0u, cb = ta + 1u < (unsigned)len ? ta + 1u : 0u;
                    const unsigned lo = vb[ca * (unsigned)GLA_NP + vdv], hi = vb[cb * (unsigned)GLA_NP + vdv];
                    vr[i] = (ta < (unsigned)len ? lo : 0u) | ((ta + 1u < (unsigned)len ? hi : 0u) << 16);
                }
                u32x4 w0, w1; w0.x = vr[0]; w0.y = vr[1]; w0.z = vr[2]; w0.w = vr[3]; w1.x = vr[4]; w1.y = vr[5]; w1.z = vr[6]; w1.w = vr[7];
                *(LAS u32x4*)(vT + vdv * 72 + tb) = w0; *(LAS u32x4*)(vT + vdv * 72 + tb + 8) = w1;
            }
        }
        __syncthreads();
        f32x4 acc[2][8];
#pragma unroll
        for (int r = 0; r < 2; ++r)
#pragma unroll
            for (int c = 0; c < 8; ++c) acc[r][c] = (f32x4){0.f, 0.f, 0.f, 0.f};
#pragma unroll
        for (int ks = 0; ks < 2; ++ks) {
            bf16x8 a[2];
#pragma unroll
            for (int r = 0; r < 2; ++r) a[r] = *(const LAS bf16x8*)(vT + ((wid * 2 + r) * 16 + fr) * 72 + ks * 32 + fq * 8);
#pragma unroll
            for (int c = 0; c < 8; ++c) {
                const bf16x8 bfr = *(const LAS bf16x8*)(khT + (c * 16 + fr) * 72 + ks * 32 + fq * 8);
#pragma unroll
                for (int r = 0; r < 2; ++r) acc[r][c] = mfma16(a[r], bfr, acc[r][c]);
            }
        }
        float* sb = SB + (size_t)slot * 32768 + (unsigned)((wid * 32 + fq * 4) * 128 + fr);
#pragma unroll
        for (int r = 0; r < 2; ++r) {
            float* sbr = sb + r * 2048; asm volatile("" : "+v"(sbr));
#pragma unroll
            for (int c = 0; c < 8; ++c)
#pragma unroll
                for (int jj = 0; jj < 4; ++jj) sbr[jj * 128 + c * 16] = acc[r][c][jj];
        }
        __syncthreads();
    }
}

__device__ __forceinline__ void gla_g2(const Params& p, int j, int G, int bid) {
    float* SB = (float*)(p.ws + OFF_SB); const float* DK = (const float*)(p.ws + OFF_DK);
    int tid_ = threadIdx.x; asm volatile("" : "+v"(tid_));
    for (int e = bid * NTHR + tid_; e < 131072; e += G * NTHR) {
        const int h = e >> 15, vd = (e >> 7) & 255, kd = e & 127;
        float* ps = SB + (size_t)h * 32768 + vd * 128 + kd; const float* pd = DK + h * 128 + kd;
        float S = 0.f;
        for (int c0 = 0; c0 < 256; c0 += 8) {
            float ds[8], dd[8];
#pragma unroll
            for (int i = 0; i < 8; ++i) { ds[i] = ps[(size_t)(c0 + i) * 131072]; dd[i] = pd[(c0 + i) * 512]; }
#pragma unroll
            for (int i = 0; i < 8; ++i) { ps[(size_t)(c0 + i) * 131072] = S; S = dd[i] * S + ds[i]; }
        }
        p.out[O_GLAP + (size_t)j * 131072 + h * 32768 + kd * 256 + vd] = S;
    }
    const float* st = p.in[2] + (size_t)j * 8 * 131072;
    for (int e = bid * NTHR + tid_; e < 8 * 131072; e += G * NTHR) {
        const int b = e >> 17, h = (e >> 15) & 3, vd = (e >> 7) & 255, kd = e & 127, slot = 1024 + b * 4 + h;
        float* ps = SB + (size_t)slot * 32768 + vd * 128 + kd;
        const size_t so = (size_t)(b * 4 + h) * 32768 + kd * 256 + vd;
        const float S0 = st[so], ds = *ps, dd = DK[slot * 128 + kd];
        *ps = S0;
        p.out[O_GLAS + (size_t)j * 8 * 131072 + so] = dd * S0 + ds;
    }
}

__device__ __forceinline__ void gla_g3(LAS unsigned char* lds, const Params& p, int j, int G, int bid) {
    const bf16_t* P = (const bf16_t*)(p.ws + OFF_P); const float* SB = (const float*)(p.ws + OFF_SB); const float* BB = (const float*)(p.ws + OFF_BB);
    bf16_t* AB = (bf16_t*)(p.ws + OFF_AB); const float* gn = p.in[13] + (size_t)j * 256;
    LAS bf16_t* qt = (LAS bf16_t*)lds;
    LAS bf16_t* kt = (LAS bf16_t*)(lds + 17408);
    LAS bf16_t* sc = (LAS bf16_t*)(lds + 34816);
    LAS bf16_t* vT = (LAS bf16_t*)(lds + 44032);
    LAS float* part = (LAS float*)(lds + 80896);
    LAS bf16_t* rl = (LAS bf16_t*)(lds + 82944);
    int tid_ = threadIdx.x; asm volatile("" : "+v"(tid_)); const int tid = tid_, wid = tid >> 6, lane = tid & 63, fr = lane & 15, fq = lane >> 4;
    const int kd = tid & 127, q4 = tid >> 7, vdv = tid & 255, hv = tid >> 8;
    for (int slot = bid; slot < NSLOT; slot += G) {
        int row0, len, h; gla_item(slot, row0, len, h);
        const bf16_t* Pr = P + (size_t)row0 * GLA_NP;
        {
            float btv[16]; unsigned short qr[16], kr[16];
#pragma unroll
            for (int i = 0; i < 16; ++i) {
                const unsigned t = 16u * q4 + i, tc = t < (unsigned)len ? t : 0u; const unsigned po = tc * (unsigned)GLA_NP + h * 128 + kd;
                btv[i] = BB[(size_t)row0 * 512 + tc * 512u + h * 128 + kd]; qr[i] = Pr[po]; kr[i] = Pr[po + 512u];
            }
            __builtin_amdgcn_sched_barrier(0);
#pragma unroll
            for (int i = 0; i < 16; ++i) {
                const unsigned t = 16u * q4 + i; const bool ok = t < (unsigned)len;
                const float qv = bf2f(qr[i]) * 0.08838834764831845f * __expf(btv[i]), kv = bf2f(kr[i]) * __expf(-btv[i]);
                qt[t * 136 + kd] = f2bf(ok ? qv : 0.f); kt[t * 136 + kd] = f2bf(ok ? kv : 0.f);
            }
        }
        {
            const bf16_t* vb = Pr + 1024 + h * 256;
#pragma nounroll
            for (int bt = 0; bt < 2; ++bt) {
                const unsigned tb = 32u * hv + 16u * bt; unsigned vr[8];
#pragma unroll
                for (int i = 0; i < 8; ++i) {
                    const unsigned ta = tb + 2u * i, ca = ta < (unsigned)len ? ta : 0u, cb = ta + 1u < (unsigned)len ? ta + 1u : 0u;
                    const bf16_t* pa = vb + ca * (unsigned)GLA_NP + vdv; const bf16_t* pb = vb + cb * (unsigned)GLA_NP + vdv;
                    const unsigned lo = pa[0], hi = pb[0];
                    rl[ta * 264 + vdv] = pa[1024]; rl[(ta + 1u) * 264 + vdv] = pb[1024];
                    vr[i] = (ta < (unsigned)len ? lo : 0u) | ((ta + 1u < (unsigned)len ? hi : 0u) << 16);
                }
                u32x4 w0, w1; w0.x = vr[0]; w0.y = vr[1]; w0.z = vr[2]; w0.w = vr[3]; w1.x = vr[4]; w1.y = vr[5]; w1.z = vr[6]; w1.w = vr[7];
                *(LAS u32x4*)(vT + vdv * 72 + tb) = w0; *(LAS u32x4*)(vT + vdv * 72 + tb + 8) = w1;
            }
        }
        __syncthreads();
        const float* sp = SB + (size_t)slot * 32768 + (size_t)(wid * 32 + fr) * 128 + fq * 8;
        float4 spf[2][4][2];
#pragma unroll
        for (int c = 0; c < 2; ++c)
#pragma unroll
            for (int ks = 0; ks < 4; ++ks) { spf[c][ks][0] = *(const float4*)(sp + c * 2048 + ks * 32); spf[c][ks][1] = *(const float4*)(sp + c * 2048 + ks * 32 + 4); }
#pragma unroll
        for (int i = 0; i < 2; ++i) {
            const int ti = wid * 2 + i, rt = ti >> 2, ct = ti & 3;
            f32x4 a4 = (f32x4){0.f, 0.f, 0.f, 0.f};
            if (ct <= rt) {
#pragma unroll
                for (int ks = 0; ks < 4; ++ks) {
                    const bf16x8 a = *(const LAS bf16x8*)(qt + (rt * 16 + fr) * 136 + ks * 32 + fq * 8);
                    const bf16x8 b = *(const LAS bf16x8*)(kt + (ct * 16 + fr) * 136 + ks * 32 + fq * 8);
                    a4 = mfma16(a, b, a4);
                }
            }
#pragma unroll
            for (int jj = 0; jj < 4; ++jj) { const int t = rt * 16 + fq * 4 + jj, s = ct * 16 + fr; sc[t * 72 + s] = f2bf(s <= t ? a4[jj] : 0.f); }
        }
        __syncthreads();
        f32x4 acc[4][2];
#pragma unroll
        for (int r = 0; r < 4; ++r)
#pragma unroll
            for (int c = 0; c < 2; ++c) acc[r][c] = (f32x4){0.f, 0.f, 0.f, 0.f};
#pragma unroll
        for (int ks = 0; ks < 2; ++ks) {
            bf16x8 b[2];
#pragma unroll
            for (int c = 0; c < 2; ++c) b[c] = *(const LAS bf16x8*)(vT + (wid * 32 + c * 16 + fr) * 72 + ks * 32 + fq * 8);
#pragma unroll
            for (int r = 0; r < 4; ++r) {
                const bf16x8 a = *(const LAS bf16x8*)(sc + (r * 16 + fr) * 72 + ks * 32 + fq * 8);
#pragma unroll
                for (int c = 0; c < 2; ++c) acc[r][c] = mfma16(a, b[c], acc[r][c]);
            }
        }
#pragma unroll
        for (int ks = 0; ks < 4; ++ks) {
            bf16x8 b[2];
#pragma unroll
            for (int c = 0; c < 2; ++c) {
                const float4 x0 = spf[c][ks][0], x1 = spf[c][ks][1];
                u32x4 w; w.x = pk2(x0.x, x0.y); w.y = pk2(x0.z, x0.w); w.z = pk2(x1.x, x1.y); w.w = pk2(x1.z, x1.w);
                b[c] = __builtin_bit_cast(bf16x8, w);
            }
#pragma unroll
            for (int r = 0; r < 4; ++r) {
                const bf16x8 a = *(const LAS bf16x8*)(qt + (r * 16 + fr) * 136 + ks * 32 + fq * 8);
#pragma unroll
                for (int c = 0; c < 2; ++c) acc[r][c] = mfma16(a, b[c], acc[r][c]);
            }
        }
#pragma unroll
        for (int r = 0; r < 4; ++r)
#pragma unroll
            for (int jj = 0; jj < 4; ++jj) {
                float ss = acc[r][0][jj] * acc[r][0][jj] + acc[r][1][jj] * acc[r][1][jj];
                ss += __shfl_xor(ss, 1); ss += __shfl_xor(ss, 2); ss += __shfl_xor(ss, 4); ss += __shfl_xor(ss, 8);
                if (fr == 0) part[(r * 16 + fq * 4 + jj) * 8 + wid] = ss;
            }
        __syncthreads();
        const float gn0 = gn[wid * 32 + fr], gn1 = gn[wid * 32 + 16 + fr];
#pragma unroll
        for (int r = 0; r < 4; ++r)
#pragma unroll
            for (int jj = 0; jj < 4; ++jj) {
                const int t = r * 16 + fq * 4 + jj;
                const f32x4 p0 = *(const LAS f32x4*)(part + t * 8), p1 = *(const LAS f32x4*)(part + t * 8 + 4);
                const float tot = ((p0[0] + p0[1]) + (p0[2] + p0[3])) + ((p1[0] + p1[1]) + (p1[2] + p1[3]));
                const float rinv = 1.0f / sqrtf(tot * (1.0f / 256.0f) + LN_EPS);
                LAS bf16_t* ro = rl + t * 264 + wid * 32 + fr;
                ro[0] = f2bf(acc[r][0][jj] * rinv * gn0 * silu_f(bf2f(ro[0])));
                ro[16] = f2bf(acc[r][1][jj] * rinv * gn1 * silu_f(bf2f(ro[16])));
            }
        __syncthreads();
        for (int idx = tid; idx < len * 32; idx += NTHR) {
            const int t = idx >> 5, c16 = idx & 31;
            *(u32x4*)(AB + (size_t)(row0 + t) * D + h * 256 + c16 * 8) = *(const LAS u32x4*)(rl + t * 264 + c16 * 8);
        }
        __syncthreads();
    }
}

constexpr size_t OFF_VSTAT = OFF_BIG + (size_t)MT * 4096 * 2;
__device__ __forceinline__ void sg_phase(LAS unsigned char* lds, const Params& p, int j, int G, int bid) {
    bf16_t* U = (bf16_t*)(p.ws + OFF_BIG); const bf16_t* V = (const bf16_t*)(p.ws + OFF_BIG + (size_t)MT * 2048 * 2);
    const float* VS = (const float*)(p.ws + OFF_VSTAT);
    const float* lg = p.in[16] + (size_t)j * 2048; const float* lb = p.in[17] + (size_t)j * 2048;
    const float* wsp = p.in[18] + (size_t)j * 8 * 128 * 128; const float* bsp = p.in[19] + (size_t)j * 8 * 128;
    float* sgv = p.out + O_SGV + (size_t)j * 8 * 32 * 2048;
    LAS bf16_t* vnT = (LAS bf16_t*)lds;
    LAS bf16_t* wsA = (LAS bf16_t*)(lds + 69632);
    LAS float* stat = (LAS float*)(lds + 104448);
    LAS float* bsl = (LAS float*)(lds + 105472);
    int tid_ = threadIdx.x; asm volatile("" : "+v"(tid_)); const int tid = tid_, wid = tid >> 6, lane = tid & 63, fr = lane & 15, fq = lane >> 4;
    const int NIT = (128 + 8) * 8;
    for (int it = bid; it < NIT; it += G) {
        const int ci = it >> 3, g = it & 7; const bool samp = ci >= 128;
        const int row0 = samp ? MP + (ci - 128) * 32 : ci * 128, len = samp ? 32 : 128;
        if (tid < len) {
            const float4* sp = (const float4*)(VS + (size_t)(row0 + tid) * 64); float s = 0.f, q = 0.f;
#pragma unroll
            for (int i = 0; i < 16; ++i) { const float4 x = sp[i]; s += x.x + x.z; q += x.y + x.w; }
            const float mean = s * (1.0f / 2048.0f), var = q * (1.0f / 2048.0f) - mean * mean;
            stat[tid * 2] = mean; stat[tid * 2 + 1] = 1.0f / sqrtf(fmaxf(var, 0.f) + LN_EPS);
        }
        if (tid >= 384) bsl[tid - 384] = bsp[g * 128 + tid - 384];
        {
            const int tt = tid >> 2, s0 = (tid & 3) * 32; const float* wrow = wsp + (size_t)g * 16384 + tt * 128 + s0;
            float4 wa[4], wb[4];
#pragma unroll
            for (int i = 0; i < 4; ++i) { wa[i] = *(const float4*)(wrow + 8 * i); wb[i] = *(const float4*)(wrow + 8 * i + 4); }
            __builtin_amdgcn_sched_barrier(0);
#pragma unroll
            for (int i = 0; i < 4; ++i) {
                const float4 a = wa[i], b = wb[i]; const int sb = s0 + 8 * i;
                u32x4 w; w.x = pk2(sb + 0 <= tt ? a.x : 0.f, sb + 1 <= tt ? a.y : 0.f); w.y = pk2(sb + 2 <= tt ? a.z : 0.f, sb + 3 <= tt ? a.w : 0.f);
                w.z = pk2(sb + 4 <= tt ? b.x : 0.f, sb + 5 <= tt ? b.y : 0.f); w.w = pk2(sb + 6 <= tt ? b.z : 0.f, sb + 7 <= tt ? b.w : 0.f);
                *(LAS u32x4*)(wsA + tt * 136 + sb) = w;
            }
        }
        __syncthreads();
        {
            const int d = tid & 255, hh = tid >> 8; const float lgd = lg[g * 256 + d], lbd = lb[g * 256 + d];
            const bf16_t* vb = V + (size_t)row0 * 2048 + g * 256 + d;
#pragma nounroll
            for (int bt = 0; bt < 4; ++bt) {
                const unsigned sb = 64u * hh + 16u * bt; float vn[16];
#pragma unroll
                for (int i = 0; i < 16; ++i) {
                    const unsigned s = sb + i, sc_ = s < (unsigned)len ? s : 0u;
                    const float x = (bf2f(vb[sc_ * 2048u]) - stat[sc_ * 2]) * stat[sc_ * 2 + 1] * lgd + lbd;
                    vn[i] = s < (unsigned)len ? x : 0.f;
                }
                if (samp && sb < (unsigned)len) {
#pragma unroll
                    for (int i = 0; i < 16; ++i) sgv[(size_t)(row0 - MP + sb + i) * 2048 + g * 256 + d] = vn[i];
                }
                u32x4 w0, w1;
                w0.x = pk2(vn[0], vn[1]); w0.y = pk2(vn[2], vn[3]); w0.z = pk2(vn[4], vn[5]); w0.w = pk2(vn[6], vn[7]);
                w1.x = pk2(vn[8], vn[9]); w1.y = pk2(vn[10], vn[11]); w1.z = pk2(vn[12], vn[13]); w1.w = pk2(vn[14], vn[15]);
                *(LAS u32x4*)(vnT + d * 136 + sb) = w0; *(LAS u32x4*)(vnT + d * 136 + sb + 8) = w1;
            }
        }
        __syncthreads();
        f32x4 acc[8][2];
#pragma unroll
        for (int r = 0; r < 8; ++r)
#pragma unroll
            for (int c = 0; c < 2; ++c) acc[r][c] = (f32x4){0.f, 0.f, 0.f, 0.f};
#pragma unroll
        for (int ks = 0; ks < 4; ++ks) {
            bf16x8 b[2];
#pragma unroll
            for (int c = 0; c < 2; ++c) b[c] = *(const LAS bf16x8*)(vnT + (wid * 32 + c * 16 + fr) * 136 + ks * 32 + fq * 8);
#pragma unroll
            for (int r = 0; r < 8; ++r) {
                if (ks * 32 <= r * 16 + 15) {
                    const bf16x8 a = *(const LAS bf16x8*)(wsA + (r * 16 + fr) * 136 + ks * 32 + fq * 8);
#pragma unroll
                    for (int c = 0; c < 2; ++c) acc[r][c] = mfma16(a, b[c], acc[r][c]);
                }
            }
        }
        __syncthreads();
#pragma unroll
        for (int r = 0; r < 8; ++r)
#pragma unroll
            for (int jj = 0; jj < 4; ++jj) {
                const int t = r * 16 + fq * 4 + jj; const float bsv = bsl[t];
                LAS bf16_t* so = vnT + t * 264 + wid * 32 + fr;
                so[0] = f2bf(acc[r][0][jj] + bsv); so[16] = f2bf(acc[r][1][jj] + bsv);
            }
        __syncthreads();
        for (int idx = tid; idx < len * 32; idx += NTHR) {
            const int t = idx >> 5, c16 = idx & 31;
            bf16_t* up = U + (size_t)(row0 + t) * 2048 + g * 256 + c16 * 8;
            const u32x4 uw = *(const u32x4*)up, sw = *(const LAS u32x4*)(vnT + t * 264 + c16 * 8);
            u32x4 w; w.x = pk2(bflo(uw.x) * bflo(sw.x), bfhi(uw.x) * bfhi(sw.x)); w.y = pk2(bflo(uw.y) * bflo(sw.y), bfhi(uw.y) * bfhi(sw.y));
            w.z = pk2(bflo(uw.z) * bflo(sw.z), bfhi(uw.z) * bfhi(sw.z)); w.w = pk2(bflo(uw.w) * bflo(sw.w), bfhi(uw.w) * bfhi(sw.w));
            *(u32x4*)up = w;
        }
        __syncthreads();
    }
}

template <int K> __device__ __forceinline__ void skinny_out(LAS unsigned char* lds, const bf16_t* __restrict__ A, const bf16_t* __restrict__ Bt, float* X, float alpha, float scale, int G, int bid) {
    int tid_ = threadIdx.x; asm volatile("" : "+v"(tid_)); const int tid = tid_, wid = tid >> 6, lane = tid & 63, fr = lane & 15, fq = lane >> 4;
    LAS float* part = (LAS float*)lds;
    constexpr int KW = K / 8;
    for (int it = bid; it < 256; it += G) {
        const int rf = it >> 4, cc = it & 15;
        const bf16_t* ap = A + (size_t)(MP + rf * 16 + fr) * K + wid * KW + fq * 8;
        const bf16_t* bp = Bt + (size_t)(cc * 64 + fr) * K + wid * KW + fq * 8;
        f32x4 acc[4];
#pragma unroll
        for (int c = 0; c < 4; ++c) acc[c] = (f32x4){0.f, 0.f, 0.f, 0.f};
#pragma unroll
        for (int k0 = 0; k0 < KW; k0 += 128) {
            bf16x8 a[4], b[4][4];
#pragma unroll
            for (int s = 0; s < 4; ++s)
                if (k0 + s * 32 < KW) {
                    a[s] = *(const bf16x8*)(ap + k0 + s * 32);
#pragma unroll
                    for (int c = 0; c < 4; ++c) b[s][c] = *(const bf16x8*)(bp + (size_t)c * 16 * K + k0 + s * 32);
                }
            __builtin_amdgcn_sched_barrier(0);
#pragma unroll
            for (int s = 0; s < 4; ++s)
                if (k0 + s * 32 < KW) {
#pragma unroll
                    for (int c = 0; c < 4; ++c) acc[c] = mfma16(a[s], b[s][c], acc[c]);
                }
            __builtin_amdgcn_sched_barrier(0);
        }
#pragma unroll
        for (int c = 0; c < 4; ++c)
#pragma unroll
            for (int jj = 0; jj < 4; ++jj) part[(wid * 16 + fq * 4 + jj) * 64 + c * 16 + fr] = acc[c][jj];
        __syncthreads();
        for (int e = tid; e < 1024; e += NTHR) {
            const int r = e >> 6, c = e & 63; float s = 0.f;
#pragma unroll
            for (int w = 0; w < 8; ++w) s += part[(w * 16 + r) * 64 + c];
            float* xp = X + (size_t)(MP + rf * 16 + r) * D + cc * 64 + c;
            *xp = alpha * (*xp) + scale * s;
        }
        __syncthreads();
    }
}

#ifndef PROBE_CLASS
#define PROBE_CLASS 0
#endif
#define PB(c) { if (PROBE_CLASS && ((PROBE_MASK >> (c)) & 1)) t0_ = wall_clock64(); }
#define PE(c) { if (PROBE_CLASS && ((PROBE_MASK >> (c)) & 1)) t_acc += wall_clock64() - t0_; }
#ifndef PROBE_MASK
#define PROBE_MASK 0
#endif
#define XB_TMO      128
#define XB_XCNT(j)  (256  + 64 * (j))
#define XB_XSUB(j)  (1280 + 64 * (j))
#define XB_XGEN(j)  (2304 + 64 * (j))
#define XB_TOP      3328
#define XB_TOPGEN   3392
#define XCD_BAR_WORDS 3456
#define XB_SPIN_CAP (1u << 18)

__device__ __forceinline__ unsigned xb_ld(unsigned* p)              { return __hip_atomic_load(p, __ATOMIC_RELAXED, __HIP_MEMORY_SCOPE_AGENT); }
__device__ __forceinline__ unsigned xb_add(unsigned* p, unsigned v) { return __hip_atomic_fetch_add(p, v, __ATOMIC_RELAXED, __HIP_MEMORY_SCOPE_AGENT); }
__device__ __forceinline__ unsigned xb_xcc_id() { return (unsigned)__builtin_amdgcn_s_getreg((3 << 11) | 20) & 0xFu; }
#define XB_SPIN(cond, bar) do { unsigned _sp = 0; while (cond) { __builtin_amdgcn_s_sleep(1); \
    if ((++_sp & 255u) == 0u) { if (xb_ld(&(bar)[XB_TMO])) break; if (_sp > XB_SPIN_CAP) { atomicAdd(&(bar)[XB_TMO], 1u); break; } } } } while (0)

struct XcdBarrier {
    unsigned* bar; unsigned x;
    volatile LAS unsigned* st;
};

__device__ __forceinline__ XcdBarrier xcd_barrier_post(unsigned* bar, volatile LAS unsigned* st) {
    XcdBarrier b; b.bar = bar; b.x = xb_xcc_id(); b.st = st;
    if (threadIdx.x == 0) (void)xb_add(&bar[XB_XCNT(b.x)], 1u);
    return b;
}
__device__ __forceinline__ void xcd_barrier_complete(unsigned* bar, unsigned x, unsigned& nloc, unsigned& nx) {
    const unsigned G = gridDim.x * gridDim.y * gridDim.z;
    unsigned sum, cnt, mine, sp = 0u;
    for (;;) {
        sum = 0u; cnt = 0u; mine = 0u;
#pragma unroll
        for (unsigned j = 0; j < 16; ++j) { const unsigned c = xb_ld(&bar[XB_XCNT(j)]); sum += c; cnt += (c > 0u) ? 1u : 0u; mine = (j == x) ? c : mine; }
        if (sum == G) break;
        __builtin_amdgcn_s_sleep(1);
        if ((++sp & 255u) == 0u) { if (xb_ld(&bar[XB_TMO])) break; if (sp > XB_SPIN_CAP) { atomicAdd(&bar[XB_TMO], 1u); break; } }
    }
    nloc = mine > 0u ? mine : 1u; nx = cnt > 0u ? cnt : 1u;
}

__device__ __forceinline__ void xcd_barrier(const XcdBarrier& b) {
    asm volatile("s_waitcnt vmcnt(0)" ::: "memory");
    __syncthreads();
    if (threadIdx.x == 0) {
        unsigned* bar = b.bar;
        __builtin_amdgcn_s_waitcnt(0);
        unsigned nloc = b.st[0], nx = b.st[1];
        if (nloc == 0u) { xcd_barrier_complete(bar, b.x, nloc, nx); b.st[0] = nloc; b.st[1] = nx; }
        const unsigned old = xb_add(&bar[XB_XSUB(b.x)], 1u);
        const unsigned gen = old / nloc;
        if (old + 1u == (gen + 1u) * nloc) {
            __builtin_amdgcn_fence(__ATOMIC_RELEASE, "agent");
            asm volatile("s_waitcnt vmcnt(0)" ::: "memory");
            const unsigned og = xb_add(&bar[XB_TOP], 1u);
            const unsigned tg = og / nx;
            if (og + 1u == (tg + 1u) * nx) xb_add(&bar[XB_TOPGEN], 1u);
            else XB_SPIN(xb_ld(&bar[XB_TOPGEN]) == tg, bar);
            __builtin_amdgcn_fence(__ATOMIC_ACQUIRE, "agent");
            xb_add(&bar[XB_XGEN(b.x)], 1u);
            asm volatile("s_waitcnt vmcnt(0)" ::: "memory");
        } else {
            XB_SPIN(xb_ld(&bar[XB_XGEN(b.x)]) == gen, bar);
            __builtin_amdgcn_fence(__ATOMIC_ACQUIRE, "agent");
            asm volatile("s_waitcnt vmcnt(0)" ::: "memory");
        }
    }
    __syncthreads();
}


#define XSYNC() { if (PROBE_CLASS && ((PROBE_MASK >> 11) & 1)) { t0_ = wall_clock64(); grid.sync(); t_acc += wall_clock64() - t0_; } }
__global__ void __launch_bounds__(NTHR, 2) mega(Params p) {
    extern __shared__ __attribute__((aligned(16))) unsigned char lds_raw[];
    LAS unsigned char* lds = (LAS unsigned char*)lds_raw;
    cg::grid_group grid = cg::this_grid();
    const int G = gridDim.x, bid = blockIdx.x;
    float* X = p.out + O_Y; bf16_t* XB = (bf16_t*)(p.ws + OFF_XB); bf16_t* WT = (bf16_t*)(p.ws + OFF_WT);
    bf16_t* BIG = (bf16_t*)(p.ws + OFF_BIG);

    unsigned long long t_acc = 0, t0_ = 0;
    volatile LAS unsigned* xb_st = (volatile LAS unsigned*)(lds + 135 * 1024);
    if (threadIdx.x < 4) xb_st[threadIdx.x] = 0u;
    __syncthreads();
    const XcdBarrier xbar = xcd_barrier_post((unsigned*)(p.ws + OFF_CTR), xb_st);
#define GB() xcd_barrier(xbar)
    PB(9);
    init_phase(p, G, bid);
    convert_layer(lds, p, 0, G, bid);
    grid.sync(); XSYNC();
    PE(9);

    for (int l = 0; l < 4; ++l) {
        const int mixer = l % 3, j = l / 3;
        for (int sub = 0; sub < 3; ++sub) {
            const bf16_t* Aout; const bf16_t* Wout; int Kout; float scale;
            if (sub != 1) {
                PB(1);
                pg8::Gemm g{XB, WT + (sub == 0 ? W_1IN : W_2IN), MT, 2 * DFF, D}; pg8::StaticOrder S; S.init(MT, 2 * DFF, G, bid);
                EpiPair<1> E{BIG, DFF};
                pg8::gemm_phase<EpiPair<1>, pg8::StaticOrder>(lds, g, S, E, nullptr);
                Aout = BIG; Wout = WT + (sub == 0 ? W_1OUT : W_2OUT); Kout = DFF; scale = 0.5f;
                GB();
                PE(1);
            } else if (mixer == 0) {
                PB(1);
                { pg8::Gemm g{XB, WT + W_MIN, MT, GLA_NP, D}; pg8::StaticOrder S; S.init(MT, GLA_NP, G, bid);
                  EpiBf<0> E{(bf16_t*)(p.ws + OFF_P), GLA_NP, 0, 0};
                  pg8::gemm_phase<EpiBf<0>, pg8::StaticOrder>(lds, g, S, E, nullptr); }
                GB();
                PE(1);
                PB(4);
                gla_g1(lds, p, j, G, bid);
                GB();
                PE(4);
                PB(5);
                gla_g2(p, j, G, bid);
                GB();
                PE(5);
                PB(6);
                gla_g3(lds, p, j, G, bid);
                GB();
                PE(6);
                Aout = (const bf16_t*)(p.ws + OFF_AB); Wout = WT + W_MOUT; Kout = D; scale = 1.0f;
            } else if (mixer == 1) {
                PB(1);
                { pg8::Gemm g{XB, WT + W_MIN, MT, 4096, D}; pg8::StaticOrder S; S.init(MT, 4096, G, bid);
                  EpiBf<1> E{BIG, 2048, 2048, (size_t)MT * 2048, (float*)(p.ws + OFF_VSTAT)};
                  pg8::gemm_phase<EpiBf<1>, pg8::StaticOrder>(lds, g, S, E, nullptr); }
                GB();
                PE(1);
                PB(7);
                sg_phase(lds, p, j, G, bid);
                GB();
                PE(7);
                Aout = BIG; Wout = WT + W_MOUT; Kout = 2048; scale = 1.0f;
            } else {
                PB(1);
                { pg8::Gemm g{XB, WT + W_MIN, MT, 3072, D}; pg8::StaticOrder S; S.init(MT, 3072, G, bid);
                  EpiConv E{BIG, BIG + (size_t)MT * D};
                  pg8::gemm_phase<EpiConv, pg8::StaticOrder>(lds, g, S, E, nullptr); }
                GB();
                PE(1);
                PB(8);
                conv_phase(p, j, G, bid);
                GB();
                PE(8);
                Aout = BIG + (size_t)MT * D; Wout = WT + W_MOUT; Kout = D; scale = 1.0f;
            }
            if (sub != 1) PB(2) else PB(10)
            { pg8::Gemm g{Aout, Wout, MP, D, Kout}; pg8::StaticOrder S; S.init(MP, D, G, bid);
              EpiRes E{X, ALPHA, scale};
              pg8::gemm_phase<EpiRes, pg8::StaticOrder>(lds, g, S, E, nullptr); }
            if (Kout == DFF) skinny_out<DFF>(lds, Aout, Wout, X, ALPHA, scale, G, bid);
            else if (Kout == 2048) skinny_out<2048>(lds, Aout, Wout, X, ALPHA, scale, G, bid);
            else skinny_out<1024>(lds, Aout, Wout, X, ALPHA, scale, G, bid);
            GB();
            if (sub != 1) PE(2) else PE(10)
            PB(3);
            ln_phase(X, XB, p.in[4] + (size_t)(l * 3 + sub) * D, p.in[5] + (size_t)(l * 3 + sub) * D, G, bid);
            if (sub == 2 && l < 3) convert_layer(lds, p, l + 1, G, bid);
            if (!(sub == 2 && l == 3)) GB();
            PE(3);
        }
    }
    if (PROBE_CLASS) { __syncthreads(); if (bid == 0 && threadIdx.x == 0) X[0] += (float)t_acc * (0.01f / 256.0f); }
}

extern "C" void kernel_launch(void* const* d_in, const int* in_sizes, int n_in, void* d_out, int out_size, void* d_ws, size_t ws_size, hipStream_t stream) {
    static int grid_blocks = 0;
    if (grid_blocks == 0) {
        if (n_in != 24 || ws_size < WS_END) { fprintf(stderr, "kernel_launch: unexpected n_in %d or ws_size %zu (< %zu)\n", n_in, ws_size, (size_t)WS_END); grid_blocks = -1; return; }
        int dev = 0, cus = 0, per_cu = 0;
        hipGetDevice(&dev);
        hipDeviceGetAttribute(&cus, hipDeviceAttributeMultiprocessorCount, dev);
        if (hipFuncSetAttribute((const void*)mega, hipFuncAttributeMaxDynamicSharedMemorySize, LDS_BYTES) != hipSuccess) { fprintf(stderr, "kernel_launch: hipFuncSetAttribute failed\n"); grid_blocks = -1; return; }
        if (hipOccupancyMaxActiveBlocksPerMultiprocessor(&per_cu, (const void*)mega, NTHR, LDS_BYTES) != hipSuccess || per_cu < 1) { fprintf(stderr, "kernel_launch: occupancy query says %d\n", per_cu); per_cu = 1; }
        (void)hipGetLastError();
        grid_blocks = cus * 1;
    }
    if (grid_blocks < 0) return;
    Params p{};
    for (int i = 0; i < 24; ++i) p.in[i] = (const float*)d_in[i];
    p.out = (float*)d_out; p.ws = (unsigned char*)d_ws;
    if (hipMemsetAsync((char*)d_ws + OFF_CTR, 0, 16384, stream) != hipSuccess) { fprintf(stderr, "kernel_launch: memset of the barrier counter failed\n"); return; }
    void* args[] = {&p};
    hipError_t e = hipLaunchCooperativeKernel((const void*)mega, dim3(grid_blocks), dim3(NTHR), args, LDS_BYTES, stream);
    if (e != hipSuccess) fprintf(stderr, "cooperative launch failed: %s (grid %d)\n", hipGetErrorString(e), grid_blocks);
}
```

```cpp
#include <hip/hip_runtime.h>
#include <hip/hip_cooperative_groups.h>
#include <cstdio>
namespace cg = cooperative_groups;
namespace pg8 {
#define PG8_LAS __attribute__((address_space(3)))
typedef unsigned short bf16_t;
typedef short bf16x8 __attribute__((ext_vector_type(8)));
typedef float f32x4 __attribute__((ext_vector_type(4)));
typedef unsigned u32x4 __attribute__((ext_vector_type(4)));
constexpr int BM = 256, BK = 64, HALF = 128, HTB = HALF * BK * 2  , STAGE_BYTES = 8 * HTB, NXCD = 8, WGM = 8;

__host__ __device__ __forceinline__ int lds_byte(int r, int c) { const int st = (r >> 4) * 2 + (c >> 5), rr = r & 15, cc = c & 31, ob = rr * 64 + cc * 2; return st * 1024 + (ob ^ (((ob >> 9) & 1) << 5)); }
__host__ __device__ __forceinline__ void stage_rc(int b, int& R, int& C) { const int st = b / 1024, sb = b % 1024, swz = sb ^ (((sb >> 9) & 1) << 5); R = (st >> 1) * 16 + swz / 64; C = (st & 1) * 32 + (swz % 64) / 2; }
__host__ __device__ __forceinline__ int perm32(int rho) { const int n = rho >> 4, i = rho & 15; return 8 * (i >> 2) + 4 * n + (i & 3); }

struct Unit { int pm, pn; };
struct Gemm { const bf16_t* A; const bf16_t* Bt; int M, N, K; };

struct StaticOrder {
    int nM, nN, nwg, G, c;
    __host__ __device__ void init(int M, int N, int G_, int c_) { nM = M / BM; nN = N / BM; nwg = nM * nN; G = G_; c = c_; }
    __host__ __device__ bool next(int i, Unit& u) const {
        const long L = (long)i * G + c; if (L >= nwg) return false;
        int wgid = (int)L; { const int q = nwg / NXCD, r = nwg % NXCD, xcd = wgid % NXCD, off = wgid / NXCD; wgid = (xcd < r ? xcd * (q + 1) : r * (q + 1) + (xcd - r) * q) + off; }
        const int nig = WGM * nN, gid = wgid / nig, fm = gid * WGM, gsz = (nM - fm) < WGM ? (nM - fm) : WGM;
        u.pm = fm + ((wgid % nig) % gsz); u.pn = (wgid % nig) / gsz; return true;
    }
    __device__ __forceinline__ void a_ready(const Unit&) const {}
    __device__ __forceinline__ void done(const Unit&) const {}
};
struct CountedOrder : StaticOrder {
    const unsigned* ready; unsigned need; unsigned* tmo;
    __device__ __forceinline__ void a_ready(const Unit& u) const {
        if (threadIdx.x < 64) {
            const unsigned long long t0 = __builtin_amdgcn_s_memrealtime(); unsigned polls = 0;
            while ((unsigned)__builtin_amdgcn_readfirstlane(__hip_atomic_load(ready + 64 * u.pm, __ATOMIC_RELAXED, __HIP_MEMORY_SCOPE_AGENT)) < need) {
                if ((++polls & 255u) == 0u && __builtin_amdgcn_readfirstlane(__hip_atomic_load(tmo, __ATOMIC_RELAXED, __HIP_MEMORY_SCOPE_AGENT)) != 0u) break;
                if (__builtin_amdgcn_s_memrealtime() - t0 > 2000000ull) {
                    if (threadIdx.x == 0) { unsigned expect = 0u; __hip_atomic_compare_exchange_strong(tmo + 1, &expect, 0x600u | (unsigned)(u.pm & 0xff), __ATOMIC_RELAXED, __ATOMIC_RELAXED, __HIP_MEMORY_SCOPE_AGENT); __hip_atomic_store(tmo, 1u, __ATOMIC_RELAXED, __HIP_MEMORY_SCOPE_AGENT); }
                    break; }
                __builtin_amdgcn_s_sleep(2); }
            __builtin_amdgcn_fence(__ATOMIC_ACQUIRE, "agent");
            asm volatile("s_waitcnt vmcnt(0)" ::: "memory");
        }
#if !defined(BROKEN_HOOK_NO_BARRIER)
        asm volatile("" ::: "memory"); __builtin_amdgcn_s_barrier(); asm volatile("" ::: "memory");
#endif
    }
};

__device__ __forceinline__ unsigned cvt_pk_bf16(float lo, float hi) { unsigned r; asm volatile("v_cvt_pk_bf16_f32 %0, %1, %2" : "=v"(r) : "v"(lo), "v"(hi)); return r; }
typedef float f32x2 __attribute__((ext_vector_type(2)));
__device__ __forceinline__ f32x2 gelu_pk(f32x2 v) {
    const f32x2 av = __builtin_elementwise_abs(v), d = av * 0.2316418882f + 1.0f;
    f32x2 t; t.x = __builtin_amdgcn_rcpf(d.x); t.y = __builtin_amdgcn_rcpf(d.y);
    f32x2 q = t * 0.5307027145f + (-0.7265760135f); q = q * t + 0.7107068705f; q = q * t + (-0.142248368f); q = q * t + 0.127414796f; q = q * t;
    const f32x2 s = (v * v) * (-0.72134752044f);
    f32x2 e; e.x = __builtin_amdgcn_exp2f(s.x); e.y = __builtin_amdgcn_exp2f(s.y);
    const f32x2 m = v * (q * e), r = v - m;
    f32x2 o; o.x = v.x < 0.f ? m.x : r.x; o.y = v.y < 0.f ? m.y : r.y; return o;
}

template <class Epi, class Sched, bool STAMP = false>
__device__ __forceinline__ void gemm_phase(PG8_LAS unsigned char* lds, const Gemm g, const Sched& S, const Epi& E, unsigned long long* stamps) {
    int tid_ = threadIdx.x; asm volatile("" : "+v"(tid_)); const int tid = tid_, wid = __builtin_amdgcn_readfirstlane(tid >> 6), lane = tid & 63, wr = wid >> 2, wc = wid & 3, fr = lane & 15, fq = lane >> 4;
    const int K = g.K, nt = K / BK;
    int ts_lo = 0, ts_hi = 0, nts = 0; const unsigned long long rt_entry = STAMP ? (unsigned long long)wall_clock64() : 0ull;
#define PG8_STAMP() do { if (STAMP && wid == 0 && nts < 64) { const unsigned long long _c = (unsigned long long)clock64(); \
        ts_lo = (lane == nts) ? (int)(unsigned)_c : ts_lo; ts_hi = (lane == nts) ? (int)(unsigned)(_c >> 32) : ts_hi; ++nts; } } while (0)
    PG8_STAMP();
    unsigned voffA[2], voffB[2];
#pragma unroll
    for (int i = 0; i < 2; ++i) { int R, C; stage_rc(tid * 16 + i * 8192, R, C); const int Rb = Epi::PERM ? ((R & ~31) + perm32(R & 31)) : R;
        voffA[i] = (unsigned)(R * K + C) * 2u; voffB[i] = (unsigned)(Rb * K + C) * 2u; }
    const size_t kstep = (size_t)(BK * 2);
    const size_t hstep = (size_t)HALF * K * 2;
    const size_t tstep = 2 * hstep;
    const unsigned ldsw = (unsigned)wid * 1024u;
    const int aoff = lds_byte(wr * 64 + fr, fq * 8), boff = lds_byte(wc * 32 + fr, fq * 8);
#define PG8_SA(b, h) (((b) * 2 + (h)) * HTB)
#define PG8_SB(b, h) ((4 + (b) * 2 + (h)) * HTB)
#define PG8_STAGE(bufoff, gbase, voff) do { _Pragma("unroll") for (int _i = 0; _i < 2; ++_i) \
        __builtin_amdgcn_global_load_lds((const unsigned*)((const char*)(gbase) + (voff)[_i]), (PG8_LAS unsigned*)(lds + (bufoff) + ldsw + _i * 8192), 16, 0, 0); } while (0)
#define PG8_LDA(dst, b, h) do { _Pragma("unroll") for (int m = 0; m < 4; ++m) _Pragma("unroll") for (int k = 0; k < 2; ++k) dst[m][k] = *(const PG8_LAS bf16x8*)(lds + PG8_SA(b, h) + aoff + m * 2048 + k * 1024); } while (0)
#define PG8_LDB(dst, b, h) do { _Pragma("unroll") for (int n = 0; n < 2; ++n) _Pragma("unroll") for (int k = 0; k < 2; ++k) dst[n][k] = *(const PG8_LAS bf16x8*)(lds + PG8_SB(b, h) + boff + n * 2048 + k * 1024); } while (0)
#define PG8_MMA(ai, bj, At, Bt) do { __builtin_amdgcn_s_setprio(1); _Pragma("unroll") for (int m = 0; m < 4; ++m) _Pragma("unroll") for (int n = 0; n < 2; ++n) _Pragma("unroll") for (int k = 0; k < 2; ++k) \
        acc[ai][bj][m][n] = __builtin_amdgcn_mfma_f32_16x16x32_bf16(Bt[n][k], At[m][k], acc[ai][bj][m][n], 0, 0, 0); __builtin_amdgcn_s_setprio(0); } while (0)
#define PG8_WAIT_V(n) asm volatile("s_waitcnt vmcnt(" #n ")" ::: "memory")
#define PG8_WAIT_L(n) asm volatile("s_waitcnt lgkmcnt(" #n ")" ::: "memory")
#define PG8_BAR __builtin_amdgcn_s_barrier()
#define PG8_SCHED __builtin_amdgcn_sched_barrier(0)
    Unit cur, nxt; int ui = 0;
    if (!S.next(0, cur)) return;
    f32x4 acc[2][2][4][2];
#pragma unroll
    for (int a = 0; a < 2; ++a)
#pragma unroll
        for (int b = 0; b < 2; ++b)
#pragma unroll
            for (int m = 0; m < 4; ++m)
#pragma unroll
                for (int n = 0; n < 2; ++n) acc[a][b][m][n] = (f32x4){0.f, 0.f, 0.f, 0.f};
    bf16x8 At[4][2], B0[2][2], B1[2][2];
    const char* cA = (const char*)g.A + (size_t)cur.pm * tstep; const char* cB = (const char*)g.Bt + (size_t)cur.pn * tstep;
    S.a_ready(cur);
    PG8_STAGE(PG8_SB(0, 0), cB, voffB); PG8_STAGE(PG8_SA(0, 0), cA, voffA); PG8_STAGE(PG8_SB(0, 1), cB + hstep, voffB); PG8_STAGE(PG8_SA(0, 1), cA + hstep, voffA);
    if (wr == 1) PG8_BAR;
    PG8_WAIT_V(4); PG8_BAR;
    PG8_STAGE(PG8_SB(1, 0), cB + kstep, voffB); PG8_STAGE(PG8_SA(1, 0), cA + kstep, voffA); PG8_STAGE(PG8_SB(1, 1), cB + hstep + kstep, voffB);
    PG8_WAIT_V(6); PG8_BAR;
    PG8_STAMP();
    for (;;) {
        const bool has_next = S.next(ui + 1, nxt);
        const char* nA = has_next ? (const char*)g.A + (size_t)nxt.pm * tstep : cA; const char* nB = has_next ? (const char*)g.Bt + (size_t)nxt.pn * tstep : cB;
        for (int t = 0; t < nt; t += 2) {
            const bool last = (t == nt - 2);
            const char* a1 = cA + (size_t)(t + 1) * kstep;
            const char* a2 = last ? nA : cA + (size_t)(t + 2) * kstep; const char* b2 = last ? nB : cB + (size_t)(t + 2) * kstep;
            const char* a3 = a2 + kstep; const char* b3 = b2 + kstep;
            if (last && has_next) S.a_ready(nxt);
            PG8_LDB(B0, 0, 0); PG8_SCHED; PG8_LDA(At, 0, 0); PG8_STAGE(PG8_SA(1, 1), a1 + hstep, voffA);
            PG8_WAIT_L(8); PG8_BAR; PG8_WAIT_L(0); PG8_MMA(0, 0, At, B0); PG8_BAR; PG8_SCHED;
            PG8_LDB(B1, 0, 1); PG8_STAGE(PG8_SB(0, 0), b2, voffB);
            PG8_BAR; PG8_WAIT_L(0); PG8_MMA(0, 1, At, B1); PG8_BAR;
            PG8_LDA(At, 0, 1); PG8_STAGE(PG8_SA(0, 0), a2, voffA);
            PG8_BAR; PG8_WAIT_L(0); PG8_MMA(1, 0, At, B0); PG8_BAR; PG8_SCHED;
            PG8_STAGE(PG8_SB(0, 1), b2 + hstep, voffB);
            PG8_WAIT_V(6); PG8_BAR; PG8_MMA(1, 1, At, B1); PG8_BAR;
            PG8_LDB(B0, 1, 0); PG8_SCHED; PG8_LDA(At, 1, 0); PG8_STAGE(PG8_SA(0, 1), a2 + hstep, voffA);
            PG8_WAIT_L(8); PG8_BAR; PG8_WAIT_L(0); PG8_MMA(0, 0, At, B0); PG8_BAR; PG8_SCHED;
            PG8_LDB(B1, 1, 1); PG8_STAGE(PG8_SB(1, 0), b3, voffB);
            PG8_BAR; PG8_WAIT_L(0); PG8_MMA(0, 1, At, B1); PG8_BAR;
            PG8_LDA(At, 1, 1); PG8_STAGE(PG8_SA(1, 0), a3, voffA);
            PG8_BAR; PG8_WAIT_L(0); PG8_MMA(1, 0, At, B0); PG8_BAR; PG8_SCHED;
            PG8_STAGE(PG8_SB(1, 1), b3 + hstep, voffB);
            PG8_WAIT_V(6); PG8_BAR; PG8_MMA(1, 1, At, B1); PG8_BAR;
        }
        PG8_STAMP();
        if constexpr (!Epi::AFTER_DRAIN) { E(acc, cur, wr, wc, fr, fq); S.done(cur); }
        PG8_STAMP();
        if (!has_next) break;
#pragma unroll
        for (int a = 0; a < 2; ++a)
#pragma unroll
            for (int b = 0; b < 2; ++b)
#pragma unroll
                for (int m = 0; m < 4; ++m)
#pragma unroll
                    for (int n = 0; n < 2; ++n) acc[a][b][m][n] = (f32x4){0.f, 0.f, 0.f, 0.f};
        cur = nxt; cA = nA; cB = nB; ++ui;
    }
    PG8_WAIT_V(0);
    if (wr == 0) PG8_BAR;
    PG8_BAR;
    if constexpr (Epi::AFTER_DRAIN) { E.fused(acc, cur, wr, wc, fr, fq, lds, wid, lane); S.done(cur); }
    PG8_STAMP();
    if (STAMP && wid == 0) { stamps[lane] = lane < nts ? (((unsigned long long)(unsigned)ts_hi << 32) | (unsigned)ts_lo) : 0ull;
        if (lane == 62) stamps[62] = rt_entry; if (lane == 63) stamps[63] = (unsigned long long)wall_clock64(); }
#undef PG8_STAMP
#undef PG8_SA
#undef PG8_SB
#undef PG8_STAGE
#undef PG8_LDA
#undef PG8_LDB
#undef PG8_MMA
#undef PG8_WAIT_V
#undef PG8_WAIT_L
#undef PG8_BAR
#undef PG8_SCHED
}
}

#define LAS __attribute__((address_space(3)))
using pg8::bf16_t; using pg8::bf16x8; using pg8::f32x4; using pg8::u32x4; using pg8::Unit;
typedef unsigned u32x2 __attribute__((ext_vector_type(2)));

constexpr int D = 1024, MP = 16384, MS = 256, MT = MP + MS, DFF = 2816;
constexpr int GLA_N = 3088, GLA_NP = 3328;
constexpr float ALPHA = 1.681792830507429f, LN_EPS = 1e-5f;
constexpr int NTHR = 512;
constexpr int LDS_BYTES = 136 * 1024;

constexpr size_t WT_BYTES = 48ull << 20;
constexpr size_t OFF_WT = 0;
constexpr size_t OFF_XB = OFF_WT + WT_BYTES;
constexpr size_t OFF_BIG = OFF_XB + (size_t)MT * D * 2;
constexpr int NSLOT = 1024 + 32;
constexpr size_t OFF_P = OFF_BIG;
constexpr size_t OFF_SB = OFF_P + (size_t)MT * GLA_NP * 2;
constexpr size_t OFF_BB = OFF_SB + (size_t)NSLOT * 32768 * 4;
constexpr size_t OFF_AB = OFF_BB + (size_t)MT * 512 * 4;
constexpr size_t OFF_DK = OFF_AB + (size_t)MT * D * 2;
constexpr size_t OFF_CTR = OFF_DK + (size_t)NSLOT * 128 * 4;
constexpr size_t WS_END = OFF_CTR + 16384;
constexpr size_t W_1IN = 0, W_1OUT = 5767168, W_2IN = 8650752, W_2OUT = 14417920, W_MIN = 17301504, W_MOUT = 21495808;
constexpr size_t O_Y = 0, O_GLAP = 17039360, O_GLAS = 17301504, O_CONVP = 19398656, O_CONVS = 19400704, O_SGV = 19417088;

struct Params { const float* in[24]; float* out; unsigned char* ws; };

__device__ __forceinline__ unsigned pk2(float lo, float hi) { return pg8::cvt_pk_bf16(lo, hi); }
__device__ __forceinline__ bf16_t f2bf(float f) { return (bf16_t)(pk2(f, 0.f) & 0xffffu); }
__device__ __forceinline__ float bf2f(bf16_t b) { return __uint_as_float(((unsigned)b) << 16); }
__device__ __forceinline__ float bflo(unsigned w) { return __uint_as_float(w << 16); }
__device__ __forceinline__ float bfhi(unsigned w) { return __uint_as_float(w & 0xffff0000u); }
__device__ __forceinline__ float silu_f(float x) { return x * __builtin_amdgcn_rcpf(1.0f + __expf(-x)); }
__device__ __forceinline__ float gelu_tanh_f(float x) { const float z = 1.5957691216057308f * (x + 0.044715f * x * x * x); return x * __builtin_amdgcn_rcpf(1.0f + __expf(-z)); }
__device__ __forceinline__ float logsigmoid_f(float z) { return fminf(z, 0.f) - __logf(1.0f + __expf(-fabsf(z))); }

template <int ACT> struct EpiPair {
    static constexpr bool PERM = true, AFTER_DRAIN = false;
    bf16_t* O; int ldo;
    __device__ __forceinline__ void operator()(const f32x4 (&acc)[2][2][4][2], const Unit& u, int wr, int wc, int fr, int fq) const {
        const int row0 = u.pm * 256 + wr * 64 + fr, col0 = u.pn * 128 + wc * 32 + 8 * fq;
#pragma unroll
        for (int ai = 0; ai < 2; ++ai)
#pragma unroll
            for (int m = 0; m < 4; ++m) {
                bf16_t* rowp = O + (size_t)(row0 + ai * 128 + m * 16) * ldo + col0;
                f32x4 v0, v1;
#pragma unroll
                for (int j = 0; j < 4; ++j) {
                    const float a0 = acc[ai][0][m][0][j], a1 = acc[ai][0][m][1][j];
                    v0[j] = (ACT ? silu_f(a0) : a0) * acc[ai][1][m][0][j];
                    v1[j] = (ACT ? silu_f(a1) : a1) * acc[ai][1][m][1][j];
                }
                u32x4 w; w.x = pk2(v0[0], v0[1]); w.y = pk2(v0[2], v0[3]); w.z = pk2(v1[0], v1[1]); w.w = pk2(v1[2], v1[3]);
                *(u32x4*)rowp = w;
            }
    }
};
template <int ACT> struct EpiBf {
    static constexpr bool PERM = true, AFTER_DRAIN = false;
    bf16_t* O; int ldc; int split_cols; size_t split_stride; float* vstat = nullptr;
    __device__ __forceinline__ void operator()(const f32x4 (&acc)[2][2][4][2], const Unit& u, int wr, int wc, int fr, int fq) const {
        const int row0 = u.pm * 256 + wr * 64 + fr; int colt = u.pn * 256; bf16_t* base = O;
        if (split_cols) { const int t = colt / split_cols; base += (size_t)t * split_stride; colt -= t * split_cols; }
        const int col0 = colt + wc * 32 + 8 * fq;
#pragma unroll
        for (int ai = 0; ai < 2; ++ai)
#pragma unroll
            for (int m = 0; m < 4; ++m) {
                bf16_t* rowp = base + (size_t)(row0 + ai * 128 + m * 16) * ldc + col0;
                float ssum = 0.f, qsum = 0.f;
#pragma unroll
                for (int bj = 0; bj < 2; ++bj) {
                    f32x4 v0 = acc[ai][bj][m][0], v1 = acc[ai][bj][m][1];
                    if (ACT == 1) {
#pragma unroll
                        for (int j = 0; j < 4; ++j) { v0[j] = gelu_tanh_f(v0[j]); v1[j] = gelu_tanh_f(v1[j]); }
                    }
                    u32x4 w; w.x = pk2(v0[0], v0[1]); w.y = pk2(v0[2], v0[3]); w.z = pk2(v1[0], v1[1]); w.w = pk2(v1[2], v1[3]);
                    *(u32x4*)(rowp + bj * 128) = w;
                    if (ACT == 1) {
                        const float f0 = bflo(w.x), f1 = bfhi(w.x), f2 = bflo(w.y), f3 = bfhi(w.y), f4 = bflo(w.z), f5 = bfhi(w.z), f6 = bflo(w.w), f7 = bfhi(w.w);
                        ssum += ((f0 + f1) + (f2 + f3)) + ((f4 + f5) + (f6 + f7));
                        qsum += ((f0 * f0 + f1 * f1) + (f2 * f2 + f3 * f3)) + ((f4 * f4 + f5 * f5) + (f6 * f6 + f7 * f7));
                    }
                }
                if (ACT == 1) {
                    if (vstat != nullptr && u.pn >= 8) {
                        ssum += __shfl_xor(ssum, 16); ssum += __shfl_xor(ssum, 32); qsum += __shfl_xor(qsum, 16); qsum += __shfl_xor(qsum, 32);
                        if (fq == 0) { float* sp = vstat + ((size_t)(row0 + ai * 128 + m * 16) * 32 + (u.pn - 8) * 4 + wc) * 2; sp[0] = ssum; sp[1] = qsum; }
                    }
                }
            }
    }
};
struct EpiConv {
    static constexpr bool PERM = true, AFTER_DRAIN = false;
    bf16_t* CIN; bf16_t* BG;
    __device__ __forceinline__ void operator()(const f32x4 (&acc)[2][2][4][2], const Unit& u, int wr, int wc, int fr, int fq) const {
        if (u.pn < 8) { EpiPair<0> e{CIN, D}; e(acc, u, wr, wc, fr, fq); }
        else { EpiBf<0> e{BG, D, 0, 0}; Unit v = u; v.pn = u.pn - 8; e(acc, v, wr, wc, fr, fq); }
    }
};
struct EpiRes {
    static constexpr bool PERM = false, AFTER_DRAIN = false;
    float* X; float alpha, scale;
    __device__ __forceinline__ void operator()(const f32x4 (&acc)[2][2][4][2], const Unit& u, int wr, int wc, int fr, int fq) const {
        const int row0 = u.pm * 256 + wr * 64 + fr, col0 = u.pn * 256 + wc * 32 + 4 * fq;
#pragma unroll
        for (int ai = 0; ai < 2; ++ai) {
            float* base = X + (size_t)(row0 + ai * 128) * D + col0;
            f32x4 xv[4][2][2];
#pragma unroll
            for (int m = 0; m < 4; ++m)
#pragma unroll
                for (int bj = 0; bj < 2; ++bj)
#pragma unroll
                    for (int n = 0; n < 2; ++n) xv[m][bj][n] = *(const f32x4*)(base + m * 16 * D + bj * 128 + n * 16);
            __builtin_amdgcn_sched_barrier(0);
#pragma unroll
            for (int m = 0; m < 4; ++m)
#pragma unroll
                for (int bj = 0; bj < 2; ++bj)
#pragma unroll
                    for (int n = 0; n < 2; ++n) *(f32x4*)(base + m * 16 * D + bj * 128 + n * 16) = xv[m][bj][n] * alpha + acc[ai][bj][m][n] * scale;
            __builtin_amdgcn_sched_barrier(0);
        }
    }
};

__device__ __forceinline__ int srccol(int mode, int n) {
    if (mode == 1) { const int pn = n >> 8, c = n & 255; return (c >> 7) * DFF + pn * 128 + (c & 127); }
    if (mode == 2) { if (n < 2048) { const int pn = n >> 8, c = n & 255; return 1024 + (c >> 7) * 1024 + pn * 128 + (c & 127); } return n - 2048; }
    return n;
}
__device__ __forceinline__ void convert_matrix(LAS unsigned char* lds, const float* __restrict__ W, bf16_t* __restrict__ Wt, int K, int Nsrc, int Ndst, int Nvalid, int mode, int G, int bid) {
    LAS bf16_t* tile = (LAS bf16_t*)lds;
    int tid_ = threadIdx.x; asm volatile("" : "+v"(tid_)); const int tid = tid_, ntn = Ndst >> 6, ntk = K >> 8, ntot = ntn * ntk;
    for (int t = bid; t < ntot; t += G) {
        const int tn = t % ntn, tk = t / ntn, n0 = tn * 64, k0 = tk * 256, sc0 = srccol(mode, n0);
        const int kk = tid >> 3, cc = (tid & 7) * 8;
        float4 v0[4], v1[4];
        const bool ok = n0 + cc < Nvalid;
#pragma unroll
        for (int q = 0; q < 4; ++q) {
            v0[q] = make_float4(0.f, 0.f, 0.f, 0.f); v1[q] = v0[q];
            if (ok) { const float* s = W + (size_t)(k0 + q * 64 + kk) * Nsrc + sc0 + cc; v0[q] = *(const float4*)s; v1[q] = *(const float4*)(s + 4); }
        }
        __builtin_amdgcn_sched_barrier(0);
#pragma unroll
        for (int q = 0; q < 4; ++q) {
            LAS bf16_t* tp = tile + cc * 264 + q * 64 + kk;
            tp[0] = f2bf(v0[q].x); tp[264] = f2bf(v0[q].y); tp[528] = f2bf(v0[q].z); tp[792] = f2bf(v0[q].w);
            tp[1056] = f2bf(v1[q].x); tp[1320] = f2bf(v1[q].y); tp[1584] = f2bf(v1[q].z); tp[1848] = f2bf(v1[q].w);
        }
        __syncthreads();
#pragma unroll
        for (int i = 0; i < 4; ++i) {
            const int id = tid + i * NTHR, nl = id >> 5, kc = (id & 31) * 8;
            const u32x4 w = *(const LAS u32x4*)(tile + nl * 264 + kc);
            *(u32x4*)(Wt + (size_t)(n0 + nl) * K + k0 + kc) = w;
        }
        __syncthreads();
    }
}
__device__ __forceinline__ void convert_layer(LAS unsigned char* lds, const Params& p, int l, int G, int bid) {
    bf16_t* WT = (bf16_t*)(p.ws + OFF_WT);
    convert_matrix(lds, p.in[6] + (size_t)l * D * 2 * DFF, WT + W_1IN, D, 2 * DFF, 2 * DFF, 2 * DFF, 1, G, bid);
    convert_matrix(lds, p.in[7] + (size_t)l * DFF * D, WT + W_1OUT, DFF, D, D, D, 0, G, bid);
    convert_matrix(lds, p.in[8] + (size_t)l * D * 2 * DFF, WT + W_2IN, D, 2 * DFF, 2 * DFF, 2 * DFF, 1, G, bid);
    convert_matrix(lds, p.in[9] + (size_t)l * DFF * D, WT + W_2OUT, DFF, D, D, D, 0, G, bid);
    const int mixer = l % 3, j = l / 3;
    if (mixer == 0) {
        convert_matrix(lds, p.in[10] + (size_t)j * D * GLA_N, WT + W_MIN, D, GLA_N, GLA_NP, GLA_N, 0, G, bid);
        convert_matrix(lds, p.in[14] + (size_t)j * D * D, WT + W_MOUT, D, D, D, D, 0, G, bid);
    } else if (mixer == 1) {
        convert_matrix(lds, p.in[15] + (size_t)j * D * 4096, WT + W_MIN, D, 4096, 4096, 4096, 0, G, bid);
        convert_matrix(lds, p.in[20] + (size_t)j * 2048 * D, WT + W_MOUT, 2048, D, D, D, 0, G, bid);
    } else {
        convert_matrix(lds, p.in[21] + (size_t)j * D * 3072, WT + W_MIN, D, 3072, 3072, 3072, 2, G, bid);
        convert_matrix(lds, p.in[23] + (size_t)j * D * D, WT + W_MOUT, D, D, D, D, 0, G, bid);
    }
}

__device__ __forceinline__ void init_phase(const Params& p, int G, int bid) {
    float* X = p.out + O_Y; bf16_t* XB = (bf16_t*)(p.ws + OFF_XB);
    const size_t n4 = (size_t)MT * D / 4, np4 = (size_t)MP * D / 4;
    int tid_ = threadIdx.x; asm volatile("" : "+v"(tid_));
    for (size_t i = (size_t)bid * NTHR + tid_; i < n4; i += (size_t)G * NTHR) {
        const float4 v = (i < np4) ? ((const float4*)p.in[0])[i] : ((const float4*)p.in[1])[i - np4];
        ((float4*)X)[i] = v;
        u32x2 w; w.x = pk2(v.x, v.y); w.y = pk2(v.z, v.w);
        ((u32x2*)XB)[i] = w;
    }
}

__device__ __forceinline__ void ln_row(float* xr, bf16_t* xb, const float4 (&v)[4], const float4 (&gv)[4], const float4 (&bv)[4], int lane) {
    float s = 0.f;
#pragma unroll
    for (int i = 0; i < 4; ++i) s += (v[i].x + v[i].y) + (v[i].z + v[i].w);
#pragma unroll
    for (int o = 32; o >= 1; o >>= 1) s += __shfl_xor(s, o);
    const float mean = s * (1.0f / D);
    float q = 0.f;
#pragma unroll
    for (int i = 0; i < 4; ++i) { const float a = v[i].x - mean, b2 = v[i].y - mean, c = v[i].z - mean, d = v[i].w - mean; q += (a * a + b2 * b2) + (c * c + d * d); }
#pragma unroll
    for (int o = 32; o >= 1; o >>= 1) q += __shfl_xor(q, o);
    const float rstd = 1.0f / sqrtf(q * (1.0f / D) + LN_EPS);
#pragma unroll
    for (int i = 0; i < 4; ++i) {
        float4 y;
        y.x = (v[i].x - mean) * rstd * gv[i].x + bv[i].x; y.y = (v[i].y - mean) * rstd * gv[i].y + bv[i].y;
        y.z = (v[i].z - mean) * rstd * gv[i].z + bv[i].z; y.w = (v[i].w - mean) * rstd * gv[i].w + bv[i].w;
        *(float4*)(xr + (i * 64 + lane) * 4) = y;
        u32x2 w; w.x = pk2(y.x, y.y); w.y = pk2(y.z, y.w);
        *(u32x2*)(xb + (i * 64 + lane) * 4) = w;
    }
}
__device__ __forceinline__ void ln_phase(float* X, bf16_t* XB, const float* __restrict__ g, const float* __restrict__ b, int G, int bid) {
    int tid_ = threadIdx.x; asm volatile("" : "+v"(tid_)); const int tid = tid_, wid = tid >> 6, lane = tid & 63;
    float4 gv[4], bv[4];
#pragma unroll
    for (int i = 0; i < 4; ++i) { gv[i] = *(const float4*)(g + (i * 64 + lane) * 4); bv[i] = *(const float4*)(b + (i * 64 + lane) * 4); }
    for (int row = bid * 8 + wid; row < MT; row += 4 * G * 8) {
        int rr[4]; bool has[4]; float4 v[4][4];
#pragma unroll
        for (int k = 0; k < 4; ++k) { rr[k] = row + k * G * 8; has[k] = rr[k] < MT; if (!has[k]) rr[k] = row; }
#pragma unroll
        for (int k = 0; k < 4; ++k)
#pragma unroll
            for (int i = 0; i < 4; ++i) v[k][i] = *(const float4*)(X + (size_t)rr[k] * D + (i * 64 + lane) * 4);
        __builtin_amdgcn_sched_barrier(0);
#pragma unroll
        for (int k = 0; k < 4; ++k) if (has[k]) ln_row(X + (size_t)rr[k] * D, XB + (size_t)rr[k] * D, v[k], gv, bv, lane);
    }
}

__device__ __forceinline__ void unpack8(const u32x4 w, float (&f)[8]) { f[0] = bflo(w.x); f[1] = bfhi(w.x); f[2] = bflo(w.y); f[3] = bfhi(w.y); f[4] = bflo(w.z); f[5] = bfhi(w.z); f[6] = bflo(w.w); f[7] = bfhi(w.w); }
__device__ __forceinline__ void conv_phase(const Params& p, int j, int G, int bid) {
    const bf16_t* CIN = (const bf16_t*)(p.ws + OFF_BIG); bf16_t* BG = (bf16_t*)(p.ws + OFF_BIG + (size_t)MT * D * 2);
    const float* wc = p.in[22] + (size_t)j * 3 * D; const float* st = p.in[3] + (size_t)j * 8 * 2 * D;
    float* outp = p.out + O_CONVP + (size_t)j * 2 * D; float* outs = p.out + O_CONVS + (size_t)j * 8 * 2 * D;
    const int total = MT * 128;
    int tid_ = threadIdx.x; asm volatile("" : "+v"(tid_));
    for (int idx = bid * NTHR + tid_; idx < total; idx += G * NTHR) {
        const int r = idx >> 7, c8 = (idx & 127) * 8;
        const bool samp = r >= MP; const int t = samp ? ((r - MP) & 31) : r, b = samp ? ((r - MP) >> 5) : 0, T = samp ? 32 : MP;
        float c0[8], c1[8], c2[8], bg[8];
        unpack8(*(const u32x4*)(CIN + (size_t)r * D + c8), c0);
        if (t >= 1) unpack8(*(const u32x4*)(CIN + (size_t)(r - 1) * D + c8), c1);
        else if (samp) { const float4 a = *(const float4*)(st + (size_t)(b * 2 + 1) * D + c8), a2 = *(const float4*)(st + (size_t)(b * 2 + 1) * D + c8 + 4); c1[0] = a.x; c1[1] = a.y; c1[2] = a.z; c1[3] = a.w; c1[4] = a2.x; c1[5] = a2.y; c1[6] = a2.z; c1[7] = a2.w; }
        else { for (int i = 0; i < 8; ++i) c1[i] = 0.f; }
        if (t >= 2) unpack8(*(const u32x4*)(CIN + (size_t)(r - 2) * D + c8), c2);
        else if (samp) { const float4 a = *(const float4*)(st + (size_t)(b * 2 + t) * D + c8), a2 = *(const float4*)(st + (size_t)(b * 2 + t) * D + c8 + 4); c2[0] = a.x; c2[1] = a.y; c2[2] = a.z; c2[3] = a.w; c2[4] = a2.x; c2[5] = a2.y; c2[6] = a2.z; c2[7] = a2.w; }
        else { for (int i = 0; i < 8; ++i) c2[i] = 0.f; }
        unpack8(*(const u32x4*)(BG + (size_t)r * D + c8), bg);
        float z[8];
#pragma unroll
        for (int i = 0; i < 8; ++i) z[i] = bg[i] * (wc[c8 + i] * c2[i] + wc[D + c8 + i] * c1[i] + wc[2 * D + c8 + i] * c0[i]);
        u32x4 w; w.x = pk2(z[0], z[1]); w.y = pk2(z[2], z[3]); w.z = pk2(z[4], z[5]); w.w = pk2(z[6], z[7]);
        *(u32x4*)(BG + (size_t)r * D + c8) = w;
        if (t >= T - 2) {
            float* o = (samp ? outs + (size_t)(b * 2 + (t - (T - 2))) * D : outp + (size_t)(t - (T - 2)) * D) + c8;
            *(float4*)o = make_float4(c0[0], c0[1], c0[2], c0[3]); *(float4*)(o + 4) = make_float4(c0[4], c0[5], c0[6], c0[7]);
        }
    }
}

__device__ __forceinline__ void gla_item(int slot, int& row0, int& len, int& h) { h = slot & 3; if (slot < 1024) { row0 = (slot >> 2) * 64; len = 64; } else { row0 = MP + ((slot - 1024) >> 2) * 32; len = 32; } }
__device__ __forceinline__ f32x4 mfma16(const bf16x8 a, const bf16x8 b, const f32x4 c) { return __builtin_amdgcn_mfma_f32_16x16x32_bf16(a, b, c, 0, 0, 0); }

__device__ __forceinline__ void gla_g1(LAS unsigned char* lds, const Params& p, int j, int G, int bid) {
    const bf16_t* P = (const bf16_t*)(p.ws + OFF_P); float* SB = (float*)(p.ws + OFF_SB); float* BB = (float*)(p.ws + OFF_BB); float* DK = (float*)(p.ws + OFF_DK);
    const float* wgk = p.in[11] + (size_t)j * 16 * 512; const float* bgk = p.in[12] + (size_t)j * 512;
    LAS float* gls = (LAS float*)lds;
    LAS float* wg = (LAS float*)(lds + 4096);
    LAS float* tot = (LAS float*)(lds + 12288);
    LAS bf16_t* khT = (LAS bf16_t*)(lds + 16384);
    LAS bf16_t* vT = (LAS bf16_t*)(lds + 34816);
    int tid_ = threadIdx.x; asm volatile("" : "+v"(tid_)); const int tid = tid_, wid = tid >> 6, lane = tid & 63, fr = lane & 15, fq = lane >> 4;
    const int kd = tid & 127, q4 = tid >> 7, vdv = tid & 255, hv = tid >> 8;
    for (int slot = bid; slot < NSLOT; slot += G) {
        int row0, len, h; gla_item(slot, row0, len, h);
        const bf16_t* Pr = P + (size_t)row0 * GLA_NP;
        float kf[16];
#pragma unroll
        for (int i = 0; i < 16; ++i) { const unsigned tt = 16u * q4 + i, tc = tt < (unsigned)len ? tt : 0u; const float kx = bf2f(Pr[tc * (unsigned)GLA_NP + 512u + h * 128 + kd]); kf[i] = tt < (unsigned)len ? kx : 0.f; }
        for (int idx = tid; idx < 1024; idx += NTHR) { const int t = idx >> 4, r = idx & 15; gls[idx] = t < len ? bf2f(Pr[(size_t)t * GLA_NP + 3072 + r]) : 0.f; }
        for (int idx = tid; idx < 2048; idx += NTHR) { const int r = idx >> 7, c = idx & 127; wg[idx] = wgk[r * 512 + h * 128 + c]; }
        __syncthreads();
        float bl[16];
        {
            float wr_[16];
#pragma unroll
            for (int r = 0; r < 16; ++r) wr_[r] = wg[r * 128 + kd];
            const float bias = bgk[h * 128 + kd]; float run = 0.f;
#pragma unroll
            for (int i = 0; i < 16; ++i) {
                const int t = 16 * q4 + i; float z = bias;
#pragma unroll
                for (int r = 0; r < 16; ++r) z += gls[t * 16 + r] * wr_[r];
                run += t < len ? logsigmoid_f(z) * (1.0f / 16.0f) : 0.f; bl[i] = run;
            }
            tot[q4 * 128 + kd] = run;
        }
        __syncthreads();
        {
            const float t0 = tot[kd], t1 = tot[128 + kd], t2 = tot[256 + kd], t3 = tot[384 + kd];
            const float off = (q4 > 0 ? t0 : 0.f) + (q4 > 1 ? t1 : 0.f) + (q4 > 2 ? t2 : 0.f), blast = (t0 + t1) + (t2 + t3);
            if (q4 == 0) DK[(size_t)slot * 128 + kd] = __expf(blast);
            float kh[16];
#pragma unroll
            for (int i = 0; i < 16; ++i) {
                const int t = 16 * q4 + i; const float bt = off + bl[i];
                if (t < len) BB[(size_t)(row0 + t) * 512 + h * 128 + kd] = bt;
                kh[i] = kf[i] * __expf(blast - bt);
            }
            u32x4 w0, w1;
            w0.x = pk2(kh[0], kh[1]); w0.y = pk2(kh[2], kh[3]); w0.z = pk2(kh[4], kh[5]); w0.w = pk2(kh[6], kh[7]);
            w1.x = pk2(kh[8], kh[9]); w1.y = pk2(kh[10], kh[11]); w1.z = pk2(kh[12], kh[13]); w1.w = pk2(kh[14], kh[15]);
            *(LAS u32x4*)(khT + kd * 72 + 16 * q4) = w0; *(LAS u32x4*)(khT + kd * 72 + 16 * q4 + 8) = w1;
        }
        {
            const bf16_t* vb = Pr + 1024 + h * 256;
#pragma nounroll
            for (int bt = 0; bt < 2; ++bt) {
                const unsigned tb = 32u * hv + 16u * bt; unsigned vr[8];
#pragma unroll
                for (int i = 0; i < 8; ++i) {
                    const unsigned ta = tb + 2u * i, ca = ta < (unsigned)len ? ta : 0u, cb = ta + 1u < (unsigned)len ? ta + 1u : 0u;
                    const unsigned lo = vb[ca * (unsigned)GLA_NP + vdv], hi = vb[cb * (unsigned)GLA_NP + vdv];
                    vr[i] = (ta < (unsigned)len ? lo : 0u) | ((ta + 1u < (unsigned)len ? hi : 0u) << 16);
                }
                u32x4 w0, w1; w0.x = vr[0]; w0.y = vr[1]; w0.z = vr[2]; w0.w = vr[3]; w1.x = vr[4]; w1.y = vr[5]; w1.z = vr[6]; w1.w = vr[7];
                *(LAS u32x4*)(vT + vdv * 72 + tb) = w0; *(LAS u32x4*)(vT + vdv * 72 + tb + 8) = w1;
            }
        }
        __syncthreads();
        f32x4 acc[2][8];
#pragma unroll
        for (int r = 0; r < 2; ++r)
#pragma unroll
            for (int c = 0; c < 8; ++c) acc[r][c] = (f32x4){0.f, 0.f, 0.f, 0.f};
#pragma unroll
        for (int ks = 0; ks < 2; ++ks) {
            bf16x8 a[2];
#pragma unroll
            for (int r = 0; r < 2; ++r) a[r] = *(const LAS bf16x8*)(vT + ((wid * 2 + r) * 16 + fr) * 72 + ks * 32 + fq * 8);
#pragma unroll
            for (int c = 0; c < 8; ++c) {
                const bf16x8 bfr = *(const LAS bf16x8*)(khT + (c * 16 + fr) * 72 + ks * 32 + fq * 8);
#pragma unroll
                for (int r = 0; r < 2; ++r) acc[r][c] = mfma16(a[r], bfr, acc[r][c]);
            }
        }
        float* sb = SB + (size_t)slot * 32768 + (unsigned)((wid * 32 + fq * 4) * 128 + fr);
#pragma unroll
        for (int r = 0; r < 2; ++r) {
            float* sbr = sb + r * 2048; asm volatile("" : "+v"(sbr));
#pragma unroll
            for (int c = 0; c < 8; ++c)
#pragma unroll
                for (int jj = 0; jj < 4; ++jj) sbr[jj * 128 + c * 16] = acc[r][c][jj];
        }
        __syncthreads();
    }
}

__device__ __forceinline__ void gla_g2(const Params& p, int j, int G, int bid) {
    float* SB = (float*)(p.ws + OFF_SB); const float* DK = (const float*)(p.ws + OFF_DK);
    int tid_ = threadIdx.x; asm volatile("" : "+v"(tid_));
    for (int e = bid * NTHR + tid_; e < 131072; e += G * NTHR) {
        const int h = e >> 15, vd = (e >> 7) & 255, kd = e & 127;
        float* ps = SB + (size_t)h * 32768 + vd * 128 + kd; const float* pd = DK + h * 128 + kd;
        float S = 0.f;
        for (int c0 = 0; c0 < 256; c0 += 16) {
            float ds[16], dd[16];
#pragma unroll
            for (int i = 0; i < 16; ++i) { ds[i] = ps[(size_t)(c0 + i) * 131072]; dd[i] = pd[(c0 + i) * 512]; }
            __builtin_amdgcn_sched_barrier(0);
#pragma unroll
            for (int i = 0; i < 16; ++i) { ps[(size_t)(c0 + i) * 131072] = S; S = dd[i] * S + ds[i]; }
        }
        p.out[O_GLAP + (size_t)j * 131072 + h * 32768 + kd * 256 + vd] = S;
    }
    const float* st = p.in[2] + (size_t)j * 8 * 131072;
    for (int e = bid * NTHR + tid_; e < 8 * 131072; e += G * NTHR) {
        const int b = e >> 17, h = (e >> 15) & 3, vd = (e >> 7) & 255, kd = e & 127, slot = 1024 + b * 4 + h;
        float* ps = SB + (size_t)slot * 32768 + vd * 128 + kd;
        const size_t so = (size_t)(b * 4 + h) * 32768 + kd * 256 + vd;
        const float S0 = st[so], ds = *ps, dd = DK[slot * 128 + kd];
        *ps = S0;
        p.out[O_GLAS + (size_t)j * 8 * 131072 + so] = dd * S0 + ds;
    }
}

__device__ __forceinline__ void gla_g3(LAS unsigned char* lds, const Params& p, int j, int G, int bid) {
    const bf16_t* P = (const bf16_t*)(p.ws + OFF_P); const float* SB = (const float*)(p.ws + OFF_SB); const float* BB = (const float*)(p.ws + OFF_BB);
    bf16_t* AB = (bf16_t*)(p.ws + OFF_AB); const float* gn = p.in[13] + (size_t)j * 256;
    LAS bf16_t* qt = (LAS bf16_t*)lds;
    LAS bf16_t* kt = (LAS bf16_t*)(lds + 17408);
    LAS bf16_t* sc = (LAS bf16_t*)(lds + 34816);
    LAS bf16_t* vT = (LAS bf16_t*)(lds + 44032);
    LAS float* part = (LAS float*)(lds + 80896);
    LAS bf16_t* rl = (LAS bf16_t*)(lds + 82944);
    int tid_ = threadIdx.x; asm volatile("" : "+v"(tid_)); const int tid = tid_, wid = tid >> 6, lane = tid & 63, fr = lane & 15, fq = lane >> 4;
    const int kd = tid & 127, q4 = tid >> 7, vdv = tid & 255, hv = tid >> 8;
    for (int slot = bid; slot < NSLOT; slot += G) {
        int row0, len, h; gla_item(slot, row0, len, h);
        const bf16_t* Pr = P + (size_t)row0 * GLA_NP;
        {
            float btv[16]; unsigned short qr[16], kr[16];
#pragma unroll
            for (int i = 0; i < 16; ++i) {
                const unsigned t = 16u * q4 + i, tc = t < (unsigned)len ? t : 0u; const unsigned po = tc * (unsigned)GLA_NP + h * 128 + kd;
                btv[i] = BB[(size_t)row0 * 512 + tc * 512u + h * 128 + kd]; qr[i] = Pr[po]; kr[i] = Pr[po + 512u];
            }
            __builtin_amdgcn_sched_barrier(0);
#pragma unroll
            for (int i = 0; i < 16; ++i) {
                const unsigned t = 16u * q4 + i; const bool ok = t < (unsigned)len;
                const float qv = bf2f(qr[i]) * 0.08838834764831845f * __expf(btv[i]), kv = bf2f(kr[i]) * __expf(-btv[i]);
                qt[t * 136 + kd] = f2bf(ok ? qv : 0.f); kt[t * 136 + kd] = f2bf(ok ? kv : 0.f);
            }
        }
        {
            const bf16_t* vb = Pr + 1024 + h * 256;
#pragma nounroll
            for (int bt = 0; bt < 2; ++bt) {
                const unsigned tb = 32u * hv + 16u * bt; unsigned vr[8];
#pragma unroll
                for (int i = 0; i < 8; ++i) {
                    const unsigned ta = tb + 2u * i, ca = ta < (unsigned)len ? ta : 0u, cb = ta + 1u < (unsigned)len ? ta + 1u : 0u;
                    const bf16_t* pa = vb + ca * (unsigned)GLA_NP + vdv; const bf16_t* pb = vb + cb * (unsigned)GLA_NP + vdv;
                    const unsigned lo = pa[0], hi = pb[0];
                    rl[ta * 264 + vdv] = pa[1024]; rl[(ta + 1u) * 264 + vdv] = pb[1024];
                    vr[i] = (ta < (unsigned)len ? lo : 0u) | ((ta + 1u < (unsigned)len ? hi : 0u) << 16);
                }
                u32x4 w0, w1; w0.x = vr[0]; w0.y = vr[1]; w0.z = vr[2]; w0.w = vr[3]; w1.x = vr[4]; w1.y = vr[5]; w1.z = vr[6]; w1.w = vr[7];
                *(LAS u32x4*)(vT + vdv * 72 + tb) = w0; *(LAS u32x4*)(vT + vdv * 72 + tb + 8) = w1;
            }
        }
        __syncthreads();
        const float* sp = SB + (size_t)slot * 32768 + (size_t)(wid * 32 + fr) * 128 + fq * 8;
        float4 spf[2][4][2];
#pragma unroll
        for (int c = 0; c < 2; ++c)
#pragma unroll
            for (int ks = 0; ks < 4; ++ks) { spf[c][ks][0] = *(const float4*)(sp + c * 2048 + ks * 32); spf[c][ks][1] = *(const float4*)(sp + c * 2048 + ks * 32 + 4); }
#pragma unroll
        for (int i = 0; i < 2; ++i) {
            const int ti = wid * 2 + i, rt = ti >> 2, ct = ti & 3;
            f32x4 a4 = (f32x4){0.f, 0.f, 0.f, 0.f};
            if (ct <= rt) {
#pragma unroll
                for (int ks = 0; ks < 4; ++ks) {
                    const bf16x8 a = *(const LAS bf16x8*)(qt + (rt * 16 + fr) * 136 + ks * 32 + fq * 8);
                    const bf16x8 b = *(const LAS bf16x8*)(kt + (ct * 16 + fr) * 136 + ks * 32 + fq * 8);
                    a4 = mfma16(a, b, a4);
                }
            }
#pragma unroll
            for (int jj = 0; jj < 4; ++jj) { const int t = rt * 16 + fq * 4 + jj, s = ct * 16 + fr; sc[t * 72 + s] = f2bf(s <= t ? a4[jj] : 0.f); }
        }
        __syncthreads();
        f32x4 acc[4][2];
#pragma unroll
        for (int r = 0; r < 4; ++r)
#pragma unroll
            for (int c = 0; c < 2; ++c) acc[r][c] = (f32x4){0.f, 0.f, 0.f, 0.f};
#pragma unroll
        for (int ks = 0; ks < 2; ++ks) {
            bf16x8 b[2];
#pragma unroll
            for (int c = 0; c < 2; ++c) b[c] = *(const LAS bf16x8*)(vT + (wid * 32 + c * 16 + fr) * 72 + ks * 32 + fq * 8);
#pragma unroll
            for (int r = 0; r < 4; ++r) {
                const bf16x8 a = *(const LAS bf16x8*)(sc + (r * 16 + fr) * 72 + ks * 32 + fq * 8);
#pragma unroll
                for (int c = 0; c < 2; ++c) acc[r][c] = mfma16(a, b[c], acc[r][c]);
            }
        }
#pragma unroll
        for (int ks = 0; ks < 4; ++ks) {
            bf16x8 b[2];
#pragma unroll
            for (int c = 0; c < 2; ++c) {
                const float4 x0 = spf[c][ks][0], x1 = spf[c][ks][1];
                u32x4 w; w.x = pk2(x0.x, x0.y); w.y = pk2(x0.z, x0.w); w.z = pk2(x1.x, x1.y); w.w = pk2(x1.z, x1.w);
                b[c] = __builtin_bit_cast(bf16x8, w);
            }
#pragma unroll
            for (int r = 0; r < 4; ++r) {
                const bf16x8 a = *(const LAS bf16x8*)(qt + (r * 16 + fr) * 136 + ks * 32 + fq * 8);
#pragma unroll
                for (int c = 0; c < 2; ++c) acc[r][c] = mfma16(a, b[c], acc[r][c]);
            }
        }
#pragma unroll
        for (int r = 0; r < 4; ++r)
#pragma unroll
            for (int jj = 0; jj < 4; ++jj) {
                float ss = acc[r][0][jj] * acc[r][0][jj] + acc[r][1][jj] * acc[r][1][jj];
                ss += __shfl_xor(ss, 1); ss += __shfl_xor(ss, 2); ss += __shfl_xor(ss, 4); ss += __shfl_xor(ss, 8);
                if (fr == 0) part[(r * 16 + fq * 4 + jj) * 8 + wid] = ss;
            }
        __syncthreads();
        const float gn0 = gn[wid * 32 + fr], gn1 = gn[wid * 32 + 16 + fr];
#pragma unroll
        for (int r = 0; r < 4; ++r)
#pragma unroll
            for (int jj = 0; jj < 4; ++jj) {
                const int t = r * 16 + fq * 4 + jj;
                const f32x4 p0 = *(const LAS f32x4*)(part + t * 8), p1 = *(const LAS f32x4*)(part + t * 8 + 4);
                const float tot = ((p0[0] + p0[1]) + (p0[2] + p0[3])) + ((p1[0] + p1[1]) + (p1[2] + p1[3]));
                const float rinv = __builtin_amdgcn_rsqf(tot * (1.0f / 256.0f) + LN_EPS);
                LAS bf16_t* ro = rl + t * 264 + wid * 32 + fr;
                ro[0] = f2bf(acc[r][0][jj] * rinv * gn0 * silu_f(bf2f(ro[0])));
                ro[16] = f2bf(acc[r][1][jj] * rinv * gn1 * silu_f(bf2f(ro[16])));
            }
        __syncthreads();
        for (int idx = tid; idx < len * 32; idx += NTHR) {
            const int t = idx >> 5, c16 = idx & 31;
            *(u32x4*)(AB + (size_t)(row0 + t) * D + h * 256 + c16 * 8) = *(const LAS u32x4*)(rl + t * 264 + c16 * 8);
        }
        __syncthreads();
    }
}

constexpr size_t OFF_VSTAT = OFF_BIG + (size_t)MT * 4096 * 2;
__device__ __forceinline__ void sg_phase(LAS unsigned char* lds, const Params& p, int j, int G, int bid) {
    bf16_t* U = (bf16_t*)(p.ws + OFF_BIG); const bf16_t* V = (const bf16_t*)(p.ws + OFF_BIG + (size_t)MT * 2048 * 2);
    const float* VS = (const float*)(p.ws + OFF_VSTAT);
    const float* lg = p.in[16] + (size_t)j * 2048; const float* lb = p.in[17] + (size_t)j * 2048;
    const float* wsp = p.in[18] + (size_t)j * 8 * 128 * 128; const float* bsp = p.in[19] + (size_t)j * 8 * 128;
    float* sgv = p.out + O_SGV + (size_t)j * 8 * 32 * 2048;
    LAS bf16_t* vnT = (LAS bf16_t*)lds;
    LAS bf16_t* wsA = (LAS bf16_t*)(lds + 69632);
    LAS float* stat = (LAS float*)(lds + 104448);
    LAS float* bsl = (LAS float*)(lds + 105472);
    int tid_ = threadIdx.x; asm volatile("" : "+v"(tid_)); const int tid = tid_, wid = tid >> 6, lane = tid & 63, fr = lane & 15, fq = lane >> 4;
    const int NIT = (128 + 8) * 8;
    for (int it = bid; it < NIT; it += G) {
        const int ci = it >> 3, g = it & 7; const bool samp = ci >= 128;
        const int row0 = samp ? MP + (ci - 128) * 32 : ci * 128, len = samp ? 32 : 128;
        if (tid < len) {
            const float4* sp = (const float4*)(VS + (size_t)(row0 + tid) * 64); float s = 0.f, q = 0.f;
#pragma unroll
            for (int i = 0; i < 16; ++i) { const float4 x = sp[i]; s += x.x + x.z; q += x.y + x.w; }
            const float mean = s * (1.0f / 2048.0f), var = q * (1.0f / 2048.0f) - mean * mean;
            stat[tid * 2] = mean; stat[tid * 2 + 1] = 1.0f / sqrtf(fmaxf(var, 0.f) + LN_EPS);
        }
        if (tid >= 384) bsl[tid - 384] = bsp[g * 128 + tid - 384];
        {
            const int tt = tid >> 2, s0 = (tid & 3) * 32; const float* wrow = wsp + (size_t)g * 16384 + tt * 128 + s0;
            float4 wa[4], wb[4];
#pragma unroll
            for (int i = 0; i < 4; ++i) { wa[i] = *(const float4*)(wrow + 8 * i); wb[i] = *(const float4*)(wrow + 8 * i + 4); }
            __builtin_amdgcn_sched_barrier(0);
#pragma unroll
            for (int i = 0; i < 4; ++i) {
                const float4 a = wa[i], b = wb[i]; const int sb = s0 + 8 * i;
                u32x4 w; w.x = pk2(sb + 0 <= tt ? a.x : 0.f, sb + 1 <= tt ? a.y : 0.f); w.y = pk2(sb + 2 <= tt ? a.z : 0.f, sb + 3 <= tt ? a.w : 0.f);
                w.z = pk2(sb + 4 <= tt ? b.x : 0.f, sb + 5 <= tt ? b.y : 0.f); w.w = pk2(sb + 6 <= tt ? b.z : 0.f, sb + 7 <= tt ? b.w : 0.f);
                *(LAS u32x4*)(wsA + tt * 136 + sb) = w;
            }
        }
        __syncthreads();
        {
            const int d = tid & 255, hh = tid >> 8; const float lgd = lg[g * 256 + d], lbd = lb[g * 256 + d];
            const bf16_t* vb = V + (size_t)row0 * 2048 + g * 256 + d;
#pragma nounroll
            for (int bt = 0; bt < 4; ++bt) {
                const unsigned sb = 64u * hh + 16u * bt; float vn[16];
#pragma unroll
                for (int i = 0; i < 16; ++i) {
                    const unsigned s = sb + i, sc_ = s < (unsigned)len ? s : 0u;
                    const float x = (bf2f(vb[sc_ * 2048u]) - stat[sc_ * 2]) * stat[sc_ * 2 + 1] * lgd + lbd;
                    vn[i] = s < (unsigned)len ? x : 0.f;
                }
                if (samp && sb < (unsigned)len) {
#pragma unroll
                    for (int i = 0; i < 16; ++i) sgv[(size_t)(row0 - MP + sb + i) * 2048 + g * 256 + d] = vn[i];
                }
                u32x4 w0, w1;
                w0.x = pk2(vn[0], vn[1]); w0.y = pk2(vn[2], vn[3]); w0.z = pk2(vn[4], vn[5]); w0.w = pk2(vn[6], vn[7]);
                w1.x = pk2(vn[8], vn[9]); w1.y = pk2(vn[10], vn[11]); w1.z = pk2(vn[12], vn[13]); w1.w = pk2(vn[14], vn[15]);
                *(LAS u32x4*)(vnT + d * 136 + sb) = w0; *(LAS u32x4*)(vnT + d * 136 + sb + 8) = w1;
            }
        }
        __syncthreads();
        f32x4 acc[8][2];
#pragma unroll
        for (int r = 0; r < 8; ++r)
#pragma unroll
            for (int c = 0; c < 2; ++c) acc[r][c] = (f32x4){0.f, 0.f, 0.f, 0.f};
#pragma unroll
        for (int ks = 0; ks < 4; ++ks) {
            bf16x8 b[2];
#pragma unroll
            for (int c = 0; c < 2; ++c) b[c] = *(const LAS bf16x8*)(vnT + (wid * 32 + c * 16 + fr) * 136 + ks * 32 + fq * 8);
#pragma unroll
            for (int r = 0; r < 8; ++r) {
                if (ks * 32 <= r * 16 + 15) {
                    const bf16x8 a = *(const LAS bf16x8*)(wsA + (r * 16 + fr) * 136 + ks * 32 + fq * 8);
#pragma unroll
                    for (int c = 0; c < 2; ++c) acc[r][c] = mfma16(a, b[c], acc[r][c]);
                }
            }
        }
        __syncthreads();
#pragma unroll
        for (int r = 0; r < 8; ++r)
#pragma unroll
            for (int jj = 0; jj < 4; ++jj) {
                const int t = r * 16 + fq * 4 + jj; const float bsv = bsl[t];
                LAS bf16_t* so = vnT + t * 264 + wid * 32 + fr;
                so[0] = f2bf(acc[r][0][jj] + bsv); so[16] = f2bf(acc[r][1][jj] + bsv);
            }
        __syncthreads();
        for (int idx = tid; idx < len * 32; idx += NTHR) {
            const int t = idx >> 5, c16 = idx & 31;
            bf16_t* up = U + (size_t)(row0 + t) * 2048 + g * 256 + c16 * 8;
            const u32x4 uw = *(const u32x4*)up, sw = *(const LAS u32x4*)(vnT + t * 264 + c16 * 8);
            u32x4 w; w.x = pk2(bflo(uw.x) * bflo(sw.x), bfhi(uw.x) * bfhi(sw.x)); w.y = pk2(bflo(uw.y) * bflo(sw.y), bfhi(uw.y) * bfhi(sw.y));
            w.z = pk2(bflo(uw.z) * bflo(sw.z), bfhi(uw.z) * bfhi(sw.z)); w.w = pk2(bflo(uw.w) * bflo(sw.w), bfhi(uw.w) * bfhi(sw.w));
            *(u32x4*)up = w;
        }
        __syncthreads();
    }
}

template <int K> __device__ __forceinline__ void skinny_out(LAS unsigned char* lds, const bf16_t* __restrict__ A, const bf16_t* __restrict__ Bt, float* X, float alpha, float scale, int G, int bid) {
    int tid_ = threadIdx.x; asm volatile("" : "+v"(tid_)); const int tid = tid_, wid = tid >> 6, lane = tid & 63, fr = lane & 15, fq = lane >> 4;
    LAS float* part = (LAS float*)lds;
    constexpr int KW = K / 8;
    for (int it = bid; it < 256; it += G) {
        const int rf = it >> 4, cc = it & 15;
        const bf16_t* ap = A + (size_t)(MP + rf * 16 + fr) * K + wid * KW + fq * 8;
        const bf16_t* bp = Bt + (size_t)(cc * 64 + fr) * K + wid * KW + fq * 8;
        f32x4 acc[4];
#pragma unroll
        for (int c = 0; c < 4; ++c) acc[c] = (f32x4){0.f, 0.f, 0.f, 0.f};
        {
            constexpr int NB = (KW + 127) / 128;
            bf16x8 a[2][4], bq[2][4][4];
#define SK_LOAD(set, k0) _Pragma("unroll") for (int s = 0; s < 4; ++s) if ((k0) + s * 32 < KW) { a[set][s] = *(const bf16x8*)(ap + (k0) + s * 32); \
                _Pragma("unroll") for (int c = 0; c < 4; ++c) bq[set][s][c] = *(const bf16x8*)(bp + (size_t)c * 16 * K + (k0) + s * 32); }
#define SK_MMA(set, k0) _Pragma("unroll") for (int s = 0; s < 4; ++s) if ((k0) + s * 32 < KW) { _Pragma("unroll") for (int c = 0; c < 4; ++c) acc[c] = mfma16(a[set][s], bq[set][s][c], acc[c]); }
            SK_LOAD(0, 0)
#pragma unroll
            for (int ib = 0; ib < NB; ++ib) {
                if (ib + 1 < NB) { SK_LOAD((ib + 1) & 1, (ib + 1) * 128) }
                __builtin_amdgcn_sched_barrier(0);
                SK_MMA(ib & 1, ib * 128)
                __builtin_amdgcn_sched_barrier(0);
            }
#undef SK_LOAD
#undef SK_MMA
        }
#pragma unroll
        for (int c = 0; c < 4; ++c)
#pragma unroll
            for (int jj = 0; jj < 4; ++jj) part[(wid * 16 + fq * 4 + jj) * 64 + c * 16 + fr] = acc[c][jj];
        __syncthreads();
        for (int e = tid; e < 1024; e += NTHR) {
            const int r = e >> 6, c = e & 63; float s = 0.f;
#pragma unroll
            for (int w = 0; w < 8; ++w) s += part[(w * 16 + r) * 64 + c];
            float* xp = X + (size_t)(MP + rf * 16 + r) * D + cc * 64 + c;
            *xp = alpha * (*xp) + scale * s;
        }
        __syncthreads();
    }
}

#ifndef PROBE_CLASS
#define PROBE_CLASS 0
#endif
#define PB(c) { if (PROBE_CLASS && ((PROBE_MASK >> (c)) & 1)) t0_ = wall_clock64(); }
#define PE(c) { if (PROBE_CLASS && ((PROBE_MASK >> (c)) & 1)) t_acc += wall_clock64() - t0_; }
#ifndef PROBE_MASK
#define PROBE_MASK 0
#endif
#define XB_TMO      128
#define XB_XCNT(j)  (256  + 64 * (j))
#define XB_XSUB(j)  (1280 + 64 * (j))
#define XB_XGEN(j)  (2304 + 64 * (j))
#define XB_TOP      3328
#define XB_TOPGEN   3392
#define XCD_BAR_WORDS 3456
#define XB_SPIN_CAP (1u << 18)

__device__ __forceinline__ unsigned xb_ld(unsigned* p)              { return __hip_atomic_load(p, __ATOMIC_RELAXED, __HIP_MEMORY_SCOPE_AGENT); }
__device__ __forceinline__ unsigned xb_add(unsigned* p, unsigned v) { return __hip_atomic_fetch_add(p, v, __ATOMIC_RELAXED, __HIP_MEMORY_SCOPE_AGENT); }
__device__ __forceinline__ unsigned xb_xcc_id() { return (unsigned)__builtin_amdgcn_s_getreg((3 << 11) | 20) & 0xFu; }
#define XB_SPIN(cond, bar) do { unsigned _sp = 0; while (cond) { __builtin_amdgcn_s_sleep(1); \
    if ((++_sp & 255u) == 0u) { if (xb_ld(&(bar)[XB_TMO])) break; if (_sp > XB_SPIN_CAP) { atomicAdd(&(bar)[XB_TMO], 1u); break; } } } } while (0)

struct XcdBarrier {
    unsigned* bar; unsigned x;
    volatile LAS unsigned* st;
};

__device__ __forceinline__ XcdBarrier xcd_barrier_post(unsigned* bar, volatile LAS unsigned* st) {
    XcdBarrier b; b.bar = bar; b.x = xb_xcc_id(); b.st = st;
    if (threadIdx.x == 0) (void)xb_add(&bar[XB_XCNT(b.x)], 1u);
    return b;
}
__device__ __forceinline__ void xcd_barrier_complete(unsigned* bar, unsigned x, unsigned& nloc, unsigned& nx) {
    const unsigned G = gridDim.x * gridDim.y * gridDim.z;
    unsigned sum, cnt, mine, sp = 0u;
    for (;;) {
        sum = 0u; cnt = 0u; mine = 0u;
#pragma unroll
        for (unsigned j = 0; j < 16; ++j) { const unsigned c = xb_ld(&bar[XB_XCNT(j)]); sum += c; cnt += (c > 0u) ? 1u : 0u; mine = (j == x) ? c : mine; }
        if (sum == G) break;
        __builtin_amdgcn_s_sleep(1);
        if ((++sp & 255u) == 0u) { if (xb_ld(&bar[XB_TMO])) break; if (sp > XB_SPIN_CAP) { atomicAdd(&bar[XB_TMO], 1u); break; } }
    }
    nloc = mine > 0u ? mine : 1u; nx = cnt > 0u ? cnt : 1u;
}

__device__ __forceinline__ void xcd_barrier(const XcdBarrier& b) {
    asm volatile("s_waitcnt vmcnt(0)" ::: "memory");
    __syncthreads();
    if (threadIdx.x == 0) {
        unsigned* bar = b.bar;
        __builtin_amdgcn_s_waitcnt(0);
        unsigned nloc = b.st[0], nx = b.st[1];
        if (nloc == 0u) { xcd_barrier_complete(bar, b.x, nloc, nx); b.st[0] = nloc; b.st[1] = nx; }
        const unsigned old = xb_add(&bar[XB_XSUB(b.x)], 1u);
        const unsigned gen = old / nloc;
        if (old + 1u == (gen + 1u) * nloc) {
            __builtin_amdgcn_fence(__ATOMIC_RELEASE, "agent");
            asm volatile("s_waitcnt vmcnt(0)" ::: "memory");
            const unsigned og = xb_add(&bar[XB_TOP], 1u);
            const unsigned tg = og / nx;
            if (og + 1u == (tg + 1u) * nx) xb_add(&bar[XB_TOPGEN], 1u);
            else XB_SPIN(xb_ld(&bar[XB_TOPGEN]) == tg, bar);
            __builtin_amdgcn_fence(__ATOMIC_ACQUIRE, "agent");
            xb_add(&bar[XB_XGEN(b.x)], 1u);
            asm volatile("s_waitcnt vmcnt(0)" ::: "memory");
        } else {
            XB_SPIN(xb_ld(&bar[XB_XGEN(b.x)]) == gen, bar);
            __builtin_amdgcn_fence(__ATOMIC_ACQUIRE, "agent");
            asm volatile("s_waitcnt vmcnt(0)" ::: "memory");
        }
    }
    __syncthreads();
}


#define XSYNC() { if (PROBE_CLASS && ((PROBE_MASK >> 11) & 1)) { t0_ = wall_clock64(); grid.sync(); t_acc += wall_clock64() - t0_; } }
__global__ void __launch_bounds__(NTHR, 2) mega(Params p) {
    extern __shared__ __attribute__((aligned(16))) unsigned char lds_raw[];
    LAS unsigned char* lds = (LAS unsigned char*)lds_raw;
    cg::grid_group grid = cg::this_grid();
    const int G = gridDim.x, bid = blockIdx.x;
    float* X = p.out + O_Y; bf16_t* XB = (bf16_t*)(p.ws + OFF_XB); bf16_t* WT = (bf16_t*)(p.ws + OFF_WT);
    bf16_t* BIG = (bf16_t*)(p.ws + OFF_BIG);

    unsigned long long t_acc = 0, t0_ = 0;
    volatile LAS unsigned* xb_st = (volatile LAS unsigned*)(lds + 135 * 1024);
    if (threadIdx.x < 4) xb_st[threadIdx.x] = 0u;
    __syncthreads();
    const XcdBarrier xbar = xcd_barrier_post((unsigned*)(p.ws + OFF_CTR), xb_st);
#define GB() { xcd_barrier(xbar); if (PROBE_CLASS && ((PROBE_MASK >> 11) & 1)) { t0_ = wall_clock64(); xcd_barrier(xbar); t_acc += wall_clock64() - t0_; } }
    PB(9);
    init_phase(p, G, bid);
    convert_layer(lds, p, 0, G, bid);
    if (p.ws == nullptr) grid.sync();
    GB();
    PE(9);

    for (int l = 0; l < 4; ++l) {
        const int mixer = l % 3, j = l / 3;
        for (int sub = 0; sub < 3; ++sub) {
            const bf16_t* Aout; const bf16_t* Wout; int Kout; float scale;
            if (sub != 1) {
                PB(1);
                pg8::Gemm g{XB, WT + (sub == 0 ? W_1IN : W_2IN), MT, 2 * DFF, D}; pg8::StaticOrder S; S.init(MT, 2 * DFF, G, bid);
                EpiPair<1> E{BIG, DFF};
                pg8::gemm_phase<EpiPair<1>, pg8::StaticOrder>(lds, g, S, E, nullptr);
                Aout = BIG; Wout = WT + (sub == 0 ? W_1OUT : W_2OUT); Kout = DFF; scale = 0.5f;
                GB();
                PE(1);
            } else if (mixer == 0) {
                PB(1);
                { pg8::Gemm g{XB, WT + W_MIN, MT, GLA_NP, D}; pg8::StaticOrder S; S.init(MT, GLA_NP, G, bid);
                  EpiBf<0> E{(bf16_t*)(p.ws + OFF_P), GLA_NP, 0, 0};
                  pg8::gemm_phase<EpiBf<0>, pg8::StaticOrder>(lds, g, S, E, nullptr); }
                GB();
                PE(1);
                PB(4);
                gla_g1(lds, p, j, G, bid);
                GB();
                PE(4);
                PB(5);
                gla_g2(p, j, G, bid);
                GB();
                PE(5);
                PB(6);
                gla_g3(lds, p, j, G, bid);
                GB();
                PE(6);
                Aout = (const bf16_t*)(p.ws + OFF_AB); Wout = WT + W_MOUT; Kout = D; scale = 1.0f;
            } else if (mixer == 1) {
                PB(1);
                { pg8::Gemm g{XB, WT + W_MIN, MT, 4096, D}; pg8::StaticOrder S; S.init(MT, 4096, G, bid);
                  EpiBf<1> E{BIG, 2048, 2048, (size_t)MT * 2048, (float*)(p.ws + OFF_VSTAT)};
                  pg8::gemm_phase<EpiBf<1>, pg8::StaticOrder>(lds, g, S, E, nullptr); }
                GB();
                PE(1);
                PB(7);
                sg_phase(lds, p, j, G, bid);
                GB();
                PE(7);
                Aout = BIG; Wout = WT + W_MOUT; Kout = 2048; scale = 1.0f;
            } else {
                PB(1);
                { pg8::Gemm g{XB, WT + W_MIN, MT, 3072, D}; pg8::StaticOrder S; S.init(MT, 3072, G, bid);
                  EpiConv E{BIG, BIG + (size_t)MT * D};
                  pg8::gemm_phase<EpiConv, pg8::StaticOrder>(lds, g, S, E, nullptr); }
                GB();
                PE(1);
                PB(8);
                conv_phase(p, j, G, bid);
                GB();
                PE(8);
                Aout = BIG + (size_t)MT * D; Wout = WT + W_MOUT; Kout = D; scale = 1.0f;
            }
            if (sub != 1) PB(2) else PB(10)
            { pg8::Gemm g{Aout, Wout, MP, D, Kout}; pg8::StaticOrder S; S.init(MP, D, G, bid);
              EpiRes E{X, ALPHA, scale};
              if (sub != 1) PB(12)
              pg8::gemm_phase<EpiRes, pg8::StaticOrder>(lds, g, S, E, nullptr);
              if (sub != 1) PE(12) }
            if (sub != 1) PB(13)
            if (Kout == DFF) skinny_out<DFF>(lds, Aout, Wout, X, ALPHA, scale, G, bid);
            else if (Kout == 2048) skinny_out<2048>(lds, Aout, Wout, X, ALPHA, scale, G, bid);
            else skinny_out<1024>(lds, Aout, Wout, X, ALPHA, scale, G, bid);
            if (sub != 1) PE(13)
            GB();
            if (sub != 1) PE(2) else PE(10)
            PB(3);
            ln_phase(X, XB, p.in[4] + (size_t)(l * 3 + sub) * D, p.in[5] + (size_t)(l * 3 + sub) * D, G, bid);
            if (sub == 2 && l < 3) convert_layer(lds, p, l + 1, G, bid);
            if (!(sub == 2 && l == 3)) GB();
            PE(3);
        }
    }
    if (PROBE_CLASS) { __syncthreads(); if (bid == 0 && threadIdx.x == 0) X[0] += (float)t_acc * (0.01f / 256.0f); }
}

extern "C" void kernel_launch(void* const* d_in, const int* in_sizes, int n_in, void* d_out, int out_size, void* d_ws, size_t ws_size, hipStream_t stream) {
    static int grid_blocks = 0;
    if (grid_blocks == 0) {
        if (n_in != 24 || ws_size < WS_END) { fprintf(stderr, "kernel_launch: unexpected n_in %d or ws_size %zu (< %zu)\n", n_in, ws_size, (size_t)WS_END); grid_blocks = -1; return; }
        int dev = 0, cus = 0, per_cu = 0;
        hipGetDevice(&dev);
        hipDeviceGetAttribute(&cus, hipDeviceAttributeMultiprocessorCount, dev);
        if (hipFuncSetAttribute((const void*)mega, hipFuncAttributeMaxDynamicSharedMemorySize, LDS_BYTES) != hipSuccess) { fprintf(stderr, "kernel_launch: hipFuncSetAttribute failed\n"); grid_blocks = -1; return; }
        if (hipOccupancyMaxActiveBlocksPerMultiprocessor(&per_cu, (const void*)mega, NTHR, LDS_BYTES) != hipSuccess || per_cu < 1) { fprintf(stderr, "kernel_launch: occupancy query says %d\n", per_cu); per_cu = 1; }
        (void)hipGetLastError();
        grid_blocks = cus * 1;
    }
    if (grid_blocks < 0) return;
    Params p{};
    for (int i = 0; i < 24; ++i) p.in[i] = (const float*)d_in[i];
    p.out = (float*)d_out; p.ws = (unsigned char*)d_ws;
    if (hipMemsetAsync((char*)d_ws + OFF_CTR, 0, 16384, stream) != hipSuccess) { fprintf(stderr, "kernel_launch: memset of the barrier counter failed\n"); return; }
    void* args[] = {&p};
    hipError_t e = hipLaunchCooperativeKernel((const void*)mega, dim3(grid_blocks), dim3(NTHR), args, LDS_BYTES, stream);
    if (e != hipSuccess) fprintf(stderr, "cooperative launch failed: %s (grid %d)\n", hipGetErrorString(e), grid_blocks);
}
```

```cpp
#include <hip/hip_runtime.h>
#include <hip/hip_cooperative_groups.h>
#include <cstdio>
namespace cg = cooperative_groups;
namespace pg8 {
#define PG8_LAS __attribute__((address_space(3)))
typedef unsigned short bf16_t;
typedef short bf16x8 __attribute__((ext_vector_type(8)));
typedef float f32x4 __attribute__((ext_vector_type(4)));
typedef unsigned u32x4 __attribute__((ext_vector_type(4)));
constexpr int BM = 256, BK = 64, HALF = 128, HTB = HALF * BK * 2  , STAGE_BYTES = 8 * HTB, NXCD = 8, WGM = 8;

__host__ __device__ __forceinline__ int lds_byte(int r, int c) { const int st = (r >> 4) * 2 + (c >> 5), rr = r & 15, cc = c & 31, ob = rr * 64 + cc * 2; return st * 1024 + (ob ^ (((ob >> 9) & 1) << 5)); }
__host__ __device__ __forceinline__ void stage_rc(int b, int& R, int& C) { const int st = b / 1024, sb = b % 1024, swz = sb ^ (((sb >> 9) & 1) << 5); R = (st >> 1) * 16 + swz / 64; C = (st & 1) * 32 + (swz % 64) / 2; }
__host__ __device__ __forceinline__ int perm32(int rho) { const int n = rho >> 4, i = rho & 15; return 8 * (i >> 2) + 4 * n + (i & 3); }

struct Unit { int pm, pn; };
struct Gemm { const bf16_t* A; const bf16_t* Bt; int M, N, K; };

struct StaticOrder {
    int nM, nN, nwg, G, c;
    __host__ __device__ void init(int M, int N, int G_, int c_) { nM = M / BM; nN = N / BM; nwg = nM * nN; G = G_; c = c_; }
    __host__ __device__ bool next(int i, Unit& u) const {
        const long L = (long)i * G + c; if (L >= nwg) return false;
        int wgid = (int)L; { const int q = nwg / NXCD, r = nwg % NXCD, xcd = wgid % NXCD, off = wgid / NXCD; wgid = (xcd < r ? xcd * (q + 1) : r * (q + 1) + (xcd - r) * q) + off; }
        const int nig = WGM * nN, gid = wgid / nig, fm = gid * WGM, gsz = (nM - fm) < WGM ? (nM - fm) : WGM;
        u.pm = fm + ((wgid % nig) % gsz); u.pn = (wgid % nig) / gsz; return true;
    }
    __device__ __forceinline__ void a_ready(const Unit&) const {}
    __device__ __forceinline__ void done(const Unit&) const {}
};
struct CountedOrder : StaticOrder {
    const unsigned* ready; unsigned need; unsigned* tmo;
    __device__ __forceinline__ void a_ready(const Unit& u) const {
        if (threadIdx.x < 64) {
            const unsigned long long t0 = __builtin_amdgcn_s_memrealtime(); unsigned polls = 0;
            while ((unsigned)__builtin_amdgcn_readfirstlane(__hip_atomic_load(ready + 64 * u.pm, __ATOMIC_RELAXED, __HIP_MEMORY_SCOPE_AGENT)) < need) {
                if ((++polls & 255u) == 0u && __builtin_amdgcn_readfirstlane(__hip_atomic_load(tmo, __ATOMIC_RELAXED, __HIP_MEMORY_SCOPE_AGENT)) != 0u) break;
                if (__builtin_amdgcn_s_memrealtime() - t0 > 2000000ull) {
                    if (threadIdx.x == 0) { unsigned expect = 0u; __hip_atomic_compare_exchange_strong(tmo + 1, &expect, 0x600u | (unsigned)(u.pm & 0xff), __ATOMIC_RELAXED, __ATOMIC_RELAXED, __HIP_MEMORY_SCOPE_AGENT); __hip_atomic_store(tmo, 1u, __ATOMIC_RELAXED, __HIP_MEMORY_SCOPE_AGENT); }
                    break; }
                __builtin_amdgcn_s_sleep(2); }
            __builtin_amdgcn_fence(__ATOMIC_ACQUIRE, "agent");
            asm volatile("s_waitcnt vmcnt(0)" ::: "memory");
        }
#if !defined(BROKEN_HOOK_NO_BARRIER)
        asm volatile("" ::: "memory"); __builtin_amdgcn_s_barrier(); asm volatile("" ::: "memory");
#endif
    }
};

__device__ __forceinline__ unsigned cvt_pk_bf16(float lo, float hi) { unsigned r; asm volatile("v_cvt_pk_bf16_f32 %0, %1, %2" : "=v"(r) : "v"(lo), "v"(hi)); return r; }
typedef float f32x2 __attribute__((ext_vector_type(2)));
__device__ __forceinline__ f32x2 gelu_pk(f32x2 v) {
    const f32x2 av = __builtin_elementwise_abs(v), d = av * 0.2316418882f + 1.0f;
    f32x2 t; t.x = __builtin_amdgcn_rcpf(d.x); t.y = __builtin_amdgcn_rcpf(d.y);
    f32x2 q = t * 0.5307027145f + (-0.7265760135f); q = q * t + 0.7107068705f; q = q * t + (-0.142248368f); q = q * t + 0.127414796f; q = q * t;
    const f32x2 s = (v * v) * (-0.72134752044f);
    f32x2 e; e.x = __builtin_amdgcn_exp2f(s.x); e.y = __builtin_amdgcn_exp2f(s.y);
    const f32x2 m = v * (q * e), r = v - m;
    f32x2 o; o.x = v.x < 0.f ? m.x : r.x; o.y = v.y < 0.f ? m.y : r.y; return o;
}

template <class Epi, class Sched, bool STAMP = false>
__device__ __forceinline__ void gemm_phase(PG8_LAS unsigned char* lds, const Gemm g, const Sched& S, const Epi& E, unsigned long long* stamps) {
    int tid_ = threadIdx.x; asm volatile("" : "+v"(tid_)); const int tid = tid_, wid = __builtin_amdgcn_readfirstlane(tid >> 6), lane = tid & 63, wr = wid >> 2, wc = wid & 3, fr = lane & 15, fq = lane >> 4;
    const int K = g.K, nt = K / BK;
    int ts_lo = 0, ts_hi = 0, nts = 0; const unsigned long long rt_entry = STAMP ? (unsigned long long)wall_clock64() : 0ull;
#define PG8_STAMP() do { if (STAMP && wid == 0 && nts < 64) { const unsigned long long _c = (unsigned long long)clock64(); \
        ts_lo = (lane == nts) ? (int)(unsigned)_c : ts_lo; ts_hi = (lane == nts) ? (int)(unsigned)(_c >> 32) : ts_hi; ++nts; } } while (0)
    PG8_STAMP();
    unsigned voffA[2], voffB[2];
#pragma unroll
    for (int i = 0; i < 2; ++i) { int R, C; stage_rc(tid * 16 + i * 8192, R, C); const int Rb = Epi::PERM ? ((R & ~31) + perm32(R & 31)) : R;
        voffA[i] = (unsigned)(R * K + C) * 2u; voffB[i] = (unsigned)(Rb * K + C) * 2u; }
    const size_t kstep = (size_t)(BK * 2);
    const size_t hstep = (size_t)HALF * K * 2;
    const size_t tstep = 2 * hstep;
    const unsigned ldsw = (unsigned)wid * 1024u;
    const int aoff = lds_byte(wr * 64 + fr, fq * 8), boff = lds_byte(wc * 32 + fr, fq * 8);
#define PG8_SA(b, h) (((b) * 2 + (h)) * HTB)
#define PG8_SB(b, h) ((4 + (b) * 2 + (h)) * HTB)
#define PG8_STAGE(bufoff, gbase, voff) do { _Pragma("unroll") for (int _i = 0; _i < 2; ++_i) \
        __builtin_amdgcn_global_load_lds((const unsigned*)((const char*)(gbase) + (voff)[_i]), (PG8_LAS unsigned*)(lds + (bufoff) + ldsw + _i * 8192), 16, 0, 0); } while (0)
#define PG8_LDA(dst, b, h) do { _Pragma("unroll") for (int m = 0; m < 4; ++m) _Pragma("unroll") for (int k = 0; k < 2; ++k) dst[m][k] = *(const PG8_LAS bf16x8*)(lds + PG8_SA(b, h) + aoff + m * 2048 + k * 1024); } while (0)
#define PG8_LDB(dst, b, h) do { _Pragma("unroll") for (int n = 0; n < 2; ++n) _Pragma("unroll") for (int k = 0; k < 2; ++k) dst[n][k] = *(const PG8_LAS bf16x8*)(lds + PG8_SB(b, h) + boff + n * 2048 + k * 1024); } while (0)
#define PG8_MMA(ai, bj, At, Bt) do { __builtin_amdgcn_s_setprio(1); _Pragma("unroll") for (int m = 0; m < 4; ++m) _Pragma("unroll") for (int n = 0; n < 2; ++n) _Pragma("unroll") for (int k = 0; k < 2; ++k) \
        acc[ai][bj][m][n] = __builtin_amdgcn_mfma_f32_16x16x32_bf16(Bt[n][k], At[m][k], acc[ai][bj][m][n], 0, 0, 0); __builtin_amdgcn_s_setprio(0); } while (0)
#define PG8_WAIT_V(n) asm volatile("s_waitcnt vmcnt(" #n ")" ::: "memory")
#define PG8_WAIT_L(n) asm volatile("s_waitcnt lgkmcnt(" #n ")" ::: "memory")
#define PG8_BAR __builtin_amdgcn_s_barrier()
#define PG8_SCHED __builtin_amdgcn_sched_barrier(0)
    Unit cur, nxt; int ui = 0;
    if (!S.next(0, cur)) return;
    f32x4 acc[2][2][4][2];
#pragma unroll
    for (int a = 0; a < 2; ++a)
#pragma unroll
        for (int b = 0; b < 2; ++b)
#pragma unroll
            for (int m = 0; m < 4; ++m)
#pragma unroll
                for (int n = 0; n < 2; ++n) acc[a][b][m][n] = (f32x4){0.f, 0.f, 0.f, 0.f};
    bf16x8 At[4][2], B0[2][2], B1[2][2];
    const char* cA = (const char*)g.A + (size_t)cur.pm * tstep; const char* cB = (const char*)g.Bt + (size_t)cur.pn * tstep;
    S.a_ready(cur);
    PG8_STAGE(PG8_SB(0, 0), cB, voffB); PG8_STAGE(PG8_SA(0, 0), cA, voffA); PG8_STAGE(PG8_SB(0, 1), cB + hstep, voffB); PG8_STAGE(PG8_SA(0, 1), cA + hstep, voffA);
    if (wr == 1) PG8_BAR;
    PG8_WAIT_V(4); PG8_BAR;
    PG8_STAGE(PG8_SB(1, 0), cB + kstep, voffB); PG8_STAGE(PG8_SA(1, 0), cA + kstep, voffA); PG8_STAGE(PG8_SB(1, 1), cB + hstep + kstep, voffB);
    PG8_WAIT_V(6); PG8_BAR;
    PG8_STAMP();
    for (;;) {
        const bool has_next = S.next(ui + 1, nxt);
        const char* nA = has_next ? (const char*)g.A + (size_t)nxt.pm * tstep : cA; const char* nB = has_next ? (const char*)g.Bt + (size_t)nxt.pn * tstep : cB;
        for (int t = 0; t < nt; t += 2) {
            const bool last = (t == nt - 2);
            const char* a1 = cA + (size_t)(t + 1) * kstep;
            const char* a2 = last ? nA : cA + (size_t)(t + 2) * kstep; const char* b2 = last ? nB : cB + (size_t)(t + 2) * kstep;
            const char* a3 = a2 + kstep; const char* b3 = b2 + kstep;
            if (last && has_next) S.a_ready(nxt);
            PG8_LDB(B0, 0, 0); PG8_SCHED; PG8_LDA(At, 0, 0); PG8_STAGE(PG8_SA(1, 1), a1 + hstep, voffA);
            PG8_WAIT_L(8); PG8_BAR; PG8_WAIT_L(0); PG8_MMA(0, 0, At, B0); PG8_BAR; PG8_SCHED;
            PG8_LDB(B1, 0, 1); PG8_STAGE(PG8_SB(0, 0), b2, voffB);
            PG8_BAR; PG8_WAIT_L(0); PG8_MMA(0, 1, At, B1); PG8_BAR;
            PG8_LDA(At, 0, 1); PG8_STAGE(PG8_SA(0, 0), a2, voffA);
            PG8_BAR; PG8_WAIT_L(0); PG8_MMA(1, 0, At, B0); PG8_BAR; PG8_SCHED;
            PG8_STAGE(PG8_SB(0, 1), b2 + hstep, voffB);
            PG8_WAIT_V(6); PG8_BAR; PG8_MMA(1, 1, At, B1); PG8_BAR;
            PG8_LDB(B0, 1, 0); PG8_SCHED; PG8_LDA(At, 1, 0); PG8_STAGE(PG8_SA(0, 1), a2 + hstep, voffA);
            PG8_WAIT_L(8); PG8_BAR; PG8_WAIT_L(0); PG8_MMA(0, 0, At, B0); PG8_BAR; PG8_SCHED;
            PG8_LDB(B1, 1, 1); PG8_STAGE(PG8_SB(1, 0), b3, voffB);
            PG8_BAR; PG8_WAIT_L(0); PG8_MMA(0, 1, At, B1); PG8_BAR;
            PG8_LDA(At, 1, 1); PG8_STAGE(PG8_SA(1, 0), a3, voffA);
            PG8_BAR; PG8_WAIT_L(0); PG8_MMA(1, 0, At, B0); PG8_BAR; PG8_SCHED;
            PG8_STAGE(PG8_SB(1, 1), b3 + hstep, voffB);
            PG8_WAIT_V(6); PG8_BAR; PG8_MMA(1, 1, At, B1); PG8_BAR;
        }
        PG8_STAMP();
        if constexpr (!Epi::AFTER_DRAIN) { E(acc, cur, wr, wc, fr, fq); S.done(cur); }
        PG8_STAMP();
        if (!has_next) break;
#pragma unroll
        for (int a = 0; a < 2; ++a)
#pragma unroll
            for (int b = 0; b < 2; ++b)
#pragma unroll
                for (int m = 0; m < 4; ++m)
#pragma unroll
                    for (int n = 0; n < 2; ++n) acc[a][b][m][n] = (f32x4){0.f, 0.f, 0.f, 0.f};
        cur = nxt; cA = nA; cB = nB; ++ui;
    }
    PG8_WAIT_V(0);
    if (wr == 0) PG8_BAR;
    PG8_BAR;
    if constexpr (Epi::AFTER_DRAIN) { E.fused(acc, cur, wr, wc, fr, fq, lds, wid, lane); S.done(cur); }
    PG8_STAMP();
    if (STAMP && wid == 0) { stamps[lane] = lane < nts ? (((unsigned long long)(unsigned)ts_hi << 32) | (unsigned)ts_lo) : 0ull;
        if (lane == 62) stamps[62] = rt_entry; if (lane == 63) stamps[63] = (unsigned long long)wall_clock64(); }
#undef PG8_STAMP
#undef PG8_SA
#undef PG8_SB
#undef PG8_STAGE
#undef PG8_LDA
#undef PG8_LDB
#undef PG8_MMA
#undef PG8_WAIT_V
#undef PG8_WAIT_L
#undef PG8_BAR
#undef PG8_SCHED
}
}

#define LAS __attribute__((address_space(3)))
using pg8::bf16_t; using pg8::bf16x8; using pg8::f32x4; using pg8::u32x4; using pg8::Unit;
typedef unsigned u32x2 __attribute__((ext_vector_type(2)));

constexpr int D = 1024, MP = 16384, MS = 256, MT = MP + MS, DFF = 2816;
constexpr int GLA_N = 3088, GLA_NP = 3328;
constexpr float ALPHA = 1.681792830507429f, LN_EPS = 1e-5f;
constexpr int NTHR = 512;
constexpr int LDS_BYTES = 136 * 1024;

constexpr size_t WT_BYTES = 48ull << 20;
constexpr size_t OFF_WT = 0;
constexpr size_t OFF_XB = OFF_WT + WT_BYTES;
constexpr size_t OFF_BIG = OFF_XB + (size_t)MT * D * 2;
constexpr int NSLOT = 1024 + 32;
constexpr size_t OFF_P = OFF_BIG;
constexpr size_t OFF_SB = OFF_P + (size_t)MT * GLA_NP * 2;
constexpr size_t OFF_BB = OFF_SB + (size_t)NSLOT * 32768 * 4;
constexpr size_t OFF_AB = OFF_BB + (size_t)MT * 512 * 4;
constexpr size_t OFF_DK = OFF_AB + (size_t)MT * D * 2;
constexpr size_t OFF_CTR = OFF_DK + (size_t)NSLOT * 128 * 4;
constexpr size_t WS_END = OFF_CTR + 16384;
constexpr size_t W_1IN = 0, W_1OUT = 5767168, W_2IN = 8650752, W_2OUT = 14417920, W_MIN = 17301504, W_MOUT = 21495808;
constexpr size_t O_Y = 0, O_GLAP = 17039360, O_GLAS = 17301504, O_CONVP = 19398656, O_CONVS = 19400704, O_SGV = 19417088;

struct Params { const float* in[24]; float* out; unsigned char* ws; };

__device__ __forceinline__ unsigned pk2(float lo, float hi) { return pg8::cvt_pk_bf16(lo, hi); }
__device__ __forceinline__ bf16_t f2bf(float f) { return (bf16_t)(pk2(f, 0.f) & 0xffffu); }
__device__ __forceinline__ float bf2f(bf16_t b) { return __uint_as_float(((unsigned)b) << 16); }
__device__ __forceinline__ float bflo(unsigned w) { return __uint_as_float(w << 16); }
__device__ __forceinline__ float bfhi(unsigned w) { return __uint_as_float(w & 0xffff0000u); }
__device__ __forceinline__ float silu_f(float x) { return x * __builtin_amdgcn_rcpf(1.0f + __expf(-x)); }
__device__ __forceinline__ float gelu_tanh_f(float x) { const float z = 1.5957691216057308f * (x + 0.044715f * x * x * x); return x * __builtin_amdgcn_rcpf(1.0f + __expf(-z)); }
__device__ __forceinline__ float logsigmoid_f(float z) { return fminf(z, 0.f) - __logf(1.0f + __expf(-fabsf(z))); }

template <int ACT> struct EpiPair {
    static constexpr bool PERM = true, AFTER_DRAIN = false;
    bf16_t* O; int ldo;
    __device__ __forceinline__ void operator()(const f32x4 (&acc)[2][2][4][2], const Unit& u, int wr, int wc, int fr, int fq) const {
        const int row0 = u.pm * 256 + wr * 64 + fr, col0 = u.pn * 128 + wc * 32 + 8 * fq;
#pragma unroll
        for (int ai = 0; ai < 2; ++ai)
#pragma unroll
            for (int m = 0; m < 4; ++m) {
                bf16_t* rowp = O + (size_t)(row0 + ai * 128 + m * 16) * ldo + col0;
                f32x4 v0, v1;
#pragma unroll
                for (int j = 0; j < 4; ++j) {
                    const float a0 = acc[ai][0][m][0][j], a1 = acc[ai][0][m][1][j];
                    v0[j] = (ACT ? silu_f(a0) : a0) * acc[ai][1][m][0][j];
                    v1[j] = (ACT ? silu_f(a1) : a1) * acc[ai][1][m][1][j];
                }
                u32x4 w; w.x = pk2(v0[0], v0[1]); w.y = pk2(v0[2], v0[3]); w.z = pk2(v1[0], v1[1]); w.w = pk2(v1[2], v1[3]);
                *(u32x4*)rowp = w;
            }
    }
};
template <int ACT> struct EpiBf {
    static constexpr bool PERM = true, AFTER_DRAIN = false;
    bf16_t* O; int ldc; int split_cols; size_t split_stride; float* vstat = nullptr;
    __device__ __forceinline__ void operator()(const f32x4 (&acc)[2][2][4][2], const Unit& u, int wr, int wc, int fr, int fq) const {
        const int row0 = u.pm * 256 + wr * 64 + fr; int colt = u.pn * 256; bf16_t* base = O;
        if (split_cols) { const int t = colt / split_cols; base += (size_t)t * split_stride; colt -= t * split_cols; }
        const int col0 = colt + wc * 32 + 8 * fq;
#pragma unroll
        for (int ai = 0; ai < 2; ++ai)
#pragma unroll
            for (int m = 0; m < 4; ++m) {
                bf16_t* rowp = base + (size_t)(row0 + ai * 128 + m * 16) * ldc + col0;
                float ssum = 0.f, qsum = 0.f;
#pragma unroll
                for (int bj = 0; bj < 2; ++bj) {
                    f32x4 v0 = acc[ai][bj][m][0], v1 = acc[ai][bj][m][1];
                    if (ACT == 1) {
#pragma unroll
                        for (int j = 0; j < 4; ++j) { v0[j] = gelu_tanh_f(v0[j]); v1[j] = gelu_tanh_f(v1[j]); }
                    }
                    u32x4 w; w.x = pk2(v0[0], v0[1]); w.y = pk2(v0[2], v0[3]); w.z = pk2(v1[0], v1[1]); w.w = pk2(v1[2], v1[3]);
                    *(u32x4*)(rowp + bj * 128) = w;
                    if (ACT == 1) {
                        const float f0 = bflo(w.x), f1 = bfhi(w.x), f2 = bflo(w.y), f3 = bfhi(w.y), f4 = bflo(w.z), f5 = bfhi(w.z), f6 = bflo(w.w), f7 = bfhi(w.w);
                        ssum += ((f0 + f1) + (f2 + f3)) + ((f4 + f5) + (f6 + f7));
                        qsum += ((f0 * f0 + f1 * f1) + (f2 * f2 + f3 * f3)) + ((f4 * f4 + f5 * f5) + (f6 * f6 + f7 * f7));
                    }
                }
                if (ACT == 1) {
                    if (vstat != nullptr && u.pn >= 8) {
                        ssum += __shfl_xor(ssum, 16); ssum += __shfl_xor(ssum, 32); qsum += __shfl_xor(qsum, 16); qsum += __shfl_xor(qsum, 32);
                        if (fq == 0) { float* sp = vstat + ((size_t)(row0 + ai * 128 + m * 16) * 32 + (u.pn - 8) * 4 + wc) * 2; sp[0] = ssum; sp[1] = qsum; }
                    }
                }
            }
    }
};
struct EpiConv {
    static constexpr bool PERM = true, AFTER_DRAIN = false;
    bf16_t* CIN; bf16_t* BG;
    __device__ __forceinline__ void operator()(const f32x4 (&acc)[2][2][4][2], const Unit& u, int wr, int wc, int fr, int fq) const {
        if (u.pn < 8) { EpiPair<0> e{CIN, D}; e(acc, u, wr, wc, fr, fq); }
        else { EpiBf<0> e{BG, D, 0, 0}; Unit v = u; v.pn = u.pn - 8; e(acc, v, wr, wc, fr, fq); }
    }
};
struct EpiRes {
    static constexpr bool PERM = false, AFTER_DRAIN = false;
    float* X; const bf16_t* XB; float alpha, scale;
    __device__ __forceinline__ void operator()(const f32x4 (&acc)[2][2][4][2], const Unit& u, int wr, int wc, int fr, int fq) const {
        const int row0 = u.pm * 256 + wr * 64 + fr, col0 = u.pn * 256 + wc * 32 + 4 * fq;
#pragma unroll
        for (int ai = 0; ai < 2; ++ai) {
            const size_t off = (size_t)(row0 + ai * 128) * D + col0;
            u32x2 xv[4][2][2];
#pragma unroll
            for (int m = 0; m < 4; ++m)
#pragma unroll
                for (int bj = 0; bj < 2; ++bj)
#pragma unroll
                    for (int n = 0; n < 2; ++n) xv[m][bj][n] = *(const u32x2*)(XB + off + m * 16 * D + bj * 128 + n * 16);
            __builtin_amdgcn_sched_barrier(0);
#pragma unroll
            for (int m = 0; m < 4; ++m)
#pragma unroll
                for (int bj = 0; bj < 2; ++bj)
#pragma unroll
                    for (int n = 0; n < 2; ++n) {
                        const u32x2 w = xv[m][bj][n]; const f32x4 x = (f32x4){bflo(w.x), bfhi(w.x), bflo(w.y), bfhi(w.y)};
                        *(f32x4*)(X + off + m * 16 * D + bj * 128 + n * 16) = x * alpha + acc[ai][bj][m][n] * scale;
                    }
            __builtin_amdgcn_sched_barrier(0);
        }
    }
};

__device__ __forceinline__ int srccol(int mode, int n) {
    if (mode == 1) { const int pn = n >> 8, c = n & 255; return (c >> 7) * DFF + pn * 128 + (c & 127); }
    if (mode == 2) { if (n < 2048) { const int pn = n >> 8, c = n & 255; return 1024 + (c >> 7) * 1024 + pn * 128 + (c & 127); } return n - 2048; }
    return n;
}
__device__ __forceinline__ void convert_matrix(LAS unsigned char* lds, const float* __restrict__ W, bf16_t* __restrict__ Wt, int K, int Nsrc, int Ndst, int Nvalid, int mode, int G, int bid) {
    LAS bf16_t* tile = (LAS bf16_t*)lds;
    int tid_ = threadIdx.x; asm volatile("" : "+v"(tid_)); const int tid = tid_, ntn = Ndst >> 6, ntk = K >> 8, ntot = ntn * ntk;
    for (int t = bid; t < ntot; t += G) {
        const int tn = t % ntn, tk = t / ntn, n0 = tn * 64, k0 = tk * 256, sc0 = srccol(mode, n0);
        const int kk = tid >> 3, cc = (tid & 7) * 8;
        float4 v0[4], v1[4];
        const bool ok = n0 + cc < Nvalid;
#pragma unroll
        for (int q = 0; q < 4; ++q) {
            v0[q] = make_float4(0.f, 0.f, 0.f, 0.f); v1[q] = v0[q];
            if (ok) { const float* s = W + (size_t)(k0 + q * 64 + kk) * Nsrc + sc0 + cc; v0[q] = *(const float4*)s; v1[q] = *(const float4*)(s + 4); }
        }
        __builtin_amdgcn_sched_barrier(0);
#pragma unroll
        for (int q = 0; q < 4; ++q) {
            LAS bf16_t* tp = tile + cc * 264 + q * 64 + kk;
            tp[0] = f2bf(v0[q].x); tp[264] = f2bf(v0[q].y); tp[528] = f2bf(v0[q].z); tp[792] = f2bf(v0[q].w);
            tp[1056] = f2bf(v1[q].x); tp[1320] = f2bf(v1[q].y); tp[1584] = f2bf(v1[q].z); tp[1848] = f2bf(v1[q].w);
        }
        __syncthreads();
#pragma unroll
        for (int i = 0; i < 4; ++i) {
            const int id = tid + i * NTHR, nl = id >> 5, kc = (id & 31) * 8;
            const u32x4 w = *(const LAS u32x4*)(tile + nl * 264 + kc);
            *(u32x4*)(Wt + (size_t)(n0 + nl) * K + k0 + kc) = w;
        }
        __syncthreads();
    }
}
__device__ __forceinline__ void convert_layer(LAS unsigned char* lds, const Params& p, int l, int G, int bid) {
    bf16_t* WT = (bf16_t*)(p.ws + OFF_WT);
    convert_matrix(lds, p.in[6] + (size_t)l * D * 2 * DFF, WT + W_1IN, D, 2 * DFF, 2 * DFF, 2 * DFF, 1, G, bid);
    convert_matrix(lds, p.in[7] + (size_t)l * DFF * D, WT + W_1OUT, DFF, D, D, D, 0, G, bid);
    convert_matrix(lds, p.in[8] + (size_t)l * D * 2 * DFF, WT + W_2IN, D, 2 * DFF, 2 * DFF, 2 * DFF, 1, G, bid);
    convert_matrix(lds, p.in[9] + (size_t)l * DFF * D, WT + W_2OUT, DFF, D, D, D, 0, G, bid);
    const int mixer = l % 3, j = l / 3;
    if (mixer == 0) {
        convert_matrix(lds, p.in[10] + (size_t)j * D * GLA_N, WT + W_MIN, D, GLA_N, GLA_NP, GLA_N, 0, G, bid);
        convert_matrix(lds, p.in[14] + (size_t)j * D * D, WT + W_MOUT, D, D, D, D, 0, G, bid);
    } else if (mixer == 1) {
        convert_matrix(lds, p.in[15] + (size_t)j * D * 4096, WT + W_MIN, D, 4096, 4096, 4096, 0, G, bid);
        convert_matrix(lds, p.in[20] + (size_t)j * 2048 * D, WT + W_MOUT, 2048, D, D, D, 0, G, bid);
    } else {
        convert_matrix(lds, p.in[21] + (size_t)j * D * 3072, WT + W_MIN, D, 3072, 3072, 3072, 2, G, bid);
        convert_matrix(lds, p.in[23] + (size_t)j * D * D, WT + W_MOUT, D, D, D, D, 0, G, bid);
    }
}

__device__ __forceinline__ void init_phase(const Params& p, int G, int bid) {
    float* X = p.out + O_Y; bf16_t* XB = (bf16_t*)(p.ws + OFF_XB);
    const size_t n4 = (size_t)MT * D / 4, np4 = (size_t)MP * D / 4;
    int tid_ = threadIdx.x; asm volatile("" : "+v"(tid_));
    for (size_t i = (size_t)bid * NTHR + tid_; i < n4; i += (size_t)G * NTHR) {
        const float4 v = (i < np4) ? ((const float4*)p.in[0])[i] : ((const float4*)p.in[1])[i - np4];
        u32x2 w; w.x = pk2(v.x, v.y); w.y = pk2(v.z, v.w);
        ((u32x2*)XB)[i] = w;
    }
}

__device__ __forceinline__ void ln_row(float* xr, bf16_t* xb, const float4 (&v)[4], const float4 (&gv)[4], const float4 (&bv)[4], int lane, bool fin) {
    float s = 0.f;
#pragma unroll
    for (int i = 0; i < 4; ++i) s += (v[i].x + v[i].y) + (v[i].z + v[i].w);
#pragma unroll
    for (int o = 32; o >= 1; o >>= 1) s += __shfl_xor(s, o);
    const float mean = s * (1.0f / D);
    float q = 0.f;
#pragma unroll
    for (int i = 0; i < 4; ++i) { const float a = v[i].x - mean, b2 = v[i].y - mean, c = v[i].z - mean, d = v[i].w - mean; q += (a * a + b2 * b2) + (c * c + d * d); }
#pragma unroll
    for (int o = 32; o >= 1; o >>= 1) q += __shfl_xor(q, o);
    const float rstd = 1.0f / sqrtf(q * (1.0f / D) + LN_EPS);
#pragma unroll
    for (int i = 0; i < 4; ++i) {
        float4 y;
        y.x = (v[i].x - mean) * rstd * gv[i].x + bv[i].x; y.y = (v[i].y - mean) * rstd * gv[i].y + bv[i].y;
        y.z = (v[i].z - mean) * rstd * gv[i].z + bv[i].z; y.w = (v[i].w - mean) * rstd * gv[i].w + bv[i].w;
        if (fin) *(float4*)(xr + (i * 64 + lane) * 4) = y;
        else { u32x2 w; w.x = pk2(y.x, y.y); w.y = pk2(y.z, y.w); *(u32x2*)(xb + (i * 64 + lane) * 4) = w; }
    }
}
__device__ __forceinline__ void ln_phase(float* X, bf16_t* XB, const float* __restrict__ g, const float* __restrict__ b, int G, int bid, bool fin) {
    int tid_ = threadIdx.x; asm volatile("" : "+v"(tid_)); const int tid = tid_, wid = tid >> 6, lane = tid & 63;
    float4 gv[4], bv[4];
#pragma unroll
    for (int i = 0; i < 4; ++i) { gv[i] = *(const float4*)(g + (i * 64 + lane) * 4); bv[i] = *(const float4*)(b + (i * 64 + lane) * 4); }
    for (int row = bid * 8 + wid; row < MT; row += 4 * G * 8) {
        int rr[4]; bool has[4]; float4 v[4][4];
#pragma unroll
        for (int k = 0; k < 4; ++k) { rr[k] = row + k * G * 8; has[k] = rr[k] < MT; if (!has[k]) rr[k] = row; }
#pragma unroll
        for (int k = 0; k < 4; ++k)
#pragma unroll
            for (int i = 0; i < 4; ++i) v[k][i] = *(const float4*)(X + (size_t)rr[k] * D + (i * 64 + lane) * 4);
        __builtin_amdgcn_sched_barrier(0);
#pragma unroll
        for (int k = 0; k < 4; ++k) if (has[k]) ln_row(X + (size_t)rr[k] * D, XB + (size_t)rr[k] * D, v[k], gv, bv, lane, fin);
    }
}

__device__ __forceinline__ void unpack8(const u32x4 w, float (&f)[8]) { f[0] = bflo(w.x); f[1] = bfhi(w.x); f[2] = bflo(w.y); f[3] = bfhi(w.y); f[4] = bflo(w.z); f[5] = bfhi(w.z); f[6] = bflo(w.w); f[7] = bfhi(w.w); }
__device__ __forceinline__ void conv_phase(const Params& p, int j, int G, int bid) {
    const bf16_t* CIN = (const bf16_t*)(p.ws + OFF_BIG); bf16_t* BG = (bf16_t*)(p.ws + OFF_BIG + (size_t)MT * D * 2);
    const float* wc = p.in[22] + (size_t)j * 3 * D; const float* st = p.in[3] + (size_t)j * 8 * 2 * D;
    float* outp = p.out + O_CONVP + (size_t)j * 2 * D; float* outs = p.out + O_CONVS + (size_t)j * 8 * 2 * D;
    const int total = MT * 128;
    int tid_ = threadIdx.x; asm volatile("" : "+v"(tid_));
    for (int idx = bid * NTHR + tid_; idx < total; idx += G * NTHR) {
        const int r = idx >> 7, c8 = (idx & 127) * 8;
        const bool samp = r >= MP; const int t = samp ? ((r - MP) & 31) : r, b = samp ? ((r - MP) >> 5) : 0, T = samp ? 32 : MP;
        float c0[8], c1[8], c2[8], bg[8];
        unpack8(*(const u32x4*)(CIN + (size_t)r * D + c8), c0);
        if (t >= 1) unpack8(*(const u32x4*)(CIN + (size_t)(r - 1) * D + c8), c1);
        else if (samp) { const float4 a = *(const float4*)(st + (size_t)(b * 2 + 1) * D + c8), a2 = *(const float4*)(st + (size_t)(b * 2 + 1) * D + c8 + 4); c1[0] = a.x; c1[1] = a.y; c1[2] = a.z; c1[3] = a.w; c1[4] = a2.x; c1[5] = a2.y; c1[6] = a2.z; c1[7] = a2.w; }
        else { for (int i = 0; i < 8; ++i) c1[i] = 0.f; }
        if (t >= 2) unpack8(*(const u32x4*)(CIN + (size_t)(r - 2) * D + c8), c2);
        else if (samp) { const float4 a = *(const float4*)(st + (size_t)(b * 2 + t) * D + c8), a2 = *(const float4*)(st + (size_t)(b * 2 + t) * D + c8 + 4); c2[0] = a.x; c2[1] = a.y; c2[2] = a.z; c2[3] = a.w; c2[4] = a2.x; c2[5] = a2.y; c2[6] = a2.z; c2[7] = a2.w; }
        else { for (int i = 0; i < 8; ++i) c2[i] = 0.f; }
        unpack8(*(const u32x4*)(BG + (size_t)r * D + c8), bg);
        float z[8];
#pragma unroll
        for (int i = 0; i < 8; ++i) z[i] = bg[i] * (wc[c8 + i] * c2[i] + wc[D + c8 + i] * c1[i] + wc[2 * D + c8 + i] * c0[i]);
        u32x4 w; w.x = pk2(z[0], z[1]); w.y = pk2(z[2], z[3]); w.z = pk2(z[4], z[5]); w.w = pk2(z[6], z[7]);
        *(u32x4*)(BG + (size_t)r * D + c8) = w;
        if (t >= T - 2) {
            float* o = (samp ? outs + (size_t)(b * 2 + (t - (T - 2))) * D : outp + (size_t)(t - (T - 2)) * D) + c8;
            *(float4*)o = make_float4(c0[0], c0[1], c0[2], c0[3]); *(float4*)(o + 4) = make_float4(c0[4], c0[5], c0[6], c0[7]);
        }
    }
}

__device__ __forceinline__ void gla_item(int slot, int& row0, int& len, int& h) { h = slot & 3; if (slot < 1024) { row0 = (slot >> 2) * 64; len = 64; } else { row0 = MP + ((slot - 1024) >> 2) * 32; len = 32; } }
__device__ __forceinline__ f32x4 mfma16(const bf16x8 a, const bf16x8 b, const f32x4 c) { return __builtin_amdgcn_mfma_f32_16x16x32_bf16(a, b, c, 0, 0, 0); }

__device__ __forceinline__ void gla_g1(LAS unsigned char* lds, const Params& p, int j, int G, int bid) {
    const bf16_t* P = (const bf16_t*)(p.ws + OFF_P); float* SB = (float*)(p.ws + OFF_SB); float* BB = (float*)(p.ws + OFF_BB); float* DK = (float*)(p.ws + OFF_DK);
    const float* wgk = p.in[11] + (size_t)j * 16 * 512; const float* bgk = p.in[12] + (size_t)j * 512;
    LAS float* gls = (LAS float*)lds;
    LAS float* wg = (LAS float*)(lds + 4096);
    LAS float* tot = (LAS float*)(lds + 12288);
    LAS bf16_t* khT = (LAS bf16_t*)(lds + 16384);
    LAS bf16_t* vT = (LAS bf16_t*)(lds + 34816);
    int tid_ = threadIdx.x; asm volatile("" : "+v"(tid_)); const int tid = tid_, wid = tid >> 6, lane = tid & 63, fr = lane & 15, fq = lane >> 4;
    const int kd = tid & 127, q4 = tid >> 7, vdv = tid & 255, hv = tid >> 8;
    for (int slot = bid; slot < NSLOT; slot += G) {
        int row0, len, h; gla_item(slot, row0, len, h);
        const bf16_t* Pr = P + (size_t)row0 * GLA_NP;
        float kf[16];
#pragma unroll
        for (int i = 0; i < 16; ++i) { const unsigned tt = 16u * q4 + i, tc = tt < (unsigned)len ? tt : 0u; const float kx = bf2f(Pr[tc * (unsigned)GLA_NP + 512u + h * 128 + kd]); kf[i] = tt < (unsigned)len ? kx : 0.f; }
        for (int idx = tid; idx < 1024; idx += NTHR) { const int t = idx >> 4, r = idx & 15; gls[idx] = t < len ? bf2f(Pr[(size_t)t * GLA_NP + 3072 + r]) : 0.f; }
        for (int idx = tid; idx < 2048; idx += NTHR) { const int r = idx >> 7, c = idx & 127; wg[idx] = wgk[r * 512 + h * 128 + c]; }
        __syncthreads();
        float bl[16];
        {
            float wr_[16];
#pragma unroll
            for (int r = 0; r < 16; ++r) wr_[r] = wg[r * 128 + kd];
            const float bias = bgk[h * 128 + kd]; float run = 0.f;
#pragma unroll
            for (int i = 0; i < 16; ++i) {
                const int t = 16 * q4 + i; float z = bias;
#pragma unroll
                for (int r = 0; r < 16; ++r) z += gls[t * 16 + r] * wr_[r];
                run += t < len ? logsigmoid_f(z) * (1.0f / 16.0f) : 0.f; bl[i] = run;
            }
            tot[q4 * 128 + kd] = run;
        }
        __syncthreads();
        {
            const float t0 = tot[kd], t1 = tot[128 + kd], t2 = tot[256 + kd], t3 = tot[384 + kd];
            const float off = (q4 > 0 ? t0 : 0.f) + (q4 > 1 ? t1 : 0.f) + (q4 > 2 ? t2 : 0.f), blast = (t0 + t1) + (t2 + t3);
            if (q4 == 0) DK[(size_t)slot * 128 + kd] = __expf(blast);
            float kh[16];
#pragma unroll
            for (int i = 0; i < 16; ++i) {
                const int t = 16 * q4 + i; const float bt = off + bl[i];
                if (t < len) BB[(size_t)(row0 + t) * 512 + h * 128 + kd] = bt;
                kh[i] = kf[i] * __expf(blast - bt);
            }
            u32x4 w0, w1;
            w0.x = pk2(kh[0], kh[1]); w0.y = pk2(kh[2], kh[3]); w0.z = pk2(kh[4], kh[5]); w0.w = pk2(kh[6], kh[7]);
            w1.x = pk2(kh[8], kh[9]); w1.y = pk2(kh[10], kh[11]); w1.z = pk2(kh[12], kh[13]); w1.w = pk2(kh[14], kh[15]);
            *(LAS u32x4*)(khT + kd * 72 + 16 * q4) = w0; *(LAS u32x4*)(khT + kd * 72 + 16 * q4 + 8) = w1;
        }
        {
            const bf16_t* vb = Pr + 1024 + h * 256;
#pragma nounroll
            for (int bt = 0; bt < 2; ++bt) {
                const unsigned tb = 32u * hv + 16u * bt; unsigned vr[8];
#pragma unroll
                for (int i = 0; i < 8; ++i) {
                    const unsigned ta = tb + 2u * i, ca = ta < (unsigned)len ? ta : 0u, cb = ta + 1u < (unsigned)len ? ta + 1u : 0u;
                    const unsigned lo = vb[ca * (unsigned)GLA_NP + vdv], hi = vb[cb * (unsigned)GLA_NP + vdv];
                    vr[i] = (ta < (unsigned)len ? lo : 0u) | ((ta + 1u < (unsigned)len ? hi : 0u) << 16);
                }
                u32x4 w0, w1; w0.x = vr[0]; w0.y = vr[1]; w0.z = vr[2]; w0.w = vr[3]; w1.x = vr[4]; w1.y = vr[5]; w1.z = vr[6]; w1.w = vr[7];
                *(LAS u32x4*)(vT + vdv * 72 + tb) = w0; *(LAS u32x4*)(vT + vdv * 72 + tb + 8) = w1;
            }
        }
        __syncthreads();
        f32x4 acc[2][8];
#pragma unroll
        for (int r = 0; r < 2; ++r)
#pragma unroll
            for (int c = 0; c < 8; ++c) acc[r][c] = (f32x4){0.f, 0.f, 0.f, 0.f};
#pragma unroll
        for (int ks = 0; ks < 2; ++ks) {
            bf16x8 a[2];
#pragma unroll
            for (int r = 0; r < 2; ++r) a[r] = *(const LAS bf16x8*)(vT + ((wid * 2 + r) * 16 + fr) * 72 + ks * 32 + fq * 8);
#pragma unroll
            for (int c = 0; c < 8; ++c) {
                const bf16x8 bfr = *(const LAS bf16x8*)(khT + (c * 16 + fr) * 72 + ks * 32 + fq * 8);
#pragma unroll
                for (int r = 0; r < 2; ++r) acc[r][c] = mfma16(a[r], bfr, acc[r][c]);
            }
        }
        float* sb = SB + (size_t)slot * 32768 + (unsigned)((wid * 32 + fq * 4) * 128 + fr);
#pragma unroll
        for (int r = 0; r < 2; ++r) {
            float* sbr = sb + r * 2048; asm volatile("" : "+v"(sbr));
#pragma unroll
            for (int c = 0; c < 8; ++c)
#pragma unroll
                for (int jj = 0; jj < 4; ++jj) sbr[jj * 128 + c * 16] = acc[r][c][jj];
        }
        __syncthreads();
    }
}

__device__ __forceinline__ void gla_g2(const Params& p, int j, int G, int bid) {
    float* SB = (float*)(p.ws + OFF_SB); const float* DK = (const float*)(p.ws + OFF_DK);
    int tid_ = threadIdx.x; asm volatile("" : "+v"(tid_));
    for (int e = bid * NTHR + tid_; e < 131072; e += G * NTHR) {
        const int h = e >> 15, vd = (e >> 7) & 255, kd = e & 127;
        float* ps = SB + (size_t)h * 32768 + vd * 128 + kd; const float* pd = DK + h * 128 + kd;
        float S = 0.f;
        for (int c0 = 0; c0 < 256; c0 += 16) {
            float ds[16], dd[16];
#pragma unroll
            for (int i = 0; i < 16; ++i) { ds[i] = ps[(size_t)(c0 + i) * 131072]; dd[i] = pd[(c0 + i) * 512]; }
            __builtin_amdgcn_sched_barrier(0);
#pragma unroll
            for (int i = 0; i < 16; ++i) { ps[(size_t)(c0 + i) * 131072] = S; S = dd[i] * S + ds[i]; }
        }
        p.out[O_GLAP + (size_t)j * 131072 + h * 32768 + kd * 256 + vd] = S;
    }
    const float* st = p.in[2] + (size_t)j * 8 * 131072;
    for (int e = bid * NTHR + tid_; e < 8 * 131072; e += G * NTHR) {
        const int b = e >> 17, h = (e >> 15) & 3, vd = (e >> 7) & 255, kd = e & 127, slot = 1024 + b * 4 + h;
        float* ps = SB + (size_t)slot * 32768 + vd * 128 + kd;
        const size_t so = (size_t)(b * 4 + h) * 32768 + kd * 256 + vd;
        const float S0 = st[so], ds = *ps, dd = DK[slot * 128 + kd];
        *ps = S0;
        p.out[O_GLAS + (size_t)j * 8 * 131072 + so] = dd * S0 + ds;
    }
}

__device__ __forceinline__ void gla_g3(LAS unsigned char* lds, const Params& p, int j, int G, int bid) {
    const bf16_t* P = (const bf16_t*)(p.ws + OFF_P); const float* SB = (const float*)(p.ws + OFF_SB); const float* BB = (const float*)(p.ws + OFF_BB);
    bf16_t* AB = (bf16_t*)(p.ws + OFF_AB); const float* gn = p.in[13] + (size_t)j * 256;
    LAS bf16_t* qt = (LAS bf16_t*)lds;
    LAS bf16_t* kt = (LAS bf16_t*)(lds + 17408);
    LAS bf16_t* sc = (LAS bf16_t*)(lds + 34816);
    LAS bf16_t* vT = (LAS bf16_t*)(lds + 44032);
    LAS float* part = (LAS float*)(lds + 80896);
    LAS bf16_t* rl = (LAS bf16_t*)(lds + 82944);
    int tid_ = threadIdx.x; asm volatile("" : "+v"(tid_)); const int tid = tid_, wid = tid >> 6, lane = tid & 63, fr = lane & 15, fq = lane >> 4;
    const int kd = tid & 127, q4 = tid >> 7, vdv = tid & 255, hv = tid >> 8;
    for (int slot = bid; slot < NSLOT; slot += G) {
        int row0, len, h; gla_item(slot, row0, len, h);
        const bf16_t* Pr = P + (size_t)row0 * GLA_NP;
        {
            float btv[16]; unsigned short qr[16], kr[16];
#pragma unroll
            for (int i = 0; i < 16; ++i) {
                const unsigned t = 16u * q4 + i, tc = t < (unsigned)len ? t : 0u; const unsigned po = tc * (unsigned)GLA_NP + h * 128 + kd;
                btv[i] = BB[(size_t)row0 * 512 + tc * 512u + h * 128 + kd]; qr[i] = Pr[po]; kr[i] = Pr[po + 512u];
            }
            __builtin_amdgcn_sched_barrier(0);
#pragma unroll
            for (int i = 0; i < 16; ++i) {
                const unsigned t = 16u * q4 + i; const bool ok = t < (unsigned)len;
                const float qv = bf2f(qr[i]) * 0.08838834764831845f * __expf(btv[i]), kv = bf2f(kr[i]) * __expf(-btv[i]);
                qt[t * 136 + kd] = f2bf(ok ? qv : 0.f); kt[t * 136 + kd] = f2bf(ok ? kv : 0.f);
            }
        }
        {
            const bf16_t* vb = Pr + 1024 + h * 256;
#pragma nounroll
            for (int bt = 0; bt < 2; ++bt) {
                const unsigned tb = 32u * hv + 16u * bt; unsigned vr[8];
#pragma unroll
                for (int i = 0; i < 8; ++i) {
                    const unsigned ta = tb + 2u * i, ca = ta < (unsigned)len ? ta : 0u, cb = ta + 1u < (unsigned)len ? ta + 1u : 0u;
                    const bf16_t* pa = vb + ca * (unsigned)GLA_NP + vdv; const bf16_t* pb = vb + cb * (unsigned)GLA_NP + vdv;
                    const unsigned lo = pa[0], hi = pb[0];
                    rl[ta * 264 + vdv] = pa[1024]; rl[(ta + 1u) * 264 + vdv] = pb[1024];
                    vr[i] = (ta < (unsigned)len ? lo : 0u) | ((ta + 1u < (unsigned)len ? hi : 0u) << 16);
                }
                u32x4 w0, w1; w0.x = vr[0]; w0.y = vr[1]; w0.z = vr[2]; w0.w = vr[3]; w1.x = vr[4]; w1.y = vr[5]; w1.z = vr[6]; w1.w = vr[7];
                *(LAS u32x4*)(vT + vdv * 72 + tb) = w0; *(LAS u32x4*)(vT + vdv * 72 + tb + 8) = w1;
            }
        }
        __syncthreads();
        const float* sp = SB + (size_t)slot * 32768 + (size_t)(wid * 32 + fr) * 128 + fq * 8;
        float4 spf[2][4][2];
#pragma unroll
        for (int c = 0; c < 2; ++c)
#pragma unroll
            for (int ks = 0; ks < 4; ++ks) { spf[c][ks][0] = *(const float4*)(sp + c * 2048 + ks * 32); spf[c][ks][1] = *(const float4*)(sp + c * 2048 + ks * 32 + 4); }
#pragma unroll
        for (int i = 0; i < 2; ++i) {
            const int ti = wid * 2 + i, rt = ti >> 2, ct = ti & 3;
            f32x4 a4 = (f32x4){0.f, 0.f, 0.f, 0.f};
            if (ct <= rt) {
#pragma unroll
                for (int ks = 0; ks < 4; ++ks) {
                    const bf16x8 a = *(const LAS bf16x8*)(qt + (rt * 16 + fr) * 136 + ks * 32 + fq * 8);
                    const bf16x8 b = *(const LAS bf16x8*)(kt + (ct * 16 + fr) * 136 + ks * 32 + fq * 8);
                    a4 = mfma16(a, b, a4);
                }
            }
#pragma unroll
            for (int jj = 0; jj < 4; ++jj) { const int t = rt * 16 + fq * 4 + jj, s = ct * 16 + fr; sc[t * 72 + s] = f2bf(s <= t ? a4[jj] : 0.f); }
        }
        __syncthreads();
        f32x4 acc[4][2];
#pragma unroll
        for (int r = 0; r < 4; ++r)
#pragma unroll
            for (int c = 0; c < 2; ++c) acc[r][c] = (f32x4){0.f, 0.f, 0.f, 0.f};
#pragma unroll
        for (int ks = 0; ks < 2; ++ks) {
            bf16x8 b[2];
#pragma unroll
            for (int c = 0; c < 2; ++c) b[c] = *(const LAS bf16x8*)(vT + (wid * 32 + c * 16 + fr) * 72 + ks * 32 + fq * 8);
#pragma unroll
            for (int r = 0; r < 4; ++r) {
                const bf16x8 a = *(const LAS bf16x8*)(sc + (r * 16 + fr) * 72 + ks * 32 + fq * 8);
#pragma unroll
                for (int c = 0; c < 2; ++c) acc[r][c] = mfma16(a, b[c], acc[r][c]);
            }
        }
#pragma unroll
        for (int ks = 0; ks < 4; ++ks) {
            bf16x8 b[2];
#pragma unroll
            for (int c = 0; c < 2; ++c) {
                const float4 x0 = spf[c][ks][0], x1 = spf[c][ks][1];
                u32x4 w; w.x = pk2(x0.x, x0.y); w.y = pk2(x0.z, x0.w); w.z = pk2(x1.x, x1.y); w.w = pk2(x1.z, x1.w);
                b[c] = __builtin_bit_cast(bf16x8, w);
            }
#pragma unroll
            for (int r = 0; r < 4; ++r) {
                const bf16x8 a = *(const LAS bf16x8*)(qt + (r * 16 + fr) * 136 + ks * 32 + fq * 8);
#pragma unroll
                for (int c = 0; c < 2; ++c) acc[r][c] = mfma16(a, b[c], acc[r][c]);
            }
        }
#pragma unroll
        for (int r = 0; r < 4; ++r)
#pragma unroll
            for (int jj = 0; jj < 4; ++jj) {
                float ss = acc[r][0][jj] * acc[r][0][jj] + acc[r][1][jj] * acc[r][1][jj];
                ss += __shfl_xor(ss, 1); ss += __shfl_xor(ss, 2); ss += __shfl_xor(ss, 4); ss += __shfl_xor(ss, 8);
                if (fr == 0) part[(r * 16 + fq * 4 + jj) * 8 + wid] = ss;
            }
        __syncthreads();
        const float gn0 = gn[wid * 32 + fr], gn1 = gn[wid * 32 + 16 + fr];
#pragma unroll
        for (int r = 0; r < 4; ++r)
#pragma unroll
            for (int jj = 0; jj < 4; ++jj) {
                const int t = r * 16 + fq * 4 + jj;
                const f32x4 p0 = *(const LAS f32x4*)(part + t * 8), p1 = *(const LAS f32x4*)(part + t * 8 + 4);
                const float tot = ((p0[0] + p0[1]) + (p0[2] + p0[3])) + ((p1[0] + p1[1]) + (p1[2] + p1[3]));
                const float rinv = __builtin_amdgcn_rsqf(tot * (1.0f / 256.0f) + LN_EPS);
                LAS bf16_t* ro = rl + t * 264 + wid * 32 + fr;
                ro[0] = f2bf(acc[r][0][jj] * rinv * gn0 * silu_f(bf2f(ro[0])));
                ro[16] = f2bf(acc[r][1][jj] * rinv * gn1 * silu_f(bf2f(ro[16])));
            }
        __syncthreads();
        for (int idx = tid; idx < len * 32; idx += NTHR) {
            const int t = idx >> 5, c16 = idx & 31;
            *(u32x4*)(AB + (size_t)(row0 + t) * D + h * 256 + c16 * 8) = *(const LAS u32x4*)(rl + t * 264 + c16 * 8);
        }
        __syncthreads();
    }
}

constexpr size_t OFF_VSTAT = OFF_BIG + (size_t)MT * 4096 * 2;
__device__ __forceinline__ void sg_phase(LAS unsigned char* lds, const Params& p, int j, int G, int bid) {
    bf16_t* U = (bf16_t*)(p.ws + OFF_BIG); const bf16_t* V = (const bf16_t*)(p.ws + OFF_BIG + (size_t)MT * 2048 * 2);
    const float* VS = (const float*)(p.ws + OFF_VSTAT);
    const float* lg = p.in[16] + (size_t)j * 2048; const float* lb = p.in[17] + (size_t)j * 2048;
    const float* wsp = p.in[18] + (size_t)j * 8 * 128 * 128; const float* bsp = p.in[19] + (size_t)j * 8 * 128;
    float* sgv = p.out + O_SGV + (size_t)j * 8 * 32 * 2048;
    LAS bf16_t* vnT = (LAS bf16_t*)lds;
    LAS bf16_t* wsA = (LAS bf16_t*)(lds + 69632);
    LAS float* stat = (LAS float*)(lds + 104448);
    LAS float* bsl = (LAS float*)(lds + 105472);
    int tid_ = threadIdx.x; asm volatile("" : "+v"(tid_)); const int tid = tid_, wid = tid >> 6, lane = tid & 63, fr = lane & 15, fq = lane >> 4;
    const int NIT = (128 + 8) * 8;
    for (int it = bid; it < NIT; it += G) {
        const int ci = it >> 3, g = it & 7; const bool samp = ci >= 128;
        const int row0 = samp ? MP + (ci - 128) * 32 : ci * 128, len = samp ? 32 : 128;
        if (tid < len) {
            const float4* sp = (const float4*)(VS + (size_t)(row0 + tid) * 64); float s = 0.f, q = 0.f;
#pragma unroll
            for (int i = 0; i < 16; ++i) { const float4 x = sp[i]; s += x.x + x.z; q += x.y + x.w; }
            const float mean = s * (1.0f / 2048.0f), var = q * (1.0f / 2048.0f) - mean * mean;
            stat[tid * 2] = mean; stat[tid * 2 + 1] = 1.0f / sqrtf(fmaxf(var, 0.f) + LN_EPS);
        }
        if (tid >= 384) bsl[tid - 384] = bsp[g * 128 + tid - 384];
        {
            const int tt = tid >> 2, s0 = (tid & 3) * 32; const float* wrow = wsp + (size_t)g * 16384 + tt * 128 + s0;
            float4 wa[4], wb[4];
#pragma unroll
            for (int i = 0; i < 4; ++i) { wa[i] = *(const float4*)(wrow + 8 * i); wb[i] = *(const float4*)(wrow + 8 * i + 4); }
            __builtin_amdgcn_sched_barrier(0);
#pragma unroll
            for (int i = 0; i < 4; ++i) {
                const float4 a = wa[i], b = wb[i]; const int sb = s0 + 8 * i;
                u32x4 w; w.x = pk2(sb + 0 <= tt ? a.x : 0.f, sb + 1 <= tt ? a.y : 0.f); w.y = pk2(sb + 2 <= tt ? a.z : 0.f, sb + 3 <= tt ? a.w : 0.f);
                w.z = pk2(sb + 4 <= tt ? b.x : 0.f, sb + 5 <= tt ? b.y : 0.f); w.w = pk2(sb + 6 <= tt ? b.z : 0.f, sb + 7 <= tt ? b.w : 0.f);
                *(LAS u32x4*)(wsA + tt * 136 + sb) = w;
            }
        }
        __syncthreads();
        {
            const int d = tid & 255, hh = tid >> 8; const float lgd = lg[g * 256 + d], lbd = lb[g * 256 + d];
            const bf16_t* vb = V + (size_t)row0 * 2048 + g * 256 + d;
#pragma nounroll
            for (int bt = 0; bt < 4; ++bt) {
                const unsigned sb = 64u * hh + 16u * bt; float vn[16];
#pragma unroll
                for (int i = 0; i < 16; ++i) {
                    const unsigned s = sb + i, sc_ = s < (unsigned)len ? s : 0u;
                    const float x = (bf2f(vb[sc_ * 2048u]) - stat[sc_ * 2]) * stat[sc_ * 2 + 1] * lgd + lbd;
                    vn[i] = s < (unsigned)len ? x : 0.f;
                }
                if (samp && sb < (unsigned)len) {
#pragma unroll
                    for (int i = 0; i < 16; ++i) sgv[(size_t)(row0 - MP + sb + i) * 2048 + g * 256 + d] = vn[i];
                }
                u32x4 w0, w1;
                w0.x = pk2(vn[0], vn[1]); w0.y = pk2(vn[2], vn[3]); w0.z = pk2(vn[4], vn[5]); w0.w = pk2(vn[6], vn[7]);
                w1.x = pk2(vn[8], vn[9]); w1.y = pk2(vn[10], vn[11]); w1.z = pk2(vn[12], vn[13]); w1.w = pk2(vn[14], vn[15]);
                *(LAS u32x4*)(vnT + d * 136 + sb) = w0; *(LAS u32x4*)(vnT + d * 136 + sb + 8) = w1;
            }
        }
        __syncthreads();
        f32x4 acc[8][2];
#pragma unroll
        for (int r = 0; r < 8; ++r)
#pragma unroll
            for (int c = 0; c < 2; ++c) acc[r][c] = (f32x4){0.f, 0.f, 0.f, 0.f};
#pragma unroll
        for (int ks = 0; ks < 4; ++ks) {
            bf16x8 b[2];
#pragma unroll
            for (int c = 0; c < 2; ++c) b[c] = *(const LAS bf16x8*)(vnT + (wid * 32 + c * 16 + fr) * 136 + ks * 32 + fq * 8);
#pragma unroll
            for (int r = 0; r < 8; ++r) {
                if (ks * 32 <= r * 16 + 15) {
                    const bf16x8 a = *(const LAS bf16x8*)(wsA + (r * 16 + fr) * 136 + ks * 32 + fq * 8);
#pragma unroll
                    for (int c = 0; c < 2; ++c) acc[r][c] = mfma16(a, b[c], acc[r][c]);
                }
            }
        }
        __syncthreads();
#pragma unroll
        for (int r = 0; r < 8; ++r)
#pragma unroll
            for (int jj = 0; jj < 4; ++jj) {
                const int t = r * 16 + fq * 4 + jj; const float bsv = bsl[t];
                LAS bf16_t* so = vnT + t * 264 + wid * 32 + fr;
                so[0] = f2bf(acc[r][0][jj] + bsv); so[16] = f2bf(acc[r][1][jj] + bsv);
            }
        __syncthreads();
        for (int idx = tid; idx < len * 32; idx += NTHR) {
            const int t = idx >> 5, c16 = idx & 31;
            bf16_t* up = U + (size_t)(row0 + t) * 2048 + g * 256 + c16 * 8;
            const u32x4 uw = *(const u32x4*)up, sw = *(const LAS u32x4*)(vnT + t * 264 + c16 * 8);
            u32x4 w; w.x = pk2(bflo(uw.x) * bflo(sw.x), bfhi(uw.x) * bfhi(sw.x)); w.y = pk2(bflo(uw.y) * bflo(sw.y), bfhi(uw.y) * bfhi(sw.y));
            w.z = pk2(bflo(uw.z) * bflo(sw.z), bfhi(uw.z) * bfhi(sw.z)); w.w = pk2(bflo(uw.w) * bflo(sw.w), bfhi(uw.w) * bfhi(sw.w));
            *(u32x4*)up = w;
        }
        __syncthreads();
    }
}

template <int K> __device__ __forceinline__ void skinny_out(LAS unsigned char* lds, const bf16_t* __restrict__ A, const bf16_t* __restrict__ Bt, float* X, const bf16_t* XB, float alpha, float scale, int G, int bid) {
    int tid_ = threadIdx.x; asm volatile("" : "+v"(tid_)); const int tid = tid_, wid = tid >> 6, lane = tid & 63, fr = lane & 15, fq = lane >> 4;
    LAS float* part = (LAS float*)lds;
    constexpr int KW = K / 8;
    for (int it = bid; it < 256; it += G) {
        const int rf = it >> 4, cc = it & 15;
        const bf16_t* ap = A + (size_t)(MP + rf * 16 + fr) * K + wid * KW + fq * 8;
        const bf16_t* bp = Bt + (size_t)(cc * 64 + fr) * K + wid * KW + fq * 8;
        f32x4 acc[4];
#pragma unroll
        for (int c = 0; c < 4; ++c) acc[c] = (f32x4){0.f, 0.f, 0.f, 0.f};
        {
            constexpr int NB = (KW + 127) / 128;
            bf16x8 a[2][4], bq[2][4][4];
#define SK_LOAD(set, k0) _Pragma("unroll") for (int s = 0; s < 4; ++s) if ((k0) + s * 32 < KW) { a[set][s] = *(const bf16x8*)(ap + (k0) + s * 32); \
                _Pragma("unroll") for (int c = 0; c < 4; ++c) bq[set][s][c] = *(const bf16x8*)(bp + (size_t)c * 16 * K + (k0) + s * 32); }
#define SK_MMA(set, k0) _Pragma("unroll") for (int s = 0; s < 4; ++s) if ((k0) + s * 32 < KW) { _Pragma("unroll") for (int c = 0; c < 4; ++c) acc[c] = mfma16(a[set][s], bq[set][s][c], acc[c]); }
            SK_LOAD(0, 0)
#pragma unroll
            for (int ib = 0; ib < NB; ++ib) {
                if (ib + 1 < NB) { SK_LOAD((ib + 1) & 1, (ib + 1) * 128) }
                __builtin_amdgcn_sched_barrier(0);
                SK_MMA(ib & 1, ib * 128)
                __builtin_amdgcn_sched_barrier(0);
            }
#undef SK_LOAD
#undef SK_MMA
        }
#pragma unroll
        for (int c = 0; c < 4; ++c)
#pragma unroll
            for (int jj = 0; jj < 4; ++jj) part[(wid * 16 + fq * 4 + jj) * 64 + c * 16 + fr] = acc[c][jj];
        __syncthreads();
        for (int e = tid; e < 1024; e += NTHR) {
            const int r = e >> 6, c = e & 63; float s = 0.f;
#pragma unroll
            for (int w = 0; w < 8; ++w) s += part[(w * 16 + r) * 64 + c];
            const size_t xo = (size_t)(MP + rf * 16 + r) * D + cc * 64 + c;
            X[xo] = alpha * bf2f(XB[xo]) + scale * s;
        }
        __syncthreads();
    }
}

#ifndef PROBE_CLASS
#define PROBE_CLASS 0
#endif
#define PB(c) { if (PROBE_CLASS && ((PROBE_MASK >> (c)) & 1)) t0_ = wall_clock64(); }
#define PE(c) { if (PROBE_CLASS && ((PROBE_MASK >> (c)) & 1)) t_acc += wall_clock64() - t0_; }
#ifndef PROBE_MASK
#define PROBE_MASK 0
#endif
#define XB_TMO      128
#define XB_XCNT(j)  (256  + 64 * (j))
#define XB_XSUB(j)  (1280 + 64 * (j))
#define XB_XGEN(j)  (2304 + 64 * (j))
#define XB_TOP      3328
#define XB_TOPGEN   3392
#define XCD_BAR_WORDS 3456
#define XB_SPIN_CAP (1u << 18)

__device__ __forceinline__ unsigned xb_ld(unsigned* p)              { return __hip_atomic_load(p, __ATOMIC_RELAXED, __HIP_MEMORY_SCOPE_AGENT); }
__device__ __forceinline__ unsigned xb_add(unsigned* p, unsigned v) { return __hip_atomic_fetch_add(p, v, __ATOMIC_RELAXED, __HIP_MEMORY_SCOPE_AGENT); }
__device__ __forceinline__ unsigned xb_xcc_id() { return (unsigned)__builtin_amdgcn_s_getreg((3 << 11) | 20) & 0xFu; }
#define XB_SPIN(cond, bar) do { unsigned _sp = 0; while (cond) { __builtin_amdgcn_s_sleep(1); \
    if ((++_sp & 255u) == 0u) { if (xb_ld(&(bar)[XB_TMO])) break; if (_sp > XB_SPIN_CAP) { atomicAdd(&(bar)[XB_TMO], 1u); break; } } } } while (0)

struct XcdBarrier {
    unsigned* bar; unsigned x;
    volatile LAS unsigned* st;
};

__device__ __forceinline__ XcdBarrier xcd_barrier_post(unsigned* bar, volatile LAS unsigned* st) {
    XcdBarrier b; b.bar = bar; b.x = xb_xcc_id(); b.st = st;
    if (threadIdx.x == 0) (void)xb_add(&bar[XB_XCNT(b.x)], 1u);
    return b;
}
__device__ __forceinline__ void xcd_barrier_complete(unsigned* bar, unsigned x, unsigned& nloc, unsigned& nx) {
    const unsigned G = gridDim.x * gridDim.y * gridDim.z;
    unsigned sum, cnt, mine, sp = 0u;
    for (;;) {
        sum = 0u; cnt = 0u; mine = 0u;
#pragma unroll
        for (unsigned j = 0; j < 16; ++j) { const unsigned c = xb_ld(&bar[XB_XCNT(j)]); sum += c; cnt += (c > 0u) ? 1u : 0u; mine = (j == x) ? c : mine; }
        if (sum == G) break;
        __builtin_amdgcn_s_sleep(1);
        if ((++sp & 255u) == 0u) { if (xb_ld(&bar[XB_TMO])) break; if (sp > XB_SPIN_CAP) { atomicAdd(&bar[XB_TMO], 1u); break; } }
    }
    nloc = mine > 0u ? mine : 1u; nx = cnt > 0u ? cnt : 1u;
}

__device__ __forceinline__ void xcd_barrier(const XcdBarrier& b) {
    asm volatile("s_waitcnt vmcnt(0)" ::: "memory");
    __syncthreads();
    if (threadIdx.x == 0) {
        unsigned* bar = b.bar;
        __builtin_amdgcn_s_waitcnt(0);
        unsigned nloc = b.st[0], nx = b.st[1];
        if (nloc == 0u) { xcd_barrier_complete(bar, b.x, nloc, nx); b.st[0] = nloc; b.st[1] = nx; }
        const unsigned old = xb_add(&bar[XB_XSUB(b.x)], 1u);
        const unsigned gen = old / nloc;
        if (old + 1u == (gen + 1u) * nloc) {
            __builtin_amdgcn_fence(__ATOMIC_RELEASE, "agent");
            asm volatile("s_waitcnt vmcnt(0)" ::: "memory");
            const unsigned og = xb_add(&bar[XB_TOP], 1u);
            const unsigned tg = og / nx;
            if (og + 1u == (tg + 1u) * nx) xb_add(&bar[XB_TOPGEN], 1u);
            else XB_SPIN(xb_ld(&bar[XB_TOPGEN]) == tg, bar);
            __builtin_amdgcn_fence(__ATOMIC_ACQUIRE, "agent");
            xb_add(&bar[XB_XGEN(b.x)], 1u);
            asm volatile("s_waitcnt vmcnt(0)" ::: "memory");
        } else {
            XB_SPIN(xb_ld(&bar[XB_XGEN(b.x)]) == gen, bar);
            __builtin_amdgcn_fence(__ATOMIC_ACQUIRE, "agent");
            asm volatile("s_waitcnt vmcnt(0)" ::: "memory");
        }
    }
    __syncthreads();
}


#define XSYNC() { if (PROBE_CLASS && ((PROBE_MASK >> 11) & 1)) { t0_ = wall_clock64(); grid.sync(); t_acc += wall_clock64() - t0_; } }
__global__ void __launch_bounds__(NTHR, 2) mega(Params p) {
    extern __shared__ __attribute__((aligned(16))) unsigned char lds_raw[];
    LAS unsigned char* lds = (LAS unsigned char*)lds_raw;
    cg::grid_group grid = cg::this_grid();
    const int G = gridDim.x, bid = blockIdx.x;
    float* X = p.out + O_Y; bf16_t* XB = (bf16_t*)(p.ws + OFF_XB); bf16_t* WT = (bf16_t*)(p.ws + OFF_WT);
    bf16_t* BIG = (bf16_t*)(p.ws + OFF_BIG);

    unsigned long long t_acc = 0, t0_ = 0;
    volatile LAS unsigned* xb_st = (volatile LAS unsigned*)(lds + 135 * 1024);
    if (threadIdx.x < 4) xb_st[threadIdx.x] = 0u;
    __syncthreads();
    const XcdBarrier xbar = xcd_barrier_post((unsigned*)(p.ws + OFF_CTR), xb_st);
#define GB() { xcd_barrier(xbar); if (PROBE_CLASS && ((PROBE_MASK >> 11) & 1)) { t0_ = wall_clock64(); xcd_barrier(xbar); t_acc += wall_clock64() - t0_; } }
    PB(9);
    init_phase(p, G, bid);
    convert_layer(lds, p, 0, G, bid);
    if (p.ws == nullptr) grid.sync();
    GB();
    PE(9);

    for (int l = 0; l < 4; ++l) {
        const int mixer = l % 3, j = l / 3;
        for (int sub = 0; sub < 3; ++sub) {
            const bf16_t* Aout; const bf16_t* Wout; int Kout; float scale;
            if (sub != 1) {
                PB(1);
                pg8::Gemm g{XB, WT + (sub == 0 ? W_1IN : W_2IN), MT, 2 * DFF, D}; pg8::StaticOrder S; S.init(MT, 2 * DFF, G, bid);
                EpiPair<1> E{BIG, DFF};
                pg8::gemm_phase<EpiPair<1>, pg8::StaticOrder>(lds, g, S, E, nullptr);
                Aout = BIG; Wout = WT + (sub == 0 ? W_1OUT : W_2OUT); Kout = DFF; scale = 0.5f;
                GB();
                PE(1);
            } else if (mixer == 0) {
                PB(1);
                { pg8::Gemm g{XB, WT + W_MIN, MT, GLA_NP, D}; pg8::StaticOrder S; S.init(MT, GLA_NP, G, bid);
                  EpiBf<0> E{(bf16_t*)(p.ws + OFF_P), GLA_NP, 0, 0};
                  pg8::gemm_phase<EpiBf<0>, pg8::StaticOrder>(lds, g, S, E, nullptr); }
                GB();
                PE(1);
                PB(4);
                gla_g1(lds, p, j, G, bid);
                GB();
                PE(4);
                PB(5);
                gla_g2(p, j, G, bid);
                GB();
                PE(5);
                PB(6);
                gla_g3(lds, p, j, G, bid);
                GB();
                PE(6);
                Aout = (const bf16_t*)(p.ws + OFF_AB); Wout = WT + W_MOUT; Kout = D; scale = 1.0f;
            } else if (mixer == 1) {
                PB(1);
                { pg8::Gemm g{XB, WT + W_MIN, MT, 4096, D}; pg8::StaticOrder S; S.init(MT, 4096, G, bid);
                  EpiBf<1> E{BIG, 2048, 2048, (size_t)MT * 2048, (float*)(p.ws + OFF_VSTAT)};
                  pg8::gemm_phase<EpiBf<1>, pg8::StaticOrder>(lds, g, S, E, nullptr); }
                GB();
                PE(1);
                PB(7);
                sg_phase(lds, p, j, G, bid);
                GB();
                PE(7);
                Aout = BIG; Wout = WT + W_MOUT; Kout = 2048; scale = 1.0f;
            } else {
                PB(1);
                { pg8::Gemm g{XB, WT + W_MIN, MT, 3072, D}; pg8::StaticOrder S; S.init(MT, 3072, G, bid);
                  EpiConv E{BIG, BIG + (size_t)MT * D};
                  pg8::gemm_phase<EpiConv, pg8::StaticOrder>(lds, g, S, E, nullptr); }
                GB();
                PE(1);
                PB(8);
                conv_phase(p, j, G, bid);
                GB();
                PE(8);
                Aout = BIG + (size_t)MT * D; Wout = WT + W_MOUT; Kout = D; scale = 1.0f;
            }
            if (sub != 1) PB(2) else PB(10)
            { pg8::Gemm g{Aout, Wout, MP, D, Kout}; pg8::StaticOrder S; S.init(MP, D, G, bid);
              EpiRes E{X, XB, ALPHA, scale};
              if (sub != 1) PB(12)
              pg8::gemm_phase<EpiRes, pg8::StaticOrder>(lds, g, S, E, nullptr);
              if (sub != 1) PE(12) }
            if (sub != 1) PB(13)
            if (Kout == DFF) skinny_out<DFF>(lds, Aout, Wout, X, XB, ALPHA, scale, G, bid);
            else if (Kout == 2048) skinny_out<2048>(lds, Aout, Wout, X, XB, ALPHA, scale, G, bid);
            else skinny_out<1024>(lds, Aout, Wout, X, XB, ALPHA, scale, G, bid);
            if (sub != 1) PE(13)
            GB();
            if (sub != 1) PE(2) else PE(10)
            PB(3);
            ln_phase(X, XB, p.in[4] + (size_t)(l * 3 + sub) * D, p.in[5] + (size_t)(l * 3 + sub) * D, G, bid, sub == 2 && l == 3);
            if (sub == 2 && l < 3) convert_layer(lds, p, l + 1, G, bid);
            if (!(sub == 2 && l == 3)) GB();
            PE(3);
        }
    }
    if (PROBE_CLASS) { __syncthreads(); if (bid == 0 && threadIdx.x == 0) X[0] += (float)t_acc * (0.01f / 256.0f); }
}

extern "C" void kernel_launch(void* const* d_in, const int* in_sizes, int n_in, void* d_out, int out_size, void* d_ws, size_t ws_size, hipStream_t stream) {
    static int grid_blocks = 0;
    if (grid_blocks == 0) {
        if (n_in != 24 || ws_size < WS_END) { fprintf(stderr, "kernel_launch: unexpected n_in %d or ws_size %zu (< %zu)\n", n_in, ws_size, (size_t)WS_END); grid_blocks = -1; return; }
        int dev = 0, cus = 0, per_cu = 0;
        hipGetDevice(&dev);
        hipDeviceGetAttribute(&cus, hipDeviceAttributeMultiprocessorCount, dev);
        if (hipFuncSetAttribute((const void*)mega, hipFuncAttributeMaxDynamicSharedMemorySize, LDS_BYTES) != hipSuccess) { fprintf(stderr, "kernel_launch: hipFuncSetAttribute failed\n"); grid_blocks = -1; return; }
        if (hipOccupancyMaxActiveBlocksPerMultiprocessor(&per_cu, (const void*)mega, NTHR, LDS_BYTES) != hipSuccess || per_cu < 1) { fprintf(stderr, "kernel_launch: occupancy query says %d\n", per_cu); per_cu = 1; }
        (void)hipGetLastError();
        grid_blocks = cus * 1;
    }
    if (grid_blocks < 0) return;
    Params p{};
    for (int i = 0; i < 24; ++i) p.in[i] = (const float*)d_in[i];
    p.out = (float*)d_out; p.ws = (unsigned char*)d_ws;
    if (hipMemsetAsync((char*)d_ws + OFF_CTR, 0, 16384, stream) != hipSuccess) { fprintf(stderr, "kernel_launch: memset of the barrier counter failed\n"); return; }
    void* args[] = {&p};
    hipError_t e = hipLaunchCooperativeKernel((const void*)mega, dim3(grid_blocks), dim3(NTHR), args, LDS_BYTES, stream);
    if (e != hipSuccess) fprintf(stderr, "cooperative launch failed: %s (grid %d)\n", hipGetErrorString(e), grid_blocks);
}
```

```cpp
#include <hip/hip_runtime.h>
#include <hip/hip_cooperative_groups.h>
#include <cstdio>
namespace cg = cooperative_groups;
namespace pg8 {
#define PG8_LAS __attribute__((address_space(3)))
typedef unsigned short bf16_t;
typedef short bf16x8 __attribute__((ext_vector_type(8)));
typedef float f32x4 __attribute__((ext_vector_type(4)));
typedef unsigned u32x4 __attribute__((ext_vector_type(4)));
constexpr int BM = 256, BK = 64, HALF = 128, HTB = HALF * BK * 2  , STAGE_BYTES = 8 * HTB, NXCD = 8, WGM = 8;

__host__ __device__ __forceinline__ int lds_byte(int r, int c) { const int st = (r >> 4) * 2 + (c >> 5), rr = r & 15, cc = c & 31, ob = rr * 64 + cc * 2; return st * 1024 + (ob ^ (((ob >> 9) & 1) << 5)); }
__host__ __device__ __forceinline__ void stage_rc(int b, int& R, int& C) { const int st = b / 1024, sb = b % 1024, swz = sb ^ (((sb >> 9) & 1) << 5); R = (st >> 1) * 16 + swz / 64; C = (st & 1) * 32 + (swz % 64) / 2; }
__host__ __device__ __forceinline__ int perm32(int rho) { const int n = rho >> 4, i = rho & 15; return 8 * (i >> 2) + 4 * n + (i & 3); }

struct Unit { int pm, pn; };
struct Gemm { const bf16_t* A; const bf16_t* Bt; int M, N, K; };

struct StaticOrder {
    int nM, nN, nwg, G, c;
    __host__ __device__ void init(int M, int N, int G_, int c_) { nM = M / BM; nN = N / BM; nwg = nM * nN; G = G_; c = c_; }
    __host__ __device__ bool next(int i, Unit& u) const {
        const long L = (long)i * G + c; if (L >= nwg) return false;
        int wgid = (int)L; { const int q = nwg / NXCD, r = nwg % NXCD, xcd = wgid % NXCD, off = wgid / NXCD; wgid = (xcd < r ? xcd * (q + 1) : r * (q + 1) + (xcd - r) * q) + off; }
        const int nig = WGM * nN, gid = wgid / nig, fm = gid * WGM, gsz = (nM - fm) < WGM ? (nM - fm) : WGM;
        u.pm = fm + ((wgid % nig) % gsz); u.pn = (wgid % nig) / gsz; return true;
    }
    __device__ __forceinline__ void a_ready(const Unit&) const {}
    __device__ __forceinline__ void done(const Unit&) const {}
};
struct CountedOrder : StaticOrder {
    const unsigned* ready; unsigned need; unsigned* tmo;
    __device__ __forceinline__ void a_ready(const Unit& u) const {
        if (threadIdx.x < 64) {
            const unsigned long long t0 = __builtin_amdgcn_s_memrealtime(); unsigned polls = 0;
            while ((unsigned)__builtin_amdgcn_readfirstlane(__hip_atomic_load(ready + 64 * u.pm, __ATOMIC_RELAXED, __HIP_MEMORY_SCOPE_AGENT)) < need) {
                if ((++polls & 255u) == 0u && __builtin_amdgcn_readfirstlane(__hip_atomic_load(tmo, __ATOMIC_RELAXED, __HIP_MEMORY_SCOPE_AGENT)) != 0u) break;
                if (__builtin_amdgcn_s_memrealtime() - t0 > 2000000ull) {
                    if (threadIdx.x == 0) { unsigned expect = 0u; __hip_atomic_compare_exchange_strong(tmo + 1, &expect, 0x600u | (unsigned)(u.pm & 0xff), __ATOMIC_RELAXED, __ATOMIC_RELAXED, __HIP_MEMORY_SCOPE_AGENT); __hip_atomic_store(tmo, 1u, __ATOMIC_RELAXED, __HIP_MEMORY_SCOPE_AGENT); }
                    break; }
                __builtin_amdgcn_s_sleep(2); }
            __builtin_amdgcn_fence(__ATOMIC_ACQUIRE, "agent");
            asm volatile("s_waitcnt vmcnt(0)" ::: "memory");
        }
#if !defined(BROKEN_HOOK_NO_BARRIER)
        asm volatile("" ::: "memory"); __builtin_amdgcn_s_barrier(); asm volatile("" ::: "memory");
#endif
    }
};

__device__ __forceinline__ unsigned cvt_pk_bf16(float lo, float hi) { unsigned r; asm volatile("v_cvt_pk_bf16_f32 %0, %1, %2" : "=v"(r) : "v"(lo), "v"(hi)); return r; }
typedef float f32x2 __attribute__((ext_vector_type(2)));
__device__ __forceinline__ f32x2 gelu_pk(f32x2 v) {
    const f32x2 av = __builtin_elementwise_abs(v), d = av * 0.2316418882f + 1.0f;
    f32x2 t; t.x = __builtin_amdgcn_rcpf(d.x); t.y = __builtin_amdgcn_rcpf(d.y);
    f32x2 q = t * 0.5307027145f + (-0.7265760135f); q = q * t + 0.7107068705f; q = q * t + (-0.142248368f); q = q * t + 0.127414796f; q = q * t;
    const f32x2 s = (v * v) * (-0.72134752044f);
    f32x2 e; e.x = __builtin_amdgcn_exp2f(s.x); e.y = __builtin_amdgcn_exp2f(s.y);
    const f32x2 m = v * (q * e), r = v - m;
    f32x2 o; o.x = v.x < 0.f ? m.x : r.x; o.y = v.y < 0.f ? m.y : r.y; return o;
}

template <class Epi, class Sched, bool STAMP = false>
__device__ __forceinline__ void gemm_phase(PG8_LAS unsigned char* lds, const Gemm g, const Sched& S, const Epi& E, unsigned long long* stamps) {
    int tid_ = threadIdx.x; asm volatile("" : "+v"(tid_)); const int tid = tid_, wid = __builtin_amdgcn_readfirstlane(tid >> 6), lane = tid & 63, wr = wid >> 2, wc = wid & 3, fr = lane & 15, fq = lane >> 4;
    const int K = g.K, nt = K / BK;
    int ts_lo = 0, ts_hi = 0, nts = 0; const unsigned long long rt_entry = STAMP ? (unsigned long long)wall_clock64() : 0ull;
#define PG8_STAMP() do { if (STAMP && wid == 0 && nts < 64) { const unsigned long long _c = (unsigned long long)clock64(); \
        ts_lo = (lane == nts) ? (int)(unsigned)_c : ts_lo; ts_hi = (lane == nts) ? (int)(unsigned)(_c >> 32) : ts_hi; ++nts; } } while (0)
    PG8_STAMP();
    unsigned voffA[2], voffB[2];
#pragma unroll
    for (int i = 0; i < 2; ++i) { int R, C; stage_rc(tid * 16 + i * 8192, R, C); const int Rb = Epi::PERM ? ((R & ~31) + perm32(R & 31)) : R;
        voffA[i] = (unsigned)(R * K + C) * 2u; voffB[i] = (unsigned)(Rb * K + C) * 2u; }
    const size_t kstep = (size_t)(BK * 2);
    const size_t hstep = (size_t)HALF * K * 2;
    const size_t tstep = 2 * hstep;
    const unsigned ldsw = (unsigned)wid * 1024u;
    const int aoff = lds_byte(wr * 64 + fr, fq * 8), boff = lds_byte(wc * 32 + fr, fq * 8);
#define PG8_SA(b, h) (((b) * 2 + (h)) * HTB)
#define PG8_SB(b, h) ((4 + (b) * 2 + (h)) * HTB)
#define PG8_STAGE(bufoff, gbase, voff) do { _Pragma("unroll") for (int _i = 0; _i < 2; ++_i) \
        __builtin_amdgcn_global_load_lds((const unsigned*)((const char*)(gbase) + (voff)[_i]), (PG8_LAS unsigned*)(lds + (bufoff) + ldsw + _i * 8192), 16, 0, 0); } while (0)
#define PG8_LDA(dst, b, h) do { _Pragma("unroll") for (int m = 0; m < 4; ++m) _Pragma("unroll") for (int k = 0; k < 2; ++k) dst[m][k] = *(const PG8_LAS bf16x8*)(lds + PG8_SA(b, h) + aoff + m * 2048 + k * 1024); } while (0)
#define PG8_LDB(dst, b, h) do { _Pragma("unroll") for (int n = 0; n < 2; ++n) _Pragma("unroll") for (int k = 0; k < 2; ++k) dst[n][k] = *(const PG8_LAS bf16x8*)(lds + PG8_SB(b, h) + boff + n * 2048 + k * 1024); } while (0)
#define PG8_MMA(ai, bj, At, Bt) do { __builtin_amdgcn_s_setprio(1); _Pragma("unroll") for (int m = 0; m < 4; ++m) _Pragma("unroll") for (int n = 0; n < 2; ++n) _Pragma("unroll") for (int k = 0; k < 2; ++k) \
        acc[ai][bj][m][n] = __builtin_amdgcn_mfma_f32_16x16x32_bf16(Bt[n][k], At[m][k], acc[ai][bj][m][n], 0, 0, 0); __builtin_amdgcn_s_setprio(0); } while (0)
#define PG8_WAIT_V(n) asm volatile("s_waitcnt vmcnt(" #n ")" ::: "memory")
#define PG8_WAIT_L(n) asm volatile("s_waitcnt lgkmcnt(" #n ")" ::: "memory")
#define PG8_BAR __builtin_amdgcn_s_barrier()
#define PG8_SCHED __builtin_amdgcn_sched_barrier(0)
    Unit cur, nxt; int ui = 0;
    if (!S.next(0, cur)) return;
    f32x4 acc[2][2][4][2];
#pragma unroll
    for (int a = 0; a < 2; ++a)
#pragma unroll
        for (int b = 0; b < 2; ++b)
#pragma unroll
            for (int m = 0; m < 4; ++m)
#pragma unroll
                for (int n = 0; n < 2; ++n) acc[a][b][m][n] = (f32x4){0.f, 0.f, 0.f, 0.f};
    bf16x8 At[4][2], B0[2][2], B1[2][2];
    const char* cA = (const char*)g.A + (size_t)cur.pm * tstep; const char* cB = (const char*)g.Bt + (size_t)cur.pn * tstep;
    S.a_ready(cur);
    PG8_STAGE(PG8_SB(0, 0), cB, voffB); PG8_STAGE(PG8_SA(0, 0), cA, voffA); PG8_STAGE(PG8_SB(0, 1), cB + hstep, voffB); PG8_STAGE(PG8_SA(0, 1), cA + hstep, voffA);
    if (wr == 1) PG8_BAR;
    PG8_WAIT_V(4); PG8_BAR;
    PG8_STAGE(PG8_SB(1, 0), cB + kstep, voffB); PG8_STAGE(PG8_SA(1, 0), cA + kstep, voffA); PG8_STAGE(PG8_SB(1, 1), cB + hstep + kstep, voffB);
    PG8_WAIT_V(6); PG8_BAR;
    PG8_STAMP();
    for (;;) {
        const bool has_next = S.next(ui + 1, nxt);
        const char* nA = has_next ? (const char*)g.A + (size_t)nxt.pm * tstep : cA; const char* nB = has_next ? (const char*)g.Bt + (size_t)nxt.pn * tstep : cB;
        for (int t = 0; t < nt; t += 2) {
            const bool last = (t == nt - 2);
            const char* a1 = cA + (size_t)(t + 1) * kstep;
            const char* a2 = last ? nA : cA + (size_t)(t + 2) * kstep; const char* b2 = last ? nB : cB + (size_t)(t + 2) * kstep;
            const char* a3 = a2 + kstep; const char* b3 = b2 + kstep;
            if (last && has_next) S.a_ready(nxt);
            PG8_LDB(B0, 0, 0); PG8_SCHED; PG8_LDA(At, 0, 0); PG8_STAGE(PG8_SA(1, 1), a1 + hstep, voffA);
            PG8_WAIT_L(8); PG8_BAR; PG8_WAIT_L(0); PG8_MMA(0, 0, At, B0); PG8_BAR; PG8_SCHED;
            PG8_LDB(B1, 0, 1); PG8_STAGE(PG8_SB(0, 0), b2, voffB);
            PG8_BAR; PG8_WAIT_L(0); PG8_MMA(0, 1, At, B1); PG8_BAR;
            PG8_LDA(At, 0, 1); PG8_STAGE(PG8_SA(0, 0), a2, voffA);
            PG8_BAR; PG8_WAIT_L(0); PG8_MMA(1, 0, At, B0); PG8_BAR; PG8_SCHED;
            PG8_STAGE(PG8_SB(0, 1), b2 + hstep, voffB);
            PG8_WAIT_V(6); PG8_BAR; PG8_MMA(1, 1, At, B1); PG8_BAR;
            PG8_LDB(B0, 1, 0); PG8_SCHED; PG8_LDA(At, 1, 0); PG8_STAGE(PG8_SA(0, 1), a2 + hstep, voffA);
            PG8_WAIT_L(8); PG8_BAR; PG8_WAIT_L(0); PG8_MMA(0, 0, At, B0); PG8_BAR; PG8_SCHED;
            PG8_LDB(B1, 1, 1); PG8_STAGE(PG8_SB(1, 0), b3, voffB);
            PG8_BAR; PG8_WAIT_L(0); PG8_MMA(0, 1, At, B1); PG8_BAR;
            PG8_LDA(At, 1, 1); PG8_STAGE(PG8_SA(1, 0), a3, voffA);
            PG8_BAR; PG8_WAIT_L(0); PG8_MMA(1, 0, At, B0); PG8_BAR; PG8_SCHED;
            PG8_STAGE(PG8_SB(1, 1), b3 + hstep, voffB);
            PG8_WAIT_V(6); PG8_BAR; PG8_MMA(1, 1, At, B1); PG8_BAR;
        }
        PG8_STAMP();
        if constexpr (!Epi::AFTER_DRAIN) { E(acc, cur, wr, wc, fr, fq); S.done(cur); }
        PG8_STAMP();
        if (!has_next) break;
#pragma unroll
        for (int a = 0; a < 2; ++a)
#pragma unroll
            for (int b = 0; b < 2; ++b)
#pragma unroll
                for (int m = 0; m < 4; ++m)
#pragma unroll
                    for (int n = 0; n < 2; ++n) acc[a][b][m][n] = (f32x4){0.f, 0.f, 0.f, 0.f};
        cur = nxt; cA = nA; cB = nB; ++ui;
    }
    PG8_WAIT_V(0);
    if (wr == 0) PG8_BAR;
    PG8_BAR;
    if constexpr (Epi::AFTER_DRAIN) { E.fused(acc, cur, wr, wc, fr, fq, lds, wid, lane); S.done(cur); }
    PG8_STAMP();
    if (STAMP && wid == 0) { stamps[lane] = lane < nts ? (((unsigned long long)(unsigned)ts_hi << 32) | (unsigned)ts_lo) : 0ull;
        if (lane == 62) stamps[62] = rt_entry; if (lane == 63) stamps[63] = (unsigned long long)wall_clock64(); }
#undef PG8_STAMP
#undef PG8_SA
#undef PG8_SB
#undef PG8_STAGE
#undef PG8_LDA
#undef PG8_LDB
#undef PG8_MMA
#undef PG8_WAIT_V
#undef PG8_WAIT_L
#undef PG8_BAR
#undef PG8_SCHED
}
}

#define LAS __attribute__((address_space(3)))
using pg8::bf16_t; using pg8::bf16x8; using pg8::f32x4; using pg8::u32x4; using pg8::Unit;
typedef unsigned u32x2 __attribute__((ext_vector_type(2)));

constexpr int D = 1024, MP = 16384, MS = 256, MT = MP + MS, DFF = 2816;
constexpr int GLA_N = 3088, GLA_NP = 3328;
constexpr float ALPHA = 1.681792830507429f, LN_EPS = 1e-5f;
constexpr int NTHR = 512;
constexpr int LDS_BYTES = 136 * 1024;

constexpr size_t WT_BYTES = 48ull << 20;
constexpr size_t OFF_WT = 0;
constexpr size_t OFF_XB = OFF_WT + WT_BYTES;
constexpr size_t OFF_BIG = OFF_XB + (size_t)MT * D * 2;
constexpr int NSLOT = 1024 + 32;
constexpr size_t OFF_P = OFF_BIG;
constexpr size_t OFF_SB = OFF_P + (size_t)MT * GLA_NP * 2;
constexpr size_t OFF_BB = OFF_SB + (size_t)NSLOT * 32768 * 4;
constexpr size_t OFF_AB = OFF_BB + (size_t)MT * 512 * 4;
constexpr size_t OFF_DK = OFF_AB + (size_t)MT * D * 2;
constexpr size_t OFF_CTR = OFF_DK + (size_t)NSLOT * 128 * 4;
constexpr size_t WS_END = OFF_CTR + 16384;
constexpr size_t W_1IN = 0, W_1OUT = 5767168, W_2IN = 8650752, W_2OUT = 14417920, W_MIN = 17301504, W_MOUT = 21495808;
constexpr size_t O_Y = 0, O_GLAP = 17039360, O_GLAS = 17301504, O_CONVP = 19398656, O_CONVS = 19400704, O_SGV = 19417088;

struct Params { const float* in[24]; float* out; unsigned char* ws; };

__device__ __forceinline__ unsigned pk2(float lo, float hi) { return pg8::cvt_pk_bf16(lo, hi); }
__device__ __forceinline__ bf16_t f2bf(float f) { return (bf16_t)(pk2(f, 0.f) & 0xffffu); }
__device__ __forceinline__ float bf2f(bf16_t b) { return __uint_as_float(((unsigned)b) << 16); }
__device__ __forceinline__ float bflo(unsigned w) { return __uint_as_float(w << 16); }
__device__ __forceinline__ float bfhi(unsigned w) { return __uint_as_float(w & 0xffff0000u); }
__device__ __forceinline__ float silu_f(float x) { return x * __builtin_amdgcn_rcpf(1.0f + __expf(-x)); }
__device__ __forceinline__ float gelu_tanh_f(float x) { const float z = 1.5957691216057308f * (x + 0.044715f * x * x * x); return x * __builtin_amdgcn_rcpf(1.0f + __expf(-z)); }
__device__ __forceinline__ float logsigmoid_f(float z) { return fminf(z, 0.f) - __logf(1.0f + __expf(-fabsf(z))); }

template <int ACT> struct EpiPair {
    static constexpr bool PERM = true, AFTER_DRAIN = false;
    bf16_t* O; int ldo;
    __device__ __forceinline__ void operator()(const f32x4 (&acc)[2][2][4][2], const Unit& u, int wr, int wc, int fr, int fq) const {
        const int row0 = u.pm * 256 + wr * 64 + fr, col0 = u.pn * 128 + wc * 32 + 8 * fq;
#pragma unroll
        for (int ai = 0; ai < 2; ++ai)
#pragma unroll
            for (int m = 0; m < 4; ++m) {
                bf16_t* rowp = O + (size_t)(row0 + ai * 128 + m * 16) * ldo + col0;
                f32x4 v0, v1;
#pragma unroll
                for (int j = 0; j < 4; ++j) {
                    const float a0 = acc[ai][0][m][0][j], a1 = acc[ai][0][m][1][j];
                    v0[j] = (ACT ? silu_f(a0) : a0) * acc[ai][1][m][0][j];
                    v1[j] = (ACT ? silu_f(a1) : a1) * acc[ai][1][m][1][j];
                }
                u32x4 w; w.x = pk2(v0[0], v0[1]); w.y = pk2(v0[2], v0[3]); w.z = pk2(v1[0], v1[1]); w.w = pk2(v1[2], v1[3]);
                *(u32x4*)rowp = w;
            }
    }
};
template <int ACT> struct EpiBf {
    static constexpr bool PERM = true, AFTER_DRAIN = false;
    bf16_t* O; int ldc; int split_cols; size_t split_stride; float* vstat = nullptr;
    __device__ __forceinline__ void operator()(const f32x4 (&acc)[2][2][4][2], const Unit& u, int wr, int wc, int fr, int fq) const {
        const int row0 = u.pm * 256 + wr * 64 + fr; int colt = u.pn * 256; bf16_t* base = O;
        if (split_cols) { const int t = colt / split_cols; base += (size_t)t * split_stride; colt -= t * split_cols; }
        const int col0 = colt + wc * 32 + 8 * fq;
#pragma unroll
        for (int ai = 0; ai < 2; ++ai)
#pragma unroll
            for (int m = 0; m < 4; ++m) {
                bf16_t* rowp = base + (size_t)(row0 + ai * 128 + m * 16) * ldc + col0;
                float ssum = 0.f, qsum = 0.f;
#pragma unroll
                for (int bj = 0; bj < 2; ++bj) {
                    f32x4 v0 = acc[ai][bj][m][0], v1 = acc[ai][bj][m][1];
                    if (ACT == 1) {
#pragma unroll
                        for (int j = 0; j < 4; ++j) { v0[j] = gelu_tanh_f(v0[j]); v1[j] = gelu_tanh_f(v1[j]); }
                    }
                    u32x4 w; w.x = pk2(v0[0], v0[1]); w.y = pk2(v0[2], v0[3]); w.z = pk2(v1[0], v1[1]); w.w = pk2(v1[2], v1[3]);
                    *(u32x4*)(rowp + bj * 128) = w;
                    if (ACT == 1) {
                        const float f0 = bflo(w.x), f1 = bfhi(w.x), f2 = bflo(w.y), f3 = bfhi(w.y), f4 = bflo(w.z), f5 = bfhi(w.z), f6 = bflo(w.w), f7 = bfhi(w.w);
                        ssum += ((f0 + f1) + (f2 + f3)) + ((f4 + f5) + (f6 + f7));
                        qsum += ((f0 * f0 + f1 * f1) + (f2 * f2 + f3 * f3)) + ((f4 * f4 + f5 * f5) + (f6 * f6 + f7 * f7));
                    }
                }
                if (ACT == 1) {
                    if (vstat != nullptr && u.pn >= 8) {
                        ssum += __shfl_xor(ssum, 16); ssum += __shfl_xor(ssum, 32); qsum += __shfl_xor(qsum, 16); qsum += __shfl_xor(qsum, 32);
                        if (fq == 0) { float* sp = vstat + ((size_t)(row0 + ai * 128 + m * 16) * 32 + (u.pn - 8) * 4 + wc) * 2; sp[0] = ssum; sp[1] = qsum; }
                    }
                }
            }
    }
};
struct EpiConv {
    static constexpr bool PERM = true, AFTER_DRAIN = false;
    bf16_t* CIN; bf16_t* BG;
    __device__ __forceinline__ void operator()(const f32x4 (&acc)[2][2][4][2], const Unit& u, int wr, int wc, int fr, int fq) const {
        if (u.pn < 8) { EpiPair<0> e{CIN, D}; e(acc, u, wr, wc, fr, fq); }
        else { EpiBf<0> e{BG, D, 0, 0}; Unit v = u; v.pn = u.pn - 8; e(acc, v, wr, wc, fr, fq); }
    }
};
struct EpiRes {
    static constexpr bool PERM = false, AFTER_DRAIN = false;
    float* X; const bf16_t* XB; float alpha, scale;
    __device__ __forceinline__ void operator()(const f32x4 (&acc)[2][2][4][2], const Unit& u, int wr, int wc, int fr, int fq) const {
        const int row0 = u.pm * 256 + wr * 64 + fr, col0 = u.pn * 256 + wc * 32 + 4 * fq;
#pragma unroll
        for (int ai = 0; ai < 2; ++ai) {
            const size_t off = (size_t)(row0 + ai * 128) * D + col0;
            u32x2 xv[4][2][2];
#pragma unroll
            for (int m = 0; m < 4; ++m)
#pragma unroll
                for (int bj = 0; bj < 2; ++bj)
#pragma unroll
                    for (int n = 0; n < 2; ++n) xv[m][bj][n] = *(const u32x2*)(XB + off + m * 16 * D + bj * 128 + n * 16);
            __builtin_amdgcn_sched_barrier(0);
#pragma unroll
            for (int m = 0; m < 4; ++m)
#pragma unroll
                for (int bj = 0; bj < 2; ++bj)
#pragma unroll
                    for (int n = 0; n < 2; ++n) {
                        const u32x2 w = xv[m][bj][n]; const f32x4 x = (f32x4){bflo(w.x), bfhi(w.x), bflo(w.y), bfhi(w.y)};
                        *(f32x4*)(X + off + m * 16 * D + bj * 128 + n * 16) = x * alpha + acc[ai][bj][m][n] * scale;
                    }
            __builtin_amdgcn_sched_barrier(0);
        }
    }
};

__device__ __forceinline__ int srccol(int mode, int n) {
    if (mode == 1) { const int pn = n >> 8, c = n & 255; return (c >> 7) * DFF + pn * 128 + (c & 127); }
    if (mode == 2) { if (n < 2048) { const int pn = n >> 8, c = n & 255; return 1024 + (c >> 7) * 1024 + pn * 128 + (c & 127); } return n - 2048; }
    return n;
}
__device__ __forceinline__ void convert_matrix(LAS unsigned char* lds, const float* __restrict__ W, bf16_t* __restrict__ Wt, int K, int Nsrc, int Ndst, int Nvalid, int mode, int G, int bid) {
    LAS bf16_t* tile = (LAS bf16_t*)lds;
    int tid_ = threadIdx.x; asm volatile("" : "+v"(tid_)); const int tid = tid_, ntn = Ndst >> 6, ntk = K >> 8, ntot = ntn * ntk;
    for (int t = bid; t < ntot; t += G) {
        const int tn = t % ntn, tk = t / ntn, n0 = tn * 64, k0 = tk * 256, sc0 = srccol(mode, n0);
        const int kk = tid >> 3, cc = (tid & 7) * 8;
        float4 v0[4], v1[4];
        const bool ok = n0 + cc < Nvalid;
#pragma unroll
        for (int q = 0; q < 4; ++q) {
            v0[q] = make_float4(0.f, 0.f, 0.f, 0.f); v1[q] = v0[q];
            if (ok) { const float* s = W + (size_t)(k0 + q * 64 + kk) * Nsrc + sc0 + cc; v0[q] = *(const float4*)s; v1[q] = *(const float4*)(s + 4); }
        }
        __builtin_amdgcn_sched_barrier(0);
#pragma unroll
        for (int q = 0; q < 4; ++q) {
            LAS bf16_t* tp = tile + cc * 264 + q * 64 + kk;
            tp[0] = f2bf(v0[q].x); tp[264] = f2bf(v0[q].y); tp[528] = f2bf(v0[q].z); tp[792] = f2bf(v0[q].w);
            tp[1056] = f2bf(v1[q].x); tp[1320] = f2bf(v1[q].y); tp[1584] = f2bf(v1[q].z); tp[1848] = f2bf(v1[q].w);
        }
        __syncthreads();
#pragma unroll
        for (int i = 0; i < 4; ++i) {
            const int id = tid + i * NTHR, nl = id >> 5, kc = (id & 31) * 8;
            const u32x4 w = *(const LAS u32x4*)(tile + nl * 264 + kc);
            *(u32x4*)(Wt + (size_t)(n0 + nl) * K + k0 + kc) = w;
        }
        __syncthreads();
    }
}
__device__ __forceinline__ void convert_layer(LAS unsigned char* lds, const Params& p, int l, int G, int bid) {
    bf16_t* WT = (bf16_t*)(p.ws + OFF_WT);
    convert_matrix(lds, p.in[6] + (size_t)l * D * 2 * DFF, WT + W_1IN, D, 2 * DFF, 2 * DFF, 2 * DFF, 1, G, bid);
    convert_matrix(lds, p.in[7] + (size_t)l * DFF * D, WT + W_1OUT, DFF, D, D, D, 0, G, bid);
    convert_matrix(lds, p.in[8] + (size_t)l * D * 2 * DFF, WT + W_2IN, D, 2 * DFF, 2 * DFF, 2 * DFF, 1, G, bid);
    convert_matrix(lds, p.in[9] + (size_t)l * DFF * D, WT + W_2OUT, DFF, D, D, D, 0, G, bid);
    const int mixer = l % 3, j = l / 3;
    if (mixer == 0) {
        convert_matrix(lds, p.in[10] + (size_t)j * D * GLA_N, WT + W_MIN, D, GLA_N, GLA_NP, GLA_N, 0, G, bid);
        convert_matrix(lds, p.in[14] + (size_t)j * D * D, WT + W_MOUT, D, D, D, D, 0, G, bid);
    } else if (mixer == 1) {
        convert_matrix(lds, p.in[15] + (size_t)j * D * 4096, WT + W_MIN, D, 4096, 4096, 4096, 0, G, bid);
        convert_matrix(lds, p.in[20] + (size_t)j * 2048 * D, WT + W_MOUT, 2048, D, D, D, 0, G, bid);
    } else {
        convert_matrix(lds, p.in[21] + (size_t)j * D * 3072, WT + W_MIN, D, 3072, 3072, 3072, 2, G, bid);
        convert_matrix(lds, p.in[23] + (size_t)j * D * D, WT + W_MOUT, D, D, D, D, 0, G, bid);
    }
}

__device__ __forceinline__ void init_phase(const Params& p, int G, int bid) {
    float* X = p.out + O_Y; bf16_t* XB = (bf16_t*)(p.ws + OFF_XB);
    const size_t n4 = (size_t)MT * D / 4, np4 = (size_t)MP * D / 4;
    int tid_ = threadIdx.x; asm volatile("" : "+v"(tid_));
    for (size_t i = (size_t)bid * NTHR + tid_; i < n4; i += (size_t)G * NTHR) {
        const float4 v = (i < np4) ? ((const float4*)p.in[0])[i] : ((const float4*)p.in[1])[i - np4];
        u32x2 w; w.x = pk2(v.x, v.y); w.y = pk2(v.z, v.w);
        ((u32x2*)XB)[i] = w;
    }
}

__device__ __forceinline__ void ln_row(float* xr, bf16_t* xb, const float4 (&v)[4], const float4 (&gv)[4], const float4 (&bv)[4], int lane, bool fin) {
    float s = 0.f;
#pragma unroll
    for (int i = 0; i < 4; ++i) s += (v[i].x + v[i].y) + (v[i].z + v[i].w);
#pragma unroll
    for (int o = 32; o >= 1; o >>= 1) s += __shfl_xor(s, o);
    const float mean = s * (1.0f / D);
    float q = 0.f;
#pragma unroll
    for (int i = 0; i < 4; ++i) { const float a = v[i].x - mean, b2 = v[i].y - mean, c = v[i].z - mean, d = v[i].w - mean; q += (a * a + b2 * b2) + (c * c + d * d); }
#pragma unroll
    for (int o = 32; o >= 1; o >>= 1) q += __shfl_xor(q, o);
    const float rstd = 1.0f / sqrtf(q * (1.0f / D) + LN_EPS);
#pragma unroll
    for (int i = 0; i < 4; ++i) {
        float4 y;
        y.x = (v[i].x - mean) * rstd * gv[i].x + bv[i].x; y.y = (v[i].y - mean) * rstd * gv[i].y + bv[i].y;
        y.z = (v[i].z - mean) * rstd * gv[i].z + bv[i].z; y.w = (v[i].w - mean) * rstd * gv[i].w + bv[i].w;
        if (fin) *(float4*)(xr + (i * 64 + lane) * 4) = y;
        else { u32x2 w; w.x = pk2(y.x, y.y); w.y = pk2(y.z, y.w); *(u32x2*)(xb + (i * 64 + lane) * 4) = w; }
    }
}
__device__ __forceinline__ void ln_phase(float* X, bf16_t* XB, const float* __restrict__ g, const float* __restrict__ b, int G, int bid, bool fin) {
    int tid_ = threadIdx.x; asm volatile("" : "+v"(tid_)); const int tid = tid_, wid = tid >> 6, lane = tid & 63;
    float4 gv[4], bv[4];
#pragma unroll
    for (int i = 0; i < 4; ++i) { gv[i] = *(const float4*)(g + (i * 64 + lane) * 4); bv[i] = *(const float4*)(b + (i * 64 + lane) * 4); }
    for (int row = bid * 8 + wid; row < MT; row += 4 * G * 8) {
        int rr[4]; bool has[4]; float4 v[4][4];
#pragma unroll
        for (int k = 0; k < 4; ++k) { rr[k] = row + k * G * 8; has[k] = rr[k] < MT; if (!has[k]) rr[k] = row; }
#pragma unroll
        for (int k = 0; k < 4; ++k)
#pragma unroll
            for (int i = 0; i < 4; ++i) v[k][i] = *(const float4*)(X + (size_t)rr[k] * D + (i * 64 + lane) * 4);
        __builtin_amdgcn_sched_barrier(0);
#pragma unroll
        for (int k = 0; k < 4; ++k) if (has[k]) ln_row(X + (size_t)rr[k] * D, XB + (size_t)rr[k] * D, v[k], gv, bv, lane, fin);
    }
}

__device__ __forceinline__ void unpack8(const u32x4 w, float (&f)[8]) { f[0] = bflo(w.x); f[1] = bfhi(w.x); f[2] = bflo(w.y); f[3] = bfhi(w.y); f[4] = bflo(w.z); f[5] = bfhi(w.z); f[6] = bflo(w.w); f[7] = bfhi(w.w); }
__device__ __forceinline__ void conv_phase(const Params& p, int j, int G, int bid) {
    const bf16_t* CIN = (const bf16_t*)(p.ws + OFF_BIG); bf16_t* BG = (bf16_t*)(p.ws + OFF_BIG + (size_t)MT * D * 2);
    const float* wc = p.in[22] + (size_t)j * 3 * D; const float* st = p.in[3] + (size_t)j * 8 * 2 * D;
    float* outp = p.out + O_CONVP + (size_t)j * 2 * D; float* outs = p.out + O_CONVS + (size_t)j * 8 * 2 * D;
    const int total = MT * 128;
    int tid_ = threadIdx.x; asm volatile("" : "+v"(tid_));
    for (int idx = bid * NTHR + tid_; idx < total; idx += G * NTHR) {
        const int r = idx >> 7, c8 = (idx & 127) * 8;
        const bool samp = r >= MP; const int t = samp ? ((r - MP) & 31) : r, b = samp ? ((r - MP) >> 5) : 0, T = samp ? 32 : MP;
        float c0[8], c1[8], c2[8], bg[8];
        unpack8(*(const u32x4*)(CIN + (size_t)r * D + c8), c0);
        if (t >= 1) unpack8(*(const u32x4*)(CIN + (size_t)(r - 1) * D + c8), c1);
        else if (samp) { const float4 a = *(const float4*)(st + (size_t)(b * 2 + 1) * D + c8), a2 = *(const float4*)(st + (size_t)(b * 2 + 1) * D + c8 + 4); c1[0] = a.x; c1[1] = a.y; c1[2] = a.z; c1[3] = a.w; c1[4] = a2.x; c1[5] = a2.y; c1[6] = a2.z; c1[7] = a2.w; }
        else { for (int i = 0; i < 8; ++i) c1[i] = 0.f; }
        if (t >= 2) unpack8(*(const u32x4*)(CIN + (size_t)(r - 2) * D + c8), c2);
        else if (samp) { const float4 a = *(const float4*)(st + (size_t)(b * 2 + t) * D + c8), a2 = *(const float4*)(st + (size_t)(b * 2 + t) * D + c8 + 4); c2[0] = a.x; c2[1] = a.y; c2[2] = a.z; c2[3] = a.w; c2[4] = a2.x; c2[5] = a2.y; c2[6] = a2.z; c2[7] = a2.w; }
        else { for (int i = 0; i < 8; ++i) c2[i] = 0.f; }
        unpack8(*(const u32x4*)(BG + (size_t)r * D + c8), bg);
        float z[8];
#pragma unroll
        for (int i = 0; i < 8; ++i) z[i] = bg[i] * (wc[c8 + i] * c2[i] + wc[D + c8 + i] * c1[i] + wc[2 * D + c8 + i] * c0[i]);
        u32x4 w; w.x = pk2(z[0], z[1]); w.y = pk2(z[2], z[3]); w.z = pk2(z[4], z[5]); w.w = pk2(z[6], z[7]);
        *(u32x4*)(BG + (size_t)r * D + c8) = w;
        if (t >= T - 2) {
            float* o = (samp ? outs + (size_t)(b * 2 + (t - (T - 2))) * D : outp + (size_t)(t - (T - 2)) * D) + c8;
            *(float4*)o = make_float4(c0[0], c0[1], c0[2], c0[3]); *(float4*)(o + 4) = make_float4(c0[4], c0[5], c0[6], c0[7]);
        }
    }
}

__device__ __forceinline__ void gla_item(int slot, int& row0, int& len, int& h) { h = slot & 3; if (slot < 1024) { row0 = (slot >> 2) * 64; len = 64; } else { row0 = MP + ((slot - 1024) >> 2) * 32; len = 32; } }
__device__ __forceinline__ f32x4 mfma16(const bf16x8 a, const bf16x8 b, const f32x4 c) { return __builtin_amdgcn_mfma_f32_16x16x32_bf16(a, b, c, 0, 0, 0); }

__device__ __forceinline__ void gla_g1(LAS unsigned char* lds, const Params& p, int j, int G, int bid) {
    const bf16_t* P = (const bf16_t*)(p.ws + OFF_P); bf16_t* SB = (bf16_t*)(p.ws + OFF_SB); float* BB = (float*)(p.ws + OFF_BB); float* DK = (float*)(p.ws + OFF_DK);
    const float* wgk = p.in[11] + (size_t)j * 16 * 512; const float* bgk = p.in[12] + (size_t)j * 512;
    LAS float* gls = (LAS float*)lds;
    LAS float* wg = (LAS float*)(lds + 4096);
    LAS float* tot = (LAS float*)(lds + 12288);
    LAS bf16_t* khT = (LAS bf16_t*)(lds + 16384);
    LAS bf16_t* vT = (LAS bf16_t*)(lds + 34816);
    int tid_ = threadIdx.x; asm volatile("" : "+v"(tid_)); const int tid = tid_, wid = tid >> 6, lane = tid & 63, fr = lane & 15, fq = lane >> 4;
    const int kd = tid & 127, q4 = tid >> 7, vdv = tid & 255, hv = tid >> 8;
    for (int slot = bid; slot < NSLOT; slot += G) {
        int row0, len, h; gla_item(slot, row0, len, h);
        const bf16_t* Pr = P + (size_t)row0 * GLA_NP;
        float kf[16];
#pragma unroll
        for (int i = 0; i < 16; ++i) { const unsigned tt = 16u * q4 + i, tc = tt < (unsigned)len ? tt : 0u; const float kx = bf2f(Pr[tc * (unsigned)GLA_NP + 512u + h * 128 + kd]); kf[i] = tt < (unsigned)len ? kx : 0.f; }
        for (int idx = tid; idx < 1024; idx += NTHR) { const int t = idx >> 4, r = idx & 15; gls[idx] = t < len ? bf2f(Pr[(size_t)t * GLA_NP + 3072 + r]) : 0.f; }
        for (int idx = tid; idx < 2048; idx += NTHR) { const int r = idx >> 7, c = idx & 127; wg[idx] = wgk[r * 512 + h * 128 + c]; }
        __syncthreads();
        float bl[16];
        {
            float wr_[16];
#pragma unroll
            for (int r = 0; r < 16; ++r) wr_[r] = wg[r * 128 + kd];
            const float bias = bgk[h * 128 + kd]; float run = 0.f;
#pragma unroll
            for (int i = 0; i < 16; ++i) {
                const int t = 16 * q4 + i; float z = bias;
#pragma unroll
                for (int r = 0; r < 16; ++r) z += gls[t * 16 + r] * wr_[r];
                run += t < len ? logsigmoid_f(z) * (1.0f / 16.0f) : 0.f; bl[i] = run;
            }
            tot[q4 * 128 + kd] = run;
        }
        __syncthreads();
        {
            const float t0 = tot[kd], t1 = tot[128 + kd], t2 = tot[256 + kd], t3 = tot[384 + kd];
            const float off = (q4 > 0 ? t0 : 0.f) + (q4 > 1 ? t1 : 0.f) + (q4 > 2 ? t2 : 0.f), blast = (t0 + t1) + (t2 + t3);
            if (q4 == 0) DK[(size_t)slot * 128 + kd] = __expf(blast);
            float kh[16];
#pragma unroll
            for (int i = 0; i < 16; ++i) {
                const int t = 16 * q4 + i; const float bt = off + bl[i];
                if (t < len) BB[(size_t)(row0 + t) * 512 + h * 128 + kd] = bt;
                kh[i] = kf[i] * __expf(blast - bt);
            }
            u32x4 w0, w1;
            w0.x = pk2(kh[0], kh[1]); w0.y = pk2(kh[2], kh[3]); w0.z = pk2(kh[4], kh[5]); w0.w = pk2(kh[6], kh[7]);
            w1.x = pk2(kh[8], kh[9]); w1.y = pk2(kh[10], kh[11]); w1.z = pk2(kh[12], kh[13]); w1.w = pk2(kh[14], kh[15]);
            *(LAS u32x4*)(khT + kd * 72 + 16 * q4) = w0; *(LAS u32x4*)(khT + kd * 72 + 16 * q4 + 8) = w1;
        }
        {
            const bf16_t* vb = Pr + 1024 + h * 256;
#pragma nounroll
            for (int bt = 0; bt < 2; ++bt) {
                const unsigned tb = 32u * hv + 16u * bt; unsigned vr[8];
#pragma unroll
                for (int i = 0; i < 8; ++i) {
                    const unsigned ta = tb + 2u * i, ca = ta < (unsigned)len ? ta : 0u, cb = ta + 1u < (unsigned)len ? ta + 1u : 0u;
                    const unsigned lo = vb[ca * (unsigned)GLA_NP + vdv], hi = vb[cb * (unsigned)GLA_NP + vdv];
                    vr[i] = (ta < (unsigned)len ? lo : 0u) | ((ta + 1u < (unsigned)len ? hi : 0u) << 16);
                }
                u32x4 w0, w1; w0.x = vr[0]; w0.y = vr[1]; w0.z = vr[2]; w0.w = vr[3]; w1.x = vr[4]; w1.y = vr[5]; w1.z = vr[6]; w1.w = vr[7];
                *(LAS u32x4*)(vT + vdv * 72 + tb) = w0; *(LAS u32x4*)(vT + vdv * 72 + tb + 8) = w1;
            }
        }
        __syncthreads();
        f32x4 acc[2][8];
#pragma unroll
        for (int r = 0; r < 2; ++r)
#pragma unroll
            for (int c = 0; c < 8; ++c) acc[r][c] = (f32x4){0.f, 0.f, 0.f, 0.f};
#pragma unroll
        for (int ks = 0; ks < 2; ++ks) {
            bf16x8 a[2];
#pragma unroll
            for (int r = 0; r < 2; ++r) a[r] = *(const LAS bf16x8*)(vT + ((wid * 2 + r) * 16 + fr) * 72 + ks * 32 + fq * 8);
#pragma unroll
            for (int c = 0; c < 8; ++c) {
                const bf16x8 bfr = *(const LAS bf16x8*)(khT + (c * 16 + fr) * 72 + ks * 32 + fq * 8);
#pragma unroll
                for (int r = 0; r < 2; ++r) acc[r][c] = mfma16(bfr, a[r], acc[r][c]);
            }
        }
        bf16_t* sb = SB + (size_t)slot * 32768 + (unsigned)((wid * 32 + fr) * 128 + fq * 4);
#pragma unroll
        for (int r = 0; r < 2; ++r) {
            bf16_t* sbr = sb + r * 2048; asm volatile("" : "+v"(sbr));
#pragma unroll
            for (int c = 0; c < 8; ++c) { u32x2 w; w.x = pk2(acc[r][c][0], acc[r][c][1]); w.y = pk2(acc[r][c][2], acc[r][c][3]); *(u32x2*)(sbr + c * 16) = w; }
        }
        __syncthreads();
    }
}

__device__ __forceinline__ void gla_g2(const Params& p, int j, int G, int bid) {
    unsigned* SB = (unsigned*)(p.ws + OFF_SB); const float* DK = (const float*)(p.ws + OFF_DK);
    int tid_ = threadIdx.x; asm volatile("" : "+v"(tid_));
    for (int e = bid * NTHR + tid_; e < 65536; e += G * NTHR) {
        const int h = e >> 14, vd = (e >> 6) & 255, k2 = e & 63;
        unsigned* ps = SB + (size_t)h * 16384 + vd * 64 + k2; const float* pd = DK + h * 128 + 2 * k2;
        float S0 = 0.f, S1 = 0.f;
        for (int c0 = 0; c0 < 256; c0 += 32) {
            unsigned ds[32]; float2 dd[32];
#pragma unroll
            for (int i = 0; i < 32; ++i) { ds[i] = ps[(size_t)(c0 + i) * 65536]; dd[i] = *(const float2*)(pd + (c0 + i) * 512); }
            __builtin_amdgcn_sched_barrier(0);
#pragma unroll
            for (int i = 0; i < 32; ++i) { ps[(size_t)(c0 + i) * 65536] = pk2(S0, S1); S0 = dd[i].x * S0 + bflo(ds[i]); S1 = dd[i].y * S1 + bfhi(ds[i]); }
        }
        float* o = p.out + O_GLAP + (size_t)j * 131072 + h * 32768 + (2 * k2) * 256 + vd;
        o[0] = S0; o[256] = S1;
    }
    const float* st = p.in[2] + (size_t)j * 8 * 131072;
    for (int e = bid * NTHR + tid_; e < 8 * 65536; e += G * NTHR) {
        const int b = e >> 16, h = (e >> 14) & 3, vd = (e >> 6) & 255, k2 = e & 63, slot = 1024 + b * 4 + h;
        unsigned* ps = SB + (size_t)slot * 16384 + vd * 64 + k2;
        const size_t so = (size_t)(b * 4 + h) * 32768 + (2 * k2) * 256 + vd;
        const float A0 = st[so], A1 = st[so + 256]; const unsigned ds = *ps; const float2 dd = *(const float2*)(DK + slot * 128 + 2 * k2);
        *ps = pk2(A0, A1);
        float* o = p.out + O_GLAS + (size_t)j * 8 * 131072 + so;
        o[0] = dd.x * A0 + bflo(ds); o[256] = dd.y * A1 + bfhi(ds);
    }
}

__device__ __forceinline__ void gla_g3(LAS unsigned char* lds, const Params& p, int j, int G, int bid) {
    const bf16_t* P = (const bf16_t*)(p.ws + OFF_P); const bf16_t* SB = (const bf16_t*)(p.ws + OFF_SB); const float* BB = (const float*)(p.ws + OFF_BB);
    bf16_t* AB = (bf16_t*)(p.ws + OFF_AB); const float* gn = p.in[13] + (size_t)j * 256;
    LAS bf16_t* qt = (LAS bf16_t*)lds;
    LAS bf16_t* kt = (LAS bf16_t*)(lds + 17408);
    LAS bf16_t* sc = (LAS bf16_t*)(lds + 34816);
    LAS bf16_t* vT = (LAS bf16_t*)(lds + 44032);
    LAS float* part = (LAS float*)(lds + 80896);
    LAS bf16_t* rl = (LAS bf16_t*)(lds + 82944);
    int tid_ = threadIdx.x; asm volatile("" : "+v"(tid_)); const int tid = tid_, wid = tid >> 6, lane = tid & 63, fr = lane & 15, fq = lane >> 4;
    const int kd = tid & 127, q4 = tid >> 7, vdv = tid & 255, hv = tid >> 8;
    for (int slot = bid; slot < NSLOT; slot += G) {
        int row0, len, h; gla_item(slot, row0, len, h);
        const bf16_t* Pr = P + (size_t)row0 * GLA_NP;
        {
            float btv[16]; unsigned short qr[16], kr[16];
#pragma unroll
            for (int i = 0; i < 16; ++i) {
                const unsigned t = 16u * q4 + i, tc = t < (unsigned)len ? t : 0u; const unsigned po = tc * (unsigned)GLA_NP + h * 128 + kd;
                btv[i] = BB[(size_t)row0 * 512 + tc * 512u + h * 128 + kd]; qr[i] = Pr[po]; kr[i] = Pr[po + 512u];
            }
            __builtin_amdgcn_sched_barrier(0);
#pragma unroll
            for (int i = 0; i < 16; ++i) {
                const unsigned t = 16u * q4 + i; const bool ok = t < (unsigned)len;
                const float qv = bf2f(qr[i]) * 0.08838834764831845f * __expf(btv[i]), kv = bf2f(kr[i]) * __expf(-btv[i]);
                qt[t * 136 + kd] = f2bf(ok ? qv : 0.f); kt[t * 136 + kd] = f2bf(ok ? kv : 0.f);
            }
        }
        {
            const bf16_t* vb = Pr + 1024 + h * 256;
#pragma nounroll
            for (int bt = 0; bt < 2; ++bt) {
                const unsigned tb = 32u * hv + 16u * bt; unsigned vr[8];
#pragma unroll
                for (int i = 0; i < 8; ++i) {
                    const unsigned ta = tb + 2u * i, ca = ta < (unsigned)len ? ta : 0u, cb = ta + 1u < (unsigned)len ? ta + 1u : 0u;
                    const bf16_t* pa = vb + ca * (unsigned)GLA_NP + vdv; const bf16_t* pb = vb + cb * (unsigned)GLA_NP + vdv;
                    const unsigned lo = pa[0], hi = pb[0];
                    rl[ta * 264 + vdv] = pa[1024]; rl[(ta + 1u) * 264 + vdv] = pb[1024];
                    vr[i] = (ta < (unsigned)len ? lo : 0u) | ((ta + 1u < (unsigned)len ? hi : 0u) << 16);
                }
                u32x4 w0, w1; w0.x = vr[0]; w0.y = vr[1]; w0.z = vr[2]; w0.w = vr[3]; w1.x = vr[4]; w1.y = vr[5]; w1.z = vr[6]; w1.w = vr[7];
                *(LAS u32x4*)(vT + vdv * 72 + tb) = w0; *(LAS u32x4*)(vT + vdv * 72 + tb + 8) = w1;
            }
        }
        __syncthreads();
        const bf16_t* sp = SB + (size_t)slot * 32768 + (size_t)(wid * 32 + fr) * 128 + fq * 8;
        bf16x8 spf[2][4];
#pragma unroll
        for (int c = 0; c < 2; ++c)
#pragma unroll
            for (int ks = 0; ks < 4; ++ks) spf[c][ks] = *(const bf16x8*)(sp + c * 2048 + ks * 32);
#pragma unroll
        for (int i = 0; i < 2; ++i) {
            const int ti = wid * 2 + i, rt = ti >> 2, ct = ti & 3;
            f32x4 a4 = (f32x4){0.f, 0.f, 0.f, 0.f};
            if (ct <= rt) {
#pragma unroll
                for (int ks = 0; ks < 4; ++ks) {
                    const bf16x8 a = *(const LAS bf16x8*)(qt + (rt * 16 + fr) * 136 + ks * 32 + fq * 8);
                    const bf16x8 b = *(const LAS bf16x8*)(kt + (ct * 16 + fr) * 136 + ks * 32 + fq * 8);
                    a4 = mfma16(a, b, a4);
                }
            }
#pragma unroll
            for (int jj = 0; jj < 4; ++jj) { const int t = rt * 16 + fq * 4 + jj, s = ct * 16 + fr; sc[t * 72 + s] = f2bf(s <= t ? a4[jj] : 0.f); }
        }
        __syncthreads();
        f32x4 acc[4][2];
#pragma unroll
        for (int r = 0; r < 4; ++r)
#pragma unroll
            for (int c = 0; c < 2; ++c) acc[r][c] = (f32x4){0.f, 0.f, 0.f, 0.f};
#pragma unroll
        for (int ks = 0; ks < 2; ++ks) {
            bf16x8 b[2];
#pragma unroll
            for (int c = 0; c < 2; ++c) b[c] = *(const LAS bf16x8*)(vT + (wid * 32 + c * 16 + fr) * 72 + ks * 32 + fq * 8);
#pragma unroll
            for (int r = 0; r < 4; ++r) {
                const bf16x8 a = *(const LAS bf16x8*)(sc + (r * 16 + fr) * 72 + ks * 32 + fq * 8);
#pragma unroll
                for (int c = 0; c < 2; ++c) acc[r][c] = mfma16(a, b[c], acc[r][c]);
            }
        }
#pragma unroll
        for (int ks = 0; ks < 4; ++ks) {
            bf16x8 b[2];
#pragma unroll
            for (int c = 0; c < 2; ++c) b[c] = spf[c][ks];
#pragma unroll
            for (int r = 0; r < 4; ++r) {
                const bf16x8 a = *(const LAS bf16x8*)(qt + (r * 16 + fr) * 136 + ks * 32 + fq * 8);
#pragma unroll
                for (int c = 0; c < 2; ++c) acc[r][c] = mfma16(a, b[c], acc[r][c]);
            }
        }
#pragma unroll
        for (int r = 0; r < 4; ++r)
#pragma unroll
            for (int jj = 0; jj < 4; ++jj) {
                float ss = acc[r][0][jj] * acc[r][0][jj] + acc[r][1][jj] * acc[r][1][jj];
                ss += __shfl_xor(ss, 1); ss += __shfl_xor(ss, 2); ss += __shfl_xor(ss, 4); ss += __shfl_xor(ss, 8);
                if (fr == 0) part[(r * 16 + fq * 4 + jj) * 8 + wid] = ss;
            }
        __syncthreads();
        const float gn0 = gn[wid * 32 + fr], gn1 = gn[wid * 32 + 16 + fr];
#pragma unroll
        for (int r = 0; r < 4; ++r)
#pragma unroll
            for (int jj = 0; jj < 4; ++jj) {
                const int t = r * 16 + fq * 4 + jj;
                const f32x4 p0 = *(const LAS f32x4*)(part + t * 8), p1 = *(const LAS f32x4*)(part + t * 8 + 4);
                const float tot = ((p0[0] + p0[1]) + (p0[2] + p0[3])) + ((p1[0] + p1[1]) + (p1[2] + p1[3]));
                const float rinv = __builtin_amdgcn_rsqf(tot * (1.0f / 256.0f) + LN_EPS);
                LAS bf16_t* ro = rl + t * 264 + wid * 32 + fr;
                ro[0] = f2bf(acc[r][0][jj] * rinv * gn0 * silu_f(bf2f(ro[0])));
                ro[16] = f2bf(acc[r][1][jj] * rinv * gn1 * silu_f(bf2f(ro[16])));
            }
        __syncthreads();
        for (int idx = tid; idx < len * 32; idx += NTHR) {
            const int t = idx >> 5, c16 = idx & 31;
            *(u32x4*)(AB + (size_t)(row0 + t) * D + h * 256 + c16 * 8) = *(const LAS u32x4*)(rl + t * 264 + c16 * 8);
        }
        __syncthreads();
    }
}

constexpr size_t OFF_VSTAT = OFF_BIG + (size_t)MT * 4096 * 2;
__device__ __forceinline__ void sg_phase(LAS unsigned char* lds, const Params& p, int j, int G, int bid) {
    bf16_t* U = (bf16_t*)(p.ws + OFF_BIG); const bf16_t* V = (const bf16_t*)(p.ws + OFF_BIG + (size_t)MT * 2048 * 2);
    const float* VS = (const float*)(p.ws + OFF_VSTAT);
    const float* lg = p.in[16] + (size_t)j * 2048; const float* lb = p.in[17] + (size_t)j * 2048;
    const float* wsp = p.in[18] + (size_t)j * 8 * 128 * 128; const float* bsp = p.in[19] + (size_t)j * 8 * 128;
    float* sgv = p.out + O_SGV + (size_t)j * 8 * 32 * 2048;
    LAS bf16_t* vnT = (LAS bf16_t*)lds;
    LAS bf16_t* wsA = (LAS bf16_t*)(lds + 69632);
    LAS float* stat = (LAS float*)(lds + 104448);
    LAS float* bsl = (LAS float*)(lds + 105472);
    int tid_ = threadIdx.x; asm volatile("" : "+v"(tid_)); const int tid = tid_, wid = tid >> 6, lane = tid & 63, fr = lane & 15, fq = lane >> 4;
    const int NIT = (128 + 8) * 8;
    for (int it = bid; it < NIT; it += G) {
        const int ci = it >> 3, g = it & 7; const bool samp = ci >= 128;
        const int row0 = samp ? MP + (ci - 128) * 32 : ci * 128, len = samp ? 32 : 128;
        if (tid < len) {
            const float4* sp = (const float4*)(VS + (size_t)(row0 + tid) * 64); float s = 0.f, q = 0.f;
#pragma unroll
            for (int i = 0; i < 16; ++i) { const float4 x = sp[i]; s += x.x + x.z; q += x.y + x.w; }
            const float mean = s * (1.0f / 2048.0f), var = q * (1.0f / 2048.0f) - mean * mean;
            stat[tid * 2] = mean; stat[tid * 2 + 1] = 1.0f / sqrtf(fmaxf(var, 0.f) + LN_EPS);
        }
        if (tid >= 384) bsl[tid - 384] = bsp[g * 128 + tid - 384];
        {
            const int tt = tid >> 2, s0 = (tid & 3) * 32; const float* wrow = wsp + (size_t)g * 16384 + tt * 128 + s0;
            float4 wa[4], wb[4];
#pragma unroll
            for (int i = 0; i < 4; ++i) { wa[i] = *(const float4*)(wrow + 8 * i); wb[i] = *(const float4*)(wrow + 8 * i + 4); }
            __builtin_amdgcn_sched_barrier(0);
#pragma unroll
            for (int i = 0; i < 4; ++i) {
                const float4 a = wa[i], b = wb[i]; const int sb = s0 + 8 * i;
                u32x4 w; w.x = pk2(sb + 0 <= tt ? a.x : 0.f, sb + 1 <= tt ? a.y : 0.f); w.y = pk2(sb + 2 <= tt ? a.z : 0.f, sb + 3 <= tt ? a.w : 0.f);
                w.z = pk2(sb + 4 <= tt ? b.x : 0.f, sb + 5 <= tt ? b.y : 0.f); w.w = pk2(sb + 6 <= tt ? b.z : 0.f, sb + 7 <= tt ? b.w : 0.f);
                *(LAS u32x4*)(wsA + tt * 136 + sb) = w;
            }
        }
        __syncthreads();
        {
            const int d = tid & 255, hh = tid >> 8; const float lgd = lg[g * 256 + d], lbd = lb[g * 256 + d];
            const bf16_t* vb = V + (size_t)row0 * 2048 + g * 256 + d;
#pragma nounroll
            for (int bt = 0; bt < 4; ++bt) {
                const unsigned sb = 64u * hh + 16u * bt; float vn[16];
#pragma unroll
                for (int i = 0; i < 16; ++i) {
                    const unsigned s = sb + i, sc_ = s < (unsigned)len ? s : 0u;
                    const float x = (bf2f(vb[sc_ * 2048u]) - stat[sc_ * 2]) * stat[sc_ * 2 + 1] * lgd + lbd;
                    vn[i] = s < (unsigned)len ? x : 0.f;
                }
                if (samp && sb < (unsigned)len) {
#pragma unroll
                    for (int i = 0; i < 16; ++i) sgv[(size_t)(row0 - MP + sb + i) * 2048 + g * 256 + d] = vn[i];
                }
                u32x4 w0, w1;
                w0.x = pk2(vn[0], vn[1]); w0.y = pk2(vn[2], vn[3]); w0.z = pk2(vn[4], vn[5]); w0.w = pk2(vn[6], vn[7]);
                w1.x = pk2(vn[8], vn[9]); w1.y = pk2(vn[10], vn[11]); w1.z = pk2(vn[12], vn[13]); w1.w = pk2(vn[14], vn[15]);
                *(LAS u32x4*)(vnT + d * 136 + sb) = w0; *(LAS u32x4*)(vnT + d * 136 + sb + 8) = w1;
            }
        }
        __syncthreads();
        f32x4 acc[8][2];
#pragma unroll
        for (int r = 0; r < 8; ++r)
#pragma unroll
            for (int c = 0; c < 2; ++c) acc[r][c] = (f32x4){0.f, 0.f, 0.f, 0.f};
#pragma unroll
        for (int ks = 0; ks < 4; ++ks) {
            bf16x8 b[2];
#pragma unroll
            for (int c = 0; c < 2; ++c) b[c] = *(const LAS bf16x8*)(vnT + (wid * 32 + c * 16 + fr) * 136 + ks * 32 + fq * 8);
#pragma unroll
            for (int r = 0; r < 8; ++r) {
                if (ks * 32 <= r * 16 + 15) {
                    const bf16x8 a = *(const LAS bf16x8*)(wsA + (r * 16 + fr) * 136 + ks * 32 + fq * 8);
#pragma unroll
                    for (int c = 0; c < 2; ++c) acc[r][c] = mfma16(a, b[c], acc[r][c]);
                }
            }
        }
        __syncthreads();
#pragma unroll
        for (int r = 0; r < 8; ++r)
#pragma unroll
            for (int jj = 0; jj < 4; ++jj) {
                const int t = r * 16 + fq * 4 + jj; const float bsv = bsl[t];
                LAS bf16_t* so = vnT + t * 264 + wid * 32 + fr;
                so[0] = f2bf(acc[r][0][jj] + bsv); so[16] = f2bf(acc[r][1][jj] + bsv);
            }
        __syncthreads();
        for (int idx = tid; idx < len * 32; idx += NTHR) {
            const int t = idx >> 5, c16 = idx & 31;
            bf16_t* up = U + (size_t)(row0 + t) * 2048 + g * 256 + c16 * 8;
            const u32x4 uw = *(const u32x4*)up, sw = *(const LAS u32x4*)(vnT + t * 264 + c16 * 8);
            u32x4 w; w.x = pk2(bflo(uw.x) * bflo(sw.x), bfhi(uw.x) * bfhi(sw.x)); w.y = pk2(bflo(uw.y) * bflo(sw.y), bfhi(uw.y) * bfhi(sw.y));
            w.z = pk2(bflo(uw.z) * bflo(sw.z), bfhi(uw.z) * bfhi(sw.z)); w.w = pk2(bflo(uw.w) * bflo(sw.w), bfhi(uw.w) * bfhi(sw.w));
            *(u32x4*)up = w;
        }
        __syncthreads();
    }
}

template <int K> __device__ __forceinline__ void skinny_out(LAS unsigned char* lds, const bf16_t* __restrict__ A, const bf16_t* __restrict__ Bt, float* X, const bf16_t* XB, float alpha, float scale, int G, int bid) {
    int tid_ = threadIdx.x; asm volatile("" : "+v"(tid_)); const int tid = tid_, wid = tid >> 6, lane = tid & 63, fr = lane & 15, fq = lane >> 4;
    LAS float* part = (LAS float*)lds;
    constexpr int KW = K / 8;
    for (int it = bid; it < 256; it += G) {
        const int rf = it >> 4, cc = it & 15;
        const bf16_t* ap = A + (size_t)(MP + rf * 16 + fr) * K + wid * KW + fq * 8;
        const bf16_t* bp = Bt + (size_t)(cc * 64 + fr) * K + wid * KW + fq * 8;
        f32x4 acc[4];
#pragma unroll
        for (int c = 0; c < 4; ++c) acc[c] = (f32x4){0.f, 0.f, 0.f, 0.f};
        {
            constexpr int NB = (KW + 127) / 128;
            bf16x8 a[2][4], bq[2][4][4];
#define SK_LOAD(set, k0) _Pragma("unroll") for (int s = 0; s < 4; ++s) if ((k0) + s * 32 < KW) { a[set][s] = *(const bf16x8*)(ap + (k0) + s * 32); \
                _Pragma("unroll") for (int c = 0; c < 4; ++c) bq[set][s][c] = *(const bf16x8*)(bp + (size_t)c * 16 * K + (k0) + s * 32); }
#define SK_MMA(set, k0) _Pragma("unroll") for (int s = 0; s < 4; ++s) if ((k0) + s * 32 < KW) { _Pragma("unroll") for (int c = 0; c < 4; ++c) acc[c] = mfma16(a[set][s], bq[set][s][c], acc[c]); }
            SK_LOAD(0, 0)
#pragma unroll
            for (int ib = 0; ib < NB; ++ib) {
                if (ib + 1 < NB) { SK_LOAD((ib + 1) & 1, (ib + 1) * 128) }
                __builtin_amdgcn_sched_barrier(0);
                SK_MMA(ib & 1, ib * 128)
                __builtin_amdgcn_sched_barrier(0);
            }
#undef SK_LOAD
#undef SK_MMA
        }
#pragma unroll
        for (int c = 0; c < 4; ++c)
#pragma unroll
            for (int jj = 0; jj < 4; ++jj) part[(wid * 16 + fq * 4 + jj) * 64 + c * 16 + fr] = acc[c][jj];
        __syncthreads();
        for (int e = tid; e < 1024; e += NTHR) {
            const int r = e >> 6, c = e & 63; float s = 0.f;
#pragma unroll
            for (int w = 0; w < 8; ++w) s += part[(w * 16 + r) * 64 + c];
            const size_t xo = (size_t)(MP + rf * 16 + r) * D + cc * 64 + c;
            X[xo] = alpha * bf2f(XB[xo]) + scale * s;
        }
        __syncthreads();
    }
}

#ifndef PROBE_CLASS
#define PROBE_CLASS 0
#endif
#define PB(c) { if (PROBE_CLASS && ((PROBE_MASK >> (c)) & 1)) t0_ = wall_clock64(); }
#define PE(c) { if (PROBE_CLASS && ((PROBE_MASK >> (c)) & 1)) t_acc += wall_clock64() - t0_; }
#ifndef PROBE_MASK
#define PROBE_MASK 0
#endif
#define XB_TMO      128
#define XB_XCNT(j)  (256  + 64 * (j))
#define XB_XSUB(j)  (1280 + 64 * (j))
#define XB_XGEN(j)  (2304 + 64 * (j))
#define XB_TOP      3328
#define XB_TOPGEN   3392
#define XCD_BAR_WORDS 3456
#define XB_SPIN_CAP (1u << 18)

__device__ __forceinline__ unsigned xb_ld(unsigned* p)              { return __hip_atomic_load(p, __ATOMIC_RELAXED, __HIP_MEMORY_SCOPE_AGENT); }
__device__ __forceinline__ unsigned xb_add(unsigned* p, unsigned v) { return __hip_atomic_fetch_add(p, v, __ATOMIC_RELAXED, __HIP_MEMORY_SCOPE_AGENT); }
__device__ __forceinline__ unsigned xb_xcc_id() { return (unsigned)__builtin_amdgcn_s_getreg((3 << 11) | 20) & 0xFu; }
#define XB_SPIN(cond, bar) do { unsigned _sp = 0; while (cond) { __builtin_amdgcn_s_sleep(1); \
    if ((++_sp & 255u) == 0u) { if (xb_ld(&(bar)[XB_TMO])) break; if (_sp > XB_SPIN_CAP) { atomicAdd(&(bar)[XB_TMO], 1u); break; } } } } while (0)

struct XcdBarrier {
    unsigned* bar; unsigned x;
    volatile LAS unsigned* st;
};

__device__ __forceinline__ XcdBarrier xcd_barrier_post(unsigned* bar, volatile LAS unsigned* st) {
    XcdBarrier b; b.bar = bar; b.x = xb_xcc_id(); b.st = st;
    if (threadIdx.x == 0) (void)xb_add(&bar[XB_XCNT(b.x)], 1u);
    return b;
}
__device__ __forceinline__ void xcd_barrier_complete(unsigned* bar, unsigned x, unsigned& nloc, unsigned& nx) {
    const unsigned G = gridDim.x * gridDim.y * gridDim.z;
    unsigned sum, cnt, mine, sp = 0u;
    for (;;) {
        sum = 0u; cnt = 0u; mine = 0u;
#pragma unroll
        for (unsigned j = 0; j < 16; ++j) { const unsigned c = xb_ld(&bar[XB_XCNT(j)]); sum += c; cnt += (c > 0u) ? 1u : 0u; mine = (j == x) ? c : mine; }
        if (sum == G) break;
        __builtin_amdgcn_s_sleep(1);
        if ((++sp & 255u) == 0u) { if (xb_ld(&bar[XB_TMO])) break; if (sp > XB_SPIN_CAP) { atomicAdd(&bar[XB_TMO], 1u); break; } }
    }
    nloc = mine > 0u ? mine : 1u; nx = cnt > 0u ? cnt : 1u;
}

__device__ __forceinline__ void xcd_barrier(const XcdBarrier& b) {
    asm volatile("s_waitcnt vmcnt(0)" ::: "memory");
    __syncthreads();
    if (threadIdx.x == 0) {
        unsigned* bar = b.bar;
        __builtin_amdgcn_s_waitcnt(0);
        unsigned nloc = b.st[0], nx = b.st[1];
        if (nloc == 0u) { xcd_barrier_complete(bar, b.x, nloc, nx); b.st[0] = nloc; b.st[1] = nx; }
        const unsigned old = xb_add(&bar[XB_XSUB(b.x)], 1u);
        const unsigned gen = old / nloc;
        if (old + 1u == (gen + 1u) * nloc) {
            __builtin_amdgcn_fence(__ATOMIC_RELEASE, "agent");
            asm volatile("s_waitcnt vmcnt(0)" ::: "memory");
            const unsigned og = xb_add(&bar[XB_TOP], 1u);
            const unsigned tg = og / nx;
            if (og + 1u == (tg + 1u) * nx) xb_add(&bar[XB_TOPGEN], 1u);
            else XB_SPIN(xb_ld(&bar[XB_TOPGEN]) == tg, bar);
            __builtin_amdgcn_fence(__ATOMIC_ACQUIRE, "agent");
            xb_add(&bar[XB_XGEN(b.x)], 1u);
            asm volatile("s_waitcnt vmcnt(0)" ::: "memory");
        } else {
            XB_SPIN(xb_ld(&bar[XB_XGEN(b.x)]) == gen, bar);
            __builtin_amdgcn_fence(__ATOMIC_ACQUIRE, "agent");
            asm volatile("s_waitcnt vmcnt(0)" ::: "memory");
        }
    }
    __syncthreads();
}


#define XSYNC() { if (PROBE_CLASS && ((PROBE_MASK >> 11) & 1)) { t0_ = wall_clock64(); grid.sync(); t_acc += wall_clock64() - t0_; } }
__global__ void __launch_bounds__(NTHR, 2) mega(Params p) {
    extern __shared__ __attribute__((aligned(16))) unsigned char lds_raw[];
    LAS unsigned char* lds = (LAS unsigned char*)lds_raw;
    cg::grid_group grid = cg::this_grid();
    const int G = gridDim.x, bid = blockIdx.x;
    float* X = p.out + O_Y; bf16_t* XB = (bf16_t*)(p.ws + OFF_XB); bf16_t* WT = (bf16_t*)(p.ws + OFF_WT);
    bf16_t* BIG = (bf16_t*)(p.ws + OFF_BIG);

    unsigned long long t_acc = 0, t0_ = 0;
    volatile LAS unsigned* xb_st = (volatile LAS unsigned*)(lds + 135 * 1024);
    if (threadIdx.x < 4) xb_st[threadIdx.x] = 0u;
    __syncthreads();
    const XcdBarrier xbar = xcd_barrier_post((unsigned*)(p.ws + OFF_CTR), xb_st);
#define GB() { xcd_barrier(xbar); if (PROBE_CLASS && ((PROBE_MASK >> 11) & 1)) { t0_ = wall_clock64(); xcd_barrier(xbar); t_acc += wall_clock64() - t0_; } }
    PB(9);
    init_phase(p, G, bid);
    convert_layer(lds, p, 0, G, bid);
    if (p.ws == nullptr) grid.sync();
    GB();
    PE(9);

    for (int l = 0; l < 4; ++l) {
        const int mixer = l % 3, j = l / 3;
        for (int sub = 0; sub < 3; ++sub) {
            const bf16_t* Aout; const bf16_t* Wout; int Kout; float scale;
            if (sub != 1) {
                PB(1);
                pg8::Gemm g{XB, WT + (sub == 0 ? W_1IN : W_2IN), MT, 2 * DFF, D}; pg8::StaticOrder S; S.init(MT, 2 * DFF, G, bid);
                EpiPair<1> E{BIG, DFF};
                pg8::gemm_phase<EpiPair<1>, pg8::StaticOrder>(lds, g, S, E, nullptr);
                Aout = BIG; Wout = WT + (sub == 0 ? W_1OUT : W_2OUT); Kout = DFF; scale = 0.5f;
                GB();
                PE(1);
            } else if (mixer == 0) {
                PB(1);
                { pg8::Gemm g{XB, WT + W_MIN, MT, GLA_NP, D}; pg8::StaticOrder S; S.init(MT, GLA_NP, G, bid);
                  EpiBf<0> E{(bf16_t*)(p.ws + OFF_P), GLA_NP, 0, 0};
                  pg8::gemm_phase<EpiBf<0>, pg8::StaticOrder>(lds, g, S, E, nullptr); }
                GB();
                PE(1);
                PB(4);
                gla_g1(lds, p, j, G, bid);
                GB();
                PE(4);
                PB(5);
                gla_g2(p, j, G, bid);
                GB();
                PE(5);
                PB(6);
                gla_g3(lds, p, j, G, bid);
                GB();
                PE(6);
                Aout = (const bf16_t*)(p.ws + OFF_AB); Wout = WT + W_MOUT; Kout = D; scale = 1.0f;
            } else if (mixer == 1) {
                PB(1);
                { pg8::Gemm g{XB, WT + W_MIN, MT, 4096, D}; pg8::StaticOrder S; S.init(MT, 4096, G, bid);
                  EpiBf<1> E{BIG, 2048, 2048, (size_t)MT * 2048, (float*)(p.ws + OFF_VSTAT)};
                  pg8::gemm_phase<EpiBf<1>, pg8::StaticOrder>(lds, g, S, E, nullptr); }
                GB();
                PE(1);
                PB(7);
                sg_phase(lds, p, j, G, bid);
                GB();
                PE(7);
                Aout = BIG; Wout = WT + W_MOUT; Kout = 2048; scale = 1.0f;
            } else {
                PB(1);
                { pg8::Gemm g{XB, WT + W_MIN, MT, 3072, D}; pg8::StaticOrder S; S.init(MT, 3072, G, bid);
                  EpiConv E{BIG, BIG + (size_t)MT * D};
                  pg8::gemm_phase<EpiConv, pg8::StaticOrder>(lds, g, S, E, nullptr); }
                GB();
                PE(1);
                PB(8);
                conv_phase(p, j, G, bid);
                GB();
                PE(8);
                Aout = BIG + (size_t)MT * D; Wout = WT + W_MOUT; Kout = D; scale = 1.0f;
            }
            if (sub != 1) PB(2) else PB(10)
            { pg8::Gemm g{Aout, Wout, MP, D, Kout}; pg8::StaticOrder S; S.init(MP, D, G, bid);
              EpiRes E{X, XB, ALPHA, scale};
              if (sub != 1) PB(12)
              pg8::gemm_phase<EpiRes, pg8::StaticOrder>(lds, g, S, E, nullptr);
              if (sub != 1) PE(12) }
            if (sub != 1) PB(13)
            if (Kout == DFF) skinny_out<DFF>(lds, Aout, Wout, X, XB, ALPHA, scale, G, bid);
            else if (Kout == 2048) skinny_out<2048>(lds, Aout, Wout, X, XB, ALPHA, scale, G, bid);
            else skinny_out<1024>(lds, Aout, Wout, X, XB, ALPHA, scale, G, bid);
            if (sub != 1) PE(13)
            GB();
            if (sub != 1) PE(2) else PE(10)
            PB(3);
            ln_phase(X, XB, p.in[4] + (size_t)(l * 3 + sub) * D, p.in[5] + (size_t)(l * 3 + sub) * D, G, bid, sub == 2 && l == 3);
            if (sub == 2 && l < 3) convert_layer(lds, p, l + 1, G, bid);
            if (!(sub == 2 && l == 3)) GB();
            PE(3);
        }
    }
    if (PROBE_CLASS) { __syncthreads(); if (bid == 0 && threadIdx.x == 0) X[0] += (float)t_acc * (0.01f / 256.0f); }
}

extern "C" void kernel_launch(void* const* d_in, const int* in_sizes, int n_in, void* d_out, int out_size, void* d_ws, size_t ws_size, hipStream_t stream) {
    static int grid_blocks = 0;
    if (grid_blocks == 0) {
        if (n_in != 24 || ws_size < WS_END) { fprintf(stderr, "kernel_launch: unexpected n_in %d or ws_size %zu (< %zu)\n", n_in, ws_size, (size_t)WS_END); grid_blocks = -1; return; }
        int dev = 0, cus = 0, per_cu = 0;
        hipGetDevice(&dev);
        hipDeviceGetAttribute(&cus, hipDeviceAttributeMultiprocessorCount, dev);
        if (hipFuncSetAttribute((const void*)mega, hipFuncAttributeMaxDynamicSharedMemorySize, LDS_BYTES) != hipSuccess) { fprintf(stderr, "kernel_launch: hipFuncSetAttribute failed\n"); grid_blocks = -1; return; }
        if (hipOccupancyMaxActiveBlocksPerMultiprocessor(&per_cu, (const void*)mega, NTHR, LDS_BYTES) != hipSuccess || per_cu < 1) { fprintf(stderr, "kernel_launch: occupancy query says %d\n", per_cu); per_cu = 1; }
        (void)hipGetLastError();
        grid_blocks = cus * 1;
    }
    if (grid_blocks < 0) return;
    Params p{};
    for (int i = 0; i < 24; ++i) p.in[i] = (const float*)d_in[i];
    p.out = (float*)d_out; p.ws = (unsigned char*)d_ws;
    if (hipMemsetAsync((char*)d_ws + OFF_CTR, 0, 16384, stream) != hipSuccess) { fprintf(stderr, "kernel_launch: memset of the barrier counter failed\n"); return; }
    void* args[] = {&p};
    hipError_t e = hipLaunchCooperativeKernel((const void*)mega, dim3(grid_blocks), dim3(NTHR), args, LDS_BYTES, stream);
    if (e != hipSuccess) fprintf(stderr, "cooperative launch failed: %s (grid %d)\n", hipGetErrorString(e), grid_blocks);
}
```

```cpp
#include <hip/hip_runtime.h>
#include <hip/hip_cooperative_groups.h>
#include <cstdio>
namespace cg = cooperative_groups;
namespace pg8 {
#define PG8_LAS __attribute__((address_space(3)))
typedef unsigned short bf16_t;
typedef short bf16x8 __attribute__((ext_vector_type(8)));
typedef float f32x4 __attribute__((ext_vector_type(4)));
typedef unsigned u32x4 __attribute__((ext_vector_type(4)));
constexpr int BM = 256, BK = 64, HALF = 128, HTB = HALF * BK * 2  , STAGE_BYTES = 8 * HTB, NXCD = 8, WGM = 8;

__host__ __device__ __forceinline__ int lds_byte(int r, int c) { const int st = (r >> 4) * 2 + (c >> 5), rr = r & 15, cc = c & 31, ob = rr * 64 + cc * 2; return st * 1024 + (ob ^ (((ob >> 9) & 1) << 5)); }
__host__ __device__ __forceinline__ void stage_rc(int b, int& R, int& C) { const int st = b / 1024, sb = b % 1024, swz = sb ^ (((sb >> 9) & 1) << 5); R = (st >> 1) * 16 + swz / 64; C = (st & 1) * 32 + (swz % 64) / 2; }
__host__ __device__ __forceinline__ int perm32(int rho) { const int n = rho >> 4, i = rho & 15; return 8 * (i >> 2) + 4 * n + (i & 3); }

struct Unit { int pm, pn; };
struct Gemm { const bf16_t* A; const bf16_t* Bt; int M, N, K; };

struct StaticOrder {
    int nM, nN, nwg, G, c;
    __host__ __device__ void init(int M, int N, int G_, int c_) { nM = M / BM; nN = N / BM; nwg = nM * nN; G = G_; c = c_; }
    __host__ __device__ bool next(int i, Unit& u) const {
        const long L = (long)i * G + c; if (L >= nwg) return false;
        int wgid = (int)L; { const int q = nwg / NXCD, r = nwg % NXCD, xcd = wgid % NXCD, off = wgid / NXCD; wgid = (xcd < r ? xcd * (q + 1) : r * (q + 1) + (xcd - r) * q) + off; }
        const int nig = WGM * nN, gid = wgid / nig, fm = gid * WGM, gsz = (nM - fm) < WGM ? (nM - fm) : WGM;
        u.pm = fm + ((wgid % nig) % gsz); u.pn = (wgid % nig) / gsz; return true;
    }
    __device__ __forceinline__ void a_ready(const Unit&) const {}
    __device__ __forceinline__ void done(const Unit&) const {}
};
struct CountedOrder : StaticOrder {
    const unsigned* ready; unsigned need; unsigned* tmo;
    __device__ __forceinline__ void a_ready(const Unit& u) const {
        if (threadIdx.x < 64) {
            const unsigned long long t0 = __builtin_amdgcn_s_memrealtime(); unsigned polls = 0;
            while ((unsigned)__builtin_amdgcn_readfirstlane(__hip_atomic_load(ready + 64 * u.pm, __ATOMIC_RELAXED, __HIP_MEMORY_SCOPE_AGENT)) < need) {
                if ((++polls & 255u) == 0u && __builtin_amdgcn_readfirstlane(__hip_atomic_load(tmo, __ATOMIC_RELAXED, __HIP_MEMORY_SCOPE_AGENT)) != 0u) break;
                if (__builtin_amdgcn_s_memrealtime() - t0 > 2000000ull) {
                    if (threadIdx.x == 0) { unsigned expect = 0u; __hip_atomic_compare_exchange_strong(tmo + 1, &expect, 0x600u | (unsigned)(u.pm & 0xff), __ATOMIC_RELAXED, __ATOMIC_RELAXED, __HIP_MEMORY_SCOPE_AGENT); __hip_atomic_store(tmo, 1u, __ATOMIC_RELAXED, __HIP_MEMORY_SCOPE_AGENT); }
                    break; }
                __builtin_amdgcn_s_sleep(2); }
            __builtin_amdgcn_fence(__ATOMIC_ACQUIRE, "agent");
            asm volatile("s_waitcnt vmcnt(0)" ::: "memory");
        }
#if !defined(BROKEN_HOOK_NO_BARRIER)
        asm volatile("" ::: "memory"); __builtin_amdgcn_s_barrier(); asm volatile("" ::: "memory");
#endif
    }
};

__device__ __forceinline__ unsigned cvt_pk_bf16(float lo, float hi) { unsigned r; asm volatile("v_cvt_pk_bf16_f32 %0, %1, %2" : "=v"(r) : "v"(lo), "v"(hi)); return r; }
typedef float f32x2 __attribute__((ext_vector_type(2)));
__device__ __forceinline__ f32x2 gelu_pk(f32x2 v) {
    const f32x2 av = __builtin_elementwise_abs(v), d = av * 0.2316418882f + 1.0f;
    f32x2 t; t.x = __builtin_amdgcn_rcpf(d.x); t.y = __builtin_amdgcn_rcpf(d.y);
    f32x2 q = t * 0.5307027145f + (-0.7265760135f); q = q * t + 0.7107068705f; q = q * t + (-0.142248368f); q = q * t + 0.127414796f; q = q * t;
    const f32x2 s = (v * v) * (-0.72134752044f);
    f32x2 e; e.x = __builtin_amdgcn_exp2f(s.x); e.y = __builtin_amdgcn_exp2f(s.y);
    const f32x2 m = v * (q * e), r = v - m;
    f32x2 o; o.x = v.x < 0.f ? m.x : r.x; o.y = v.y < 0.f ? m.y : r.y; return o;
}

template <class Epi, class Sched, bool STAMP = false>
__device__ __forceinline__ void gemm_phase(PG8_LAS unsigned char* lds, const Gemm g, const Sched& S, const Epi& E, unsigned long long* stamps) {
    int tid_ = threadIdx.x; asm volatile("" : "+v"(tid_)); const int tid = tid_, wid = __builtin_amdgcn_readfirstlane(tid >> 6), lane = tid & 63, wr = wid >> 2, wc = wid & 3, fr = lane & 15, fq = lane >> 4;
    const int K = g.K, nt = K / BK;
    int ts_lo = 0, ts_hi = 0, nts = 0; const unsigned long long rt_entry = STAMP ? (unsigned long long)wall_clock64() : 0ull;
#define PG8_STAMP() do { if (STAMP && wid == 0 && nts < 64) { const unsigned long long _c = (unsigned long long)clock64(); \
        ts_lo = (lane == nts) ? (int)(unsigned)_c : ts_lo; ts_hi = (lane == nts) ? (int)(unsigned)(_c >> 32) : ts_hi; ++nts; } } while (0)
    PG8_STAMP();
    unsigned voffA[2], voffB[2];
#pragma unroll
    for (int i = 0; i < 2; ++i) { int R, C; stage_rc(tid * 16 + i * 8192, R, C); const int Rb = Epi::PERM ? ((R & ~31) + perm32(R & 31)) : R;
        voffA[i] = (unsigned)(R * K + C) * 2u; voffB[i] = (unsigned)(Rb * K + C) * 2u; }
    const size_t kstep = (size_t)(BK * 2);
    const size_t hstep = (size_t)HALF * K * 2;
    const size_t tstep = 2 * hstep;
    const unsigned ldsw = (unsigned)wid * 1024u;
    const int aoff = lds_byte(wr * 64 + fr, fq * 8), boff = lds_byte(wc * 32 + fr, fq * 8);
#define PG8_SA(b, h) (((b) * 2 + (h)) * HTB)
#define PG8_SB(b, h) ((4 + (b) * 2 + (h)) * HTB)
#define PG8_STAGE(bufoff, gbase, voff) do { _Pragma("unroll") for (int _i = 0; _i < 2; ++_i) \
        __builtin_amdgcn_global_load_lds((const unsigned*)((const char*)(gbase) + (voff)[_i]), (PG8_LAS unsigned*)(lds + (bufoff) + ldsw + _i * 8192), 16, 0, 0); } while (0)
#define PG8_LDA(dst, b, h) do { _Pragma("unroll") for (int m = 0; m < 4; ++m) _Pragma("unroll") for (int k = 0; k < 2; ++k) dst[m][k] = *(const PG8_LAS bf16x8*)(lds + PG8_SA(b, h) + aoff + m * 2048 + k * 1024); } while (0)
#define PG8_LDB(dst, b, h) do { _Pragma("unroll") for (int n = 0; n < 2; ++n) _Pragma("unroll") for (int k = 0; k < 2; ++k) dst[n][k] = *(const PG8_LAS bf16x8*)(lds + PG8_SB(b, h) + boff + n * 2048 + k * 1024); } while (0)
#define PG8_MMA(ai, bj, At, Bt) do { __builtin_amdgcn_s_setprio(1); _Pragma("unroll") for (int m = 0; m < 4; ++m) _Pragma("unroll") for (int n = 0; n < 2; ++n) _Pragma("unroll") for (int k = 0; k < 2; ++k) \
        acc[ai][bj][m][n] = __builtin_amdgcn_mfma_f32_16x16x32_bf16(Bt[n][k], At[m][k], acc[ai][bj][m][n], 0, 0, 0); __builtin_amdgcn_s_setprio(0); } while (0)
#define PG8_WAIT_V(n) asm volatile("s_waitcnt vmcnt(" #n ")" ::: "memory")
#define PG8_WAIT_L(n) asm volatile("s_waitcnt lgkmcnt(" #n ")" ::: "memory")
#define PG8_BAR __builtin_amdgcn_s_barrier()
#define PG8_SCHED __builtin_amdgcn_sched_barrier(0)
    Unit cur, nxt; int ui = 0;
    if (!S.next(0, cur)) return;
    f32x4 acc[2][2][4][2];
#pragma unroll
    for (int a = 0; a < 2; ++a)
#pragma unroll
        for (int b = 0; b < 2; ++b)
#pragma unroll
            for (int m = 0; m < 4; ++m)
#pragma unroll
                for (int n = 0; n < 2; ++n) acc[a][b][m][n] = (f32x4){0.f, 0.f, 0.f, 0.f};
    bf16x8 At[4][2], B0[2][2], B1[2][2];
    const char* cA = (const char*)g.A + (size_t)cur.pm * tstep; const char* cB = (const char*)g.Bt + (size_t)cur.pn * tstep;
    S.a_ready(cur);
    PG8_STAGE(PG8_SB(0, 0), cB, voffB); PG8_STAGE(PG8_SA(0, 0), cA, voffA); PG8_STAGE(PG8_SB(0, 1), cB + hstep, voffB); PG8_STAGE(PG8_SA(0, 1), cA + hstep, voffA);
    if (wr == 1) PG8_BAR;
    PG8_WAIT_V(4); PG8_BAR;
    PG8_STAGE(PG8_SB(1, 0), cB + kstep, voffB); PG8_STAGE(PG8_SA(1, 0), cA + kstep, voffA); PG8_STAGE(PG8_SB(1, 1), cB + hstep + kstep, voffB);
    PG8_WAIT_V(6); PG8_BAR;
    PG8_STAMP();
    for (;;) {
        const bool has_next = S.next(ui + 1, nxt);
        const char* nA = has_next ? (const char*)g.A + (size_t)nxt.pm * tstep : cA; const char* nB = has_next ? (const char*)g.Bt + (size_t)nxt.pn * tstep : cB;
        for (int t = 0; t < nt; t += 2) {
            const bool last = (t == nt - 2);
            const char* a1 = cA + (size_t)(t + 1) * kstep;
            const char* a2 = last ? nA : cA + (size_t)(t + 2) * kstep; const char* b2 = last ? nB : cB + (size_t)(t + 2) * kstep;
            const char* a3 = a2 + kstep; const char* b3 = b2 + kstep;
            if (last && has_next) S.a_ready(nxt);
            PG8_LDB(B0, 0, 0); PG8_SCHED; PG8_LDA(At, 0, 0); PG8_STAGE(PG8_SA(1, 1), a1 + hstep, voffA);
            PG8_WAIT_L(8); PG8_BAR; PG8_WAIT_L(0); PG8_MMA(0, 0, At, B0); PG8_BAR; PG8_SCHED;
            PG8_LDB(B1, 0, 1); PG8_STAGE(PG8_SB(0, 0), b2, voffB);
            PG8_BAR; PG8_WAIT_L(0); PG8_MMA(0, 1, At, B1); PG8_BAR;
            PG8_LDA(At, 0, 1); PG8_STAGE(PG8_SA(0, 0), a2, voffA);
            PG8_BAR; PG8_WAIT_L(0); PG8_MMA(1, 0, At, B0); PG8_BAR; PG8_SCHED;
            PG8_STAGE(PG8_SB(0, 1), b2 + hstep, voffB);
            PG8_WAIT_V(6); PG8_BAR; PG8_MMA(1, 1, At, B1); PG8_BAR;
            PG8_LDB(B0, 1, 0); PG8_SCHED; PG8_LDA(At, 1, 0); PG8_STAGE(PG8_SA(0, 1), a2 + hstep, voffA);
            PG8_WAIT_L(8); PG8_BAR; PG8_WAIT_L(0); PG8_MMA(0, 0, At, B0); PG8_BAR; PG8_SCHED;
            PG8_LDB(B1, 1, 1); PG8_STAGE(PG8_SB(1, 0), b3, voffB);
            PG8_BAR; PG8_WAIT_L(0); PG8_MMA(0, 1, At, B1); PG8_BAR;
            PG8_LDA(At, 1, 1); PG8_STAGE(PG8_SA(1, 0), a3, voffA);
            PG8_BAR; PG8_WAIT_L(0); PG8_MMA(1, 0, At, B0); PG8_BAR; PG8_SCHED;
            PG8_STAGE(PG8_SB(1, 1), b3 + hstep, voffB);
            PG8_WAIT_V(6); PG8_BAR; PG8_MMA(1, 1, At, B1); PG8_BAR;
        }
        PG8_STAMP();
        if constexpr (!Epi::AFTER_DRAIN) { E(acc, cur, wr, wc, fr, fq); S.done(cur); }
        PG8_STAMP();
        if (!has_next) break;
#pragma unroll
        for (int a = 0; a < 2; ++a)
#pragma unroll
            for (int b = 0; b < 2; ++b)
#pragma unroll
                for (int m = 0; m < 4; ++m)
#pragma unroll
                    for (int n = 0; n < 2; ++n) acc[a][b][m][n] = (f32x4){0.f, 0.f, 0.f, 0.f};
        cur = nxt; cA = nA; cB = nB; ++ui;
    }
    PG8_WAIT_V(0);
    if (wr == 0) PG8_BAR;
    PG8_BAR;
    if constexpr (Epi::AFTER_DRAIN) { E.fused(acc, cur, wr, wc, fr, fq, lds, wid, lane); S.done(cur); }
    PG8_STAMP();
    if (STAMP && wid == 0) { stamps[lane] = lane < nts ? (((unsigned long long)(unsigned)ts_hi << 32) | (unsigned)ts_lo) : 0ull;
        if (lane == 62) stamps[62] = rt_entry; if (lane == 63) stamps[63] = (unsigned long long)wall_clock64(); }
#undef PG8_STAMP
#undef PG8_SA
#undef PG8_SB
#undef PG8_STAGE
#undef PG8_LDA
#undef PG8_LDB
#undef PG8_MMA
#undef PG8_WAIT_V
#undef PG8_WAIT_L
#undef PG8_BAR
#undef PG8_SCHED
}
}

#define LAS __attribute__((address_space(3)))
using pg8::bf16_t; using pg8::bf16x8; using pg8::f32x4; using pg8::u32x4; using pg8::Unit;
typedef unsigned u32x2 __attribute__((ext_vector_type(2)));

constexpr int D = 1024, MP = 16384, MS = 256, MT = MP + MS, DFF = 2816;
constexpr int GLA_N = 3088, GLA_NP = 3328;
constexpr float ALPHA = 1.681792830507429f, LN_EPS = 1e-5f;
constexpr int NTHR = 512;
constexpr int LDS_BYTES = 136 * 1024;

constexpr size_t WT_BYTES = 48ull << 20;
constexpr size_t OFF_WT = 0;
constexpr size_t OFF_XB = OFF_WT + WT_BYTES;
constexpr size_t OFF_BIG = OFF_XB + (size_t)MT * D * 2;
constexpr int NSLOT = 1024 + 32;
constexpr size_t OFF_P = OFF_BIG;
constexpr size_t OFF_SB = OFF_P + (size_t)MT * GLA_NP * 2;
constexpr size_t OFF_BB = OFF_SB + (size_t)NSLOT * 32768 * 4;
constexpr size_t OFF_AB = OFF_BB + (size_t)MT * 512 * 4;
constexpr size_t OFF_DK = OFF_AB + (size_t)MT * D * 2;
constexpr size_t OFF_CTR = OFF_DK + (size_t)NSLOT * 128 * 4;
constexpr size_t WS_END = OFF_CTR + 16384;
constexpr size_t W_1IN = 0, W_1OUT = 5767168, W_2IN = 8650752, W_2OUT = 14417920, W_MIN = 17301504, W_MOUT = 21495808;
constexpr size_t O_Y = 0, O_GLAP = 17039360, O_GLAS = 17301504, O_CONVP = 19398656, O_CONVS = 19400704, O_SGV = 19417088;

struct Params { const float* in[24]; float* out; unsigned char* ws; };

__device__ __forceinline__ unsigned pk2(float lo, float hi) { return pg8::cvt_pk_bf16(lo, hi); }
__device__ __forceinline__ bf16_t f2bf(float f) { return (bf16_t)(pk2(f, 0.f) & 0xffffu); }
__device__ __forceinline__ float bf2f(bf16_t b) { return __uint_as_float(((unsigned)b) << 16); }
__device__ __forceinline__ float bflo(unsigned w) { return __uint_as_float(w << 16); }
__device__ __forceinline__ float bfhi(unsigned w) { return __uint_as_float(w & 0xffff0000u); }
__device__ __forceinline__ float silu_f(float x) { return x * __builtin_amdgcn_rcpf(1.0f + __expf(-x)); }
__device__ __forceinline__ float gelu_tanh_f(float x) { const float z = 1.5957691216057308f * (x + 0.044715f * x * x * x); return x * __builtin_amdgcn_rcpf(1.0f + __expf(-z)); }
__device__ __forceinline__ float logsigmoid_f(float z) { return fminf(z, 0.f) - __logf(1.0f + __expf(-fabsf(z))); }

template <int ACT> struct EpiPair {
    static constexpr bool PERM = true, AFTER_DRAIN = false;
    bf16_t* O; int ldo;
    __device__ __forceinline__ void operator()(const f32x4 (&acc)[2][2][4][2], const Unit& u, int wr, int wc, int fr, int fq) const {
        const int row0 = u.pm * 256 + wr * 64 + fr, col0 = u.pn * 128 + wc * 32 + 8 * fq;
#pragma unroll
        for (int ai = 0; ai < 2; ++ai)
#pragma unroll
            for (int m = 0; m < 4; ++m) {
                bf16_t* rowp = O + (size_t)(row0 + ai * 128 + m * 16) * ldo + col0;
                f32x4 v0, v1;
#pragma unroll
                for (int j = 0; j < 4; ++j) {
                    const float a0 = acc[ai][0][m][0][j], a1 = acc[ai][0][m][1][j];
                    v0[j] = (ACT ? silu_f(a0) : a0) * acc[ai][1][m][0][j];
                    v1[j] = (ACT ? silu_f(a1) : a1) * acc[ai][1][m][1][j];
                }
                u32x4 w; w.x = pk2(v0[0], v0[1]); w.y = pk2(v0[2], v0[3]); w.z = pk2(v1[0], v1[1]); w.w = pk2(v1[2], v1[3]);
                *(u32x4*)rowp = w;
            }
    }
};
template <int ACT> struct EpiBf {
    static constexpr bool PERM = true, AFTER_DRAIN = false;
    bf16_t* O; int ldc; int split_cols; size_t split_stride; float* vstat = nullptr;
    __device__ __forceinline__ void operator()(const f32x4 (&acc)[2][2][4][2], const Unit& u, int wr, int wc, int fr, int fq) const {
        const int row0 = u.pm * 256 + wr * 64 + fr; int colt = u.pn * 256; bf16_t* base = O;
        if (split_cols) { const int t = colt / split_cols; base += (size_t)t * split_stride; colt -= t * split_cols; }
        const int col0 = colt + wc * 32 + 8 * fq;
#pragma unroll
        for (int ai = 0; ai < 2; ++ai)
#pragma unroll
            for (int m = 0; m < 4; ++m) {
                bf16_t* rowp = base + (size_t)(row0 + ai * 128 + m * 16) * ldc + col0;
                float ssum = 0.f, qsum = 0.f;
#pragma unroll
                for (int bj = 0; bj < 2; ++bj) {
                    f32x4 v0 = acc[ai][bj][m][0], v1 = acc[ai][bj][m][1];
                    if (ACT == 1) {
#pragma unroll
                        for (int j = 0; j < 4; ++j) { v0[j] = gelu_tanh_f(v0[j]); v1[j] = gelu_tanh_f(v1[j]); }
                    }
                    u32x4 w; w.x = pk2(v0[0], v0[1]); w.y = pk2(v0[2], v0[3]); w.z = pk2(v1[0], v1[1]); w.w = pk2(v1[2], v1[3]);
                    *(u32x4*)(rowp + bj * 128) = w;
                    if (ACT == 1) {
                        const float f0 = bflo(w.x), f1 = bfhi(w.x), f2 = bflo(w.y), f3 = bfhi(w.y), f4 = bflo(w.z), f5 = bfhi(w.z), f6 = bflo(w.w), f7 = bfhi(w.w);
                        ssum += ((f0 + f1) + (f2 + f3)) + ((f4 + f5) + (f6 + f7));
                        qsum += ((f0 * f0 + f1 * f1) + (f2 * f2 + f3 * f3)) + ((f4 * f4 + f5 * f5) + (f6 * f6 + f7 * f7));
                    }
                }
                if (ACT == 1) {
                    if (vstat != nullptr && u.pn >= 8) {
                        ssum += __shfl_xor(ssum, 16); ssum += __shfl_xor(ssum, 32); qsum += __shfl_xor(qsum, 16); qsum += __shfl_xor(qsum, 32);
                        if (fq == 0) { float* sp = vstat + ((size_t)(row0 + ai * 128 + m * 16) * 32 + (u.pn - 8) * 4 + wc) * 2; sp[0] = ssum; sp[1] = qsum; }
                    }
                }
            }
    }
};
struct EpiConv {
    static constexpr bool PERM = true, AFTER_DRAIN = false;
    bf16_t* CIN; bf16_t* BG;
    __device__ __forceinline__ void operator()(const f32x4 (&acc)[2][2][4][2], const Unit& u, int wr, int wc, int fr, int fq) const {
        if (u.pn < 8) { EpiPair<0> e{CIN, D}; e(acc, u, wr, wc, fr, fq); }
        else { EpiBf<0> e{BG, D, 0, 0}; Unit v = u; v.pn = u.pn - 8; e(acc, v, wr, wc, fr, fq); }
    }
};
struct EpiRes {
    static constexpr bool PERM = false, AFTER_DRAIN = false;
    float* X; bf16_t* XB; float alpha, scale; bool yf32;
    __device__ __forceinline__ void operator()(const f32x4 (&acc)[2][2][4][2], const Unit& u, int wr, int wc, int fr, int fq) const {
        const int row0 = u.pm * 256 + wr * 64 + fr, col0 = u.pn * 256 + wc * 32 + 4 * fq;
#pragma unroll
        for (int ai = 0; ai < 2; ++ai) {
            const size_t off = (size_t)(row0 + ai * 128) * D + col0;
            u32x2 xv[4][2][2];
#pragma unroll
            for (int m = 0; m < 4; ++m)
#pragma unroll
                for (int bj = 0; bj < 2; ++bj)
#pragma unroll
                    for (int n = 0; n < 2; ++n) xv[m][bj][n] = *(const u32x2*)(XB + off + m * 16 * D + bj * 128 + n * 16);
            __builtin_amdgcn_sched_barrier(0);
#pragma unroll
            for (int m = 0; m < 4; ++m)
#pragma unroll
                for (int bj = 0; bj < 2; ++bj)
#pragma unroll
                    for (int n = 0; n < 2; ++n) {
                        const u32x2 w = xv[m][bj][n]; const f32x4 x = (f32x4){bflo(w.x), bfhi(w.x), bflo(w.y), bfhi(w.y)};
                        const f32x4 y = x * alpha + acc[ai][bj][m][n] * scale;
                        if (yf32) *(f32x4*)(X + off + m * 16 * D + bj * 128 + n * 16) = y;
                        else { u32x2 yw; yw.x = pk2(y[0], y[1]); yw.y = pk2(y[2], y[3]); *(u32x2*)(XB + off + m * 16 * D + bj * 128 + n * 16) = yw; }
                    }
            __builtin_amdgcn_sched_barrier(0);
        }
    }
};

__device__ __forceinline__ int srccol(int mode, int n) {
    if (mode == 1) { const int pn = n >> 8, c = n & 255; return (c >> 7) * DFF + pn * 128 + (c & 127); }
    if (mode == 2) { if (n < 2048) { const int pn = n >> 8, c = n & 255; return 1024 + (c >> 7) * 1024 + pn * 128 + (c & 127); } return n - 2048; }
    return n;
}
__device__ __forceinline__ void convert_matrix(LAS unsigned char* lds, const float* __restrict__ W, bf16_t* __restrict__ Wt, int K, int Nsrc, int Ndst, int Nvalid, int mode, int G, int bid) {
    LAS bf16_t* tile = (LAS bf16_t*)lds;
    int tid_ = threadIdx.x; asm volatile("" : "+v"(tid_)); const int tid = tid_, ntn = Ndst >> 6, ntk = K >> 8, ntot = ntn * ntk;
    for (int t = bid; t < ntot; t += G) {
        const int tn = t % ntn, tk = t / ntn, n0 = tn * 64, k0 = tk * 256, sc0 = srccol(mode, n0);
        const int kk = tid >> 3, cc = (tid & 7) * 8;
        float4 v0[4], v1[4];
        const bool ok = n0 + cc < Nvalid;
#pragma unroll
        for (int q = 0; q < 4; ++q) {
            v0[q] = make_float4(0.f, 0.f, 0.f, 0.f); v1[q] = v0[q];
            if (ok) { const float* s = W + (size_t)(k0 + q * 64 + kk) * Nsrc + sc0 + cc; v0[q] = *(const float4*)s; v1[q] = *(const float4*)(s + 4); }
        }
        __builtin_amdgcn_sched_barrier(0);
#pragma unroll
        for (int q = 0; q < 4; ++q) {
            LAS bf16_t* tp = tile + cc * 264 + q * 64 + kk;
            tp[0] = f2bf(v0[q].x); tp[264] = f2bf(v0[q].y); tp[528] = f2bf(v0[q].z); tp[792] = f2bf(v0[q].w);
            tp[1056] = f2bf(v1[q].x); tp[1320] = f2bf(v1[q].y); tp[1584] = f2bf(v1[q].z); tp[1848] = f2bf(v1[q].w);
        }
        __syncthreads();
#pragma unroll
        for (int i = 0; i < 4; ++i) {
            const int id = tid + i * NTHR, nl = id >> 5, kc = (id & 31) * 8;
            const u32x4 w = *(const LAS u32x4*)(tile + nl * 264 + kc);
            *(u32x4*)(Wt + (size_t)(n0 + nl) * K + k0 + kc) = w;
        }
        __syncthreads();
    }
}
__device__ __forceinline__ void convert_layer(LAS unsigned char* lds, const Params& p, int l, int G, int bid) {
    bf16_t* WT = (bf16_t*)(p.ws + OFF_WT);
    convert_matrix(lds, p.in[6] + (size_t)l * D * 2 * DFF, WT + W_1IN, D, 2 * DFF, 2 * DFF, 2 * DFF, 1, G, bid);
    convert_matrix(lds, p.in[7] + (size_t)l * DFF * D, WT + W_1OUT, DFF, D, D, D, 0, G, bid);
    convert_matrix(lds, p.in[8] + (size_t)l * D * 2 * DFF, WT + W_2IN, D, 2 * DFF, 2 * DFF, 2 * DFF, 1, G, bid);
    convert_matrix(lds, p.in[9] + (size_t)l * DFF * D, WT + W_2OUT, DFF, D, D, D, 0, G, bid);
    const int mixer = l % 3, j = l / 3;
    if (mixer == 0) {
        convert_matrix(lds, p.in[10] + (size_t)j * D * GLA_N, WT + W_MIN, D, GLA_N, GLA_NP, GLA_N, 0, G, bid);
        convert_matrix(lds, p.in[14] + (size_t)j * D * D, WT + W_MOUT, D, D, D, D, 0, G, bid);
    } else if (mixer == 1) {
        convert_matrix(lds, p.in[15] + (size_t)j * D * 4096, WT + W_MIN, D, 4096, 4096, 4096, 0, G, bid);
        convert_matrix(lds, p.in[20] + (size_t)j * 2048 * D, WT + W_MOUT, 2048, D, D, D, 0, G, bid);
    } else {
        convert_matrix(lds, p.in[21] + (size_t)j * D * 3072, WT + W_MIN, D, 3072, 3072, 3072, 2, G, bid);
        convert_matrix(lds, p.in[23] + (size_t)j * D * D, WT + W_MOUT, D, D, D, D, 0, G, bid);
    }
}

__device__ __forceinline__ void init_phase(const Params& p, int G, int bid) {
    float* X = p.out + O_Y; bf16_t* XB = (bf16_t*)(p.ws + OFF_XB);
    const size_t n4 = (size_t)MT * D / 4, np4 = (size_t)MP * D / 4;
    int tid_ = threadIdx.x; asm volatile("" : "+v"(tid_));
    for (size_t i = (size_t)bid * NTHR + tid_; i < n4; i += (size_t)G * NTHR) {
        const float4 v = (i < np4) ? ((const float4*)p.in[0])[i] : ((const float4*)p.in[1])[i - np4];
        u32x2 w; w.x = pk2(v.x, v.y); w.y = pk2(v.z, v.w);
        ((u32x2*)XB)[i] = w;
    }
}

__device__ __forceinline__ void ln_row(float* xr, bf16_t* xb, const float4 (&v)[4], const float4 (&gv)[4], const float4 (&bv)[4], int lane, bool fin) {
    float s = 0.f;
#pragma unroll
    for (int i = 0; i < 4; ++i) s += (v[i].x + v[i].y) + (v[i].z + v[i].w);
#pragma unroll
    for (int o = 32; o >= 1; o >>= 1) s += __shfl_xor(s, o);
    const float mean = s * (1.0f / D);
    float q = 0.f;
#pragma unroll
    for (int i = 0; i < 4; ++i) { const float a = v[i].x - mean, b2 = v[i].y - mean, c = v[i].z - mean, d = v[i].w - mean; q += (a * a + b2 * b2) + (c * c + d * d); }
#pragma unroll
    for (int o = 32; o >= 1; o >>= 1) q += __shfl_xor(q, o);
    const float rstd = 1.0f / sqrtf(q * (1.0f / D) + LN_EPS);
#pragma unroll
    for (int i = 0; i < 4; ++i) {
        float4 y;
        y.x = (v[i].x - mean) * rstd * gv[i].x + bv[i].x; y.y = (v[i].y - mean) * rstd * gv[i].y + bv[i].y;
        y.z = (v[i].z - mean) * rstd * gv[i].z + bv[i].z; y.w = (v[i].w - mean) * rstd * gv[i].w + bv[i].w;
        if (fin) *(float4*)(xr + (i * 64 + lane) * 4) = y;
        else { u32x2 w; w.x = pk2(y.x, y.y); w.y = pk2(y.z, y.w); *(u32x2*)(xb + (i * 64 + lane) * 4) = w; }
    }
}
__device__ __forceinline__ void ln_phase(float* X, bf16_t* XB, const float* __restrict__ g, const float* __restrict__ b, int G, int bid, bool fin) {
    int tid_ = threadIdx.x; asm volatile("" : "+v"(tid_)); const int tid = tid_, wid = tid >> 6, lane = tid & 63;
    float4 gv[4], bv[4];
#pragma unroll
    for (int i = 0; i < 4; ++i) { gv[i] = *(const float4*)(g + (i * 64 + lane) * 4); bv[i] = *(const float4*)(b + (i * 64 + lane) * 4); }
    for (int row = bid * 8 + wid; row < MT; row += 4 * G * 8) {
        int rr[4]; bool has[4]; float4 v[4][4];
#pragma unroll
        for (int k = 0; k < 4; ++k) { rr[k] = row + k * G * 8; has[k] = rr[k] < MT; if (!has[k]) rr[k] = row; }
        if (fin) {
#pragma unroll
            for (int k = 0; k < 4; ++k)
#pragma unroll
                for (int i = 0; i < 4; ++i) v[k][i] = *(const float4*)(X + (size_t)rr[k] * D + (i * 64 + lane) * 4);
        } else {
            u32x2 w[4][4];
#pragma unroll
            for (int k = 0; k < 4; ++k)
#pragma unroll
                for (int i = 0; i < 4; ++i) w[k][i] = *(const u32x2*)(XB + (size_t)rr[k] * D + (i * 64 + lane) * 4);
            __builtin_amdgcn_sched_barrier(0);
#pragma unroll
            for (int k = 0; k < 4; ++k)
#pragma unroll
                for (int i = 0; i < 4; ++i) v[k][i] = make_float4(bflo(w[k][i].x), bfhi(w[k][i].x), bflo(w[k][i].y), bfhi(w[k][i].y));
        }
        __builtin_amdgcn_sched_barrier(0);
#pragma unroll
        for (int k = 0; k < 4; ++k) if (has[k]) ln_row(X + (size_t)rr[k] * D, XB + (size_t)rr[k] * D, v[k], gv, bv, lane, fin);
    }
}

__device__ __forceinline__ void unpack8(const u32x4 w, float (&f)[8]) { f[0] = bflo(w.x); f[1] = bfhi(w.x); f[2] = bflo(w.y); f[3] = bfhi(w.y); f[4] = bflo(w.z); f[5] = bfhi(w.z); f[6] = bflo(w.w); f[7] = bfhi(w.w); }
__device__ __forceinline__ void conv_phase(const Params& p, int j, int G, int bid) {
    const bf16_t* CIN = (const bf16_t*)(p.ws + OFF_BIG); bf16_t* BG = (bf16_t*)(p.ws + OFF_BIG + (size_t)MT * D * 2);
    const float* wc = p.in[22] + (size_t)j * 3 * D; const float* st = p.in[3] + (size_t)j * 8 * 2 * D;
    float* outp = p.out + O_CONVP + (size_t)j * 2 * D; float* outs = p.out + O_CONVS + (size_t)j * 8 * 2 * D;
    const int total = MT * 128;
    int tid_ = threadIdx.x; asm volatile("" : "+v"(tid_));
    for (int idx = bid * NTHR + tid_; idx < total; idx += G * NTHR) {
        const int r = idx >> 7, c8 = (idx & 127) * 8;
        const bool samp = r >= MP; const int t = samp ? ((r - MP) & 31) : r, b = samp ? ((r - MP) >> 5) : 0, T = samp ? 32 : MP;
        float c0[8], c1[8], c2[8], bg[8];
        unpack8(*(const u32x4*)(CIN + (size_t)r * D + c8), c0);
        if (t >= 1) unpack8(*(const u32x4*)(CIN + (size_t)(r - 1) * D + c8), c1);
        else if (samp) { const float4 a = *(const float4*)(st + (size_t)(b * 2 + 1) * D + c8), a2 = *(const float4*)(st + (size_t)(b * 2 + 1) * D + c8 + 4); c1[0] = a.x; c1[1] = a.y; c1[2] = a.z; c1[3] = a.w; c1[4] = a2.x; c1[5] = a2.y; c1[6] = a2.z; c1[7] = a2.w; }
        else { for (int i = 0; i < 8; ++i) c1[i] = 0.f; }
        if (t >= 2) unpack8(*(const u32x4*)(CIN + (size_t)(r - 2) * D + c8), c2);
        else if (samp) { const float4 a = *(const float4*)(st + (size_t)(b * 2 + t) * D + c8), a2 = *(const float4*)(st + (size_t)(b * 2 + t) * D + c8 + 4); c2[0] = a.x; c2[1] = a.y; c2[2] = a.z; c2[3] = a.w; c2[4] = a2.x; c2[5] = a2.y; c2[6] = a2.z; c2[7] = a2.w; }
        else { for (int i = 0; i < 8; ++i) c2[i] = 0.f; }
        unpack8(*(const u32x4*)(BG + (size_t)r * D + c8), bg);
        float z[8];
#pragma unroll
        for (int i = 0; i < 8; ++i) z[i] = bg[i] * (wc[c8 + i] * c2[i] + wc[D + c8 + i] * c1[i] + wc[2 * D + c8 + i] * c0[i]);
        u32x4 w; w.x = pk2(z[0], z[1]); w.y = pk2(z[2], z[3]); w.z = pk2(z[4], z[5]); w.w = pk2(z[6], z[7]);
        *(u32x4*)(BG + (size_t)r * D + c8) = w;
        if (t >= T - 2) {
            float* o = (samp ? outs + (size_t)(b * 2 + (t - (T - 2))) * D : outp + (size_t)(t - (T - 2)) * D) + c8;
            *(float4*)o = make_float4(c0[0], c0[1], c0[2], c0[3]); *(float4*)(o + 4) = make_float4(c0[4], c0[5], c0[6], c0[7]);
        }
    }
}

__device__ __forceinline__ void gla_item(int slot, int& row0, int& len, int& h) { h = slot & 3; if (slot < 1024) { row0 = (slot >> 2) * 64; len = 64; } else { row0 = MP + ((slot - 1024) >> 2) * 32; len = 32; } }
__device__ __forceinline__ f32x4 mfma16(const bf16x8 a, const bf16x8 b, const f32x4 c) { return __builtin_amdgcn_mfma_f32_16x16x32_bf16(a, b, c, 0, 0, 0); }

__device__ __forceinline__ void gla_g1(LAS unsigned char* lds, const Params& p, int j, int G, int bid) {
    const bf16_t* P = (const bf16_t*)(p.ws + OFF_P); bf16_t* SB = (bf16_t*)(p.ws + OFF_SB); float* BB = (float*)(p.ws + OFF_BB); float* DK = (float*)(p.ws + OFF_DK);
    const float* wgk = p.in[11] + (size_t)j * 16 * 512; const float* bgk = p.in[12] + (size_t)j * 512;
    LAS float* gls = (LAS float*)lds;
    LAS float* wg = (LAS float*)(lds + 4096);
    LAS float* tot = (LAS float*)(lds + 12288);
    LAS bf16_t* khT = (LAS bf16_t*)(lds + 16384);
    LAS bf16_t* vT = (LAS bf16_t*)(lds + 34816);
    int tid_ = threadIdx.x; asm volatile("" : "+v"(tid_)); const int tid = tid_, wid = tid >> 6, lane = tid & 63, fr = lane & 15, fq = lane >> 4;
    const int kd = tid & 127, q4 = tid >> 7, vdv = tid & 255, hv = tid >> 8;
    for (int slot = bid; slot < NSLOT; slot += G) {
        int row0, len, h; gla_item(slot, row0, len, h);
        const bf16_t* Pr = P + (size_t)row0 * GLA_NP;
        float kf[16];
#pragma unroll
        for (int i = 0; i < 16; ++i) { const unsigned tt = 16u * q4 + i, tc = tt < (unsigned)len ? tt : 0u; const float kx = bf2f(Pr[tc * (unsigned)GLA_NP + 512u + h * 128 + kd]); kf[i] = tt < (unsigned)len ? kx : 0.f; }
        for (int idx = tid; idx < 1024; idx += NTHR) { const int t = idx >> 4, r = idx & 15; gls[idx] = t < len ? bf2f(Pr[(size_t)t * GLA_NP + 3072 + r]) : 0.f; }
        for (int idx = tid; idx < 2048; idx += NTHR) { const int r = idx >> 7, c = idx & 127; wg[idx] = wgk[r * 512 + h * 128 + c]; }
        __syncthreads();
        float bl[16];
        {
            float wr_[16];
#pragma unroll
            for (int r = 0; r < 16; ++r) wr_[r] = wg[r * 128 + kd];
            const float bias = bgk[h * 128 + kd]; float run = 0.f;
#pragma unroll
            for (int i = 0; i < 16; ++i) {
                const int t = 16 * q4 + i; float z = bias;
#pragma unroll
                for (int r = 0; r < 16; ++r) z += gls[t * 16 + r] * wr_[r];
                run += t < len ? logsigmoid_f(z) * (1.0f / 16.0f) : 0.f; bl[i] = run;
            }
            tot[q4 * 128 + kd] = run;
        }
        __syncthreads();
        {
            const float t0 = tot[kd], t1 = tot[128 + kd], t2 = tot[256 + kd], t3 = tot[384 + kd];
            const float off = (q4 > 0 ? t0 : 0.f) + (q4 > 1 ? t1 : 0.f) + (q4 > 2 ? t2 : 0.f), blast = (t0 + t1) + (t2 + t3);
            if (q4 == 0) DK[(size_t)slot * 128 + kd] = __expf(blast);
            float kh[16];
#pragma unroll
            for (int i = 0; i < 16; ++i) {
                const int t = 16 * q4 + i; const float bt = off + bl[i];
                if (t < len) BB[(size_t)(row0 + t) * 512 + h * 128 + kd] = bt;
                kh[i] = kf[i] * __expf(blast - bt);
            }
            u32x4 w0, w1;
            w0.x = pk2(kh[0], kh[1]); w0.y = pk2(kh[2], kh[3]); w0.z = pk2(kh[4], kh[5]); w0.w = pk2(kh[6], kh[7]);
            w1.x = pk2(kh[8], kh[9]); w1.y = pk2(kh[10], kh[11]); w1.z = pk2(kh[12], kh[13]); w1.w = pk2(kh[14], kh[15]);
            *(LAS u32x4*)(khT + kd * 72 + 16 * q4) = w0; *(LAS u32x4*)(khT + kd * 72 + 16 * q4 + 8) = w1;
        }
        {
            const bf16_t* vb = Pr + 1024 + h * 256;
#pragma nounroll
            for (int bt = 0; bt < 2; ++bt) {
                const unsigned tb = 32u * hv + 16u * bt; unsigned vr[8];
#pragma unroll
                for (int i = 0; i < 8; ++i) {
                    const unsigned ta = tb + 2u * i, ca = ta < (unsigned)len ? ta : 0u, cb = ta + 1u < (unsigned)len ? ta + 1u : 0u;
                    const unsigned lo = vb[ca * (unsigned)GLA_NP + vdv], hi = vb[cb * (unsigned)GLA_NP + vdv];
                    vr[i] = (ta < (unsigned)len ? lo : 0u) | ((ta + 1u < (unsigned)len ? hi : 0u) << 16);
                }
                u32x4 w0, w1; w0.x = vr[0]; w0.y = vr[1]; w0.z = vr[2]; w0.w = vr[3]; w1.x = vr[4]; w1.y = vr[5]; w1.z = vr[6]; w1.w = vr[7];
                *(LAS u32x4*)(vT + vdv * 72 + tb) = w0; *(LAS u32x4*)(vT + vdv * 72 + tb + 8) = w1;
            }
        }
        __syncthreads();
        f32x4 acc[2][8];
#pragma unroll
        for (int r = 0; r < 2; ++r)
#pragma unroll
            for (int c = 0; c < 8; ++c) acc[r][c] = (f32x4){0.f, 0.f, 0.f, 0.f};
#pragma unroll
        for (int ks = 0; ks < 2; ++ks) {
            bf16x8 a[2];
#pragma unroll
            for (int r = 0; r < 2; ++r) a[r] = *(const LAS bf16x8*)(vT + ((wid * 2 + r) * 16 + fr) * 72 + ks * 32 + fq * 8);
#pragma unroll
            for (int c = 0; c < 8; ++c) {
                const bf16x8 bfr = *(const LAS bf16x8*)(khT + (c * 16 + fr) * 72 + ks * 32 + fq * 8);
#pragma unroll
                for (int r = 0; r < 2; ++r) acc[r][c] = mfma16(bfr, a[r], acc[r][c]);
            }
        }
        bf16_t* sb = SB + (size_t)slot * 32768 + (unsigned)((wid * 32 + fr) * 128 + fq * 4);
#pragma unroll
        for (int r = 0; r < 2; ++r) {
            bf16_t* sbr = sb + r * 2048; asm volatile("" : "+v"(sbr));
#pragma unroll
            for (int c = 0; c < 8; ++c) { u32x2 w; w.x = pk2(acc[r][c][0], acc[r][c][1]); w.y = pk2(acc[r][c][2], acc[r][c][3]); *(u32x2*)(sbr + c * 16) = w; }
        }
        __syncthreads();
    }
}

__device__ __forceinline__ void gla_g2(const Params& p, int j, int G, int bid) {
    unsigned* SB = (unsigned*)(p.ws + OFF_SB); const float* DK = (const float*)(p.ws + OFF_DK);
    int tid_ = threadIdx.x; asm volatile("" : "+v"(tid_));
    for (int e = bid * NTHR + tid_; e < 65536; e += G * NTHR) {
        const int h = e >> 14, vd = (e >> 6) & 255, k2 = e & 63;
        unsigned* ps = SB + (size_t)h * 16384 + vd * 64 + k2; const float* pd = DK + h * 128 + 2 * k2;
        float S0 = 0.f, S1 = 0.f;
        for (int c0 = 0; c0 < 256; c0 += 32) {
            unsigned ds[32]; float2 dd[32];
#pragma unroll
            for (int i = 0; i < 32; ++i) { ds[i] = ps[(size_t)(c0 + i) * 65536]; dd[i] = *(const float2*)(pd + (c0 + i) * 512); }
            __builtin_amdgcn_sched_barrier(0);
#pragma unroll
            for (int i = 0; i < 32; ++i) { ps[(size_t)(c0 + i) * 65536] = pk2(S0, S1); S0 = dd[i].x * S0 + bflo(ds[i]); S1 = dd[i].y * S1 + bfhi(ds[i]); }
        }
        float* o = p.out + O_GLAP + (size_t)j * 131072 + h * 32768 + (2 * k2) * 256 + vd;
        o[0] = S0; o[256] = S1;
    }
    const float* st = p.in[2] + (size_t)j * 8 * 131072;
    for (int e = bid * NTHR + tid_; e < 8 * 65536; e += G * NTHR) {
        const int b = e >> 16, h = (e >> 14) & 3, vd = (e >> 6) & 255, k2 = e & 63, slot = 1024 + b * 4 + h;
        unsigned* ps = SB + (size_t)slot * 16384 + vd * 64 + k2;
        const size_t so = (size_t)(b * 4 + h) * 32768 + (2 * k2) * 256 + vd;
        const float A0 = st[so], A1 = st[so + 256]; const unsigned ds = *ps; const float2 dd = *(const float2*)(DK + slot * 128 + 2 * k2);
        *ps = pk2(A0, A1);
        float* o = p.out + O_GLAS + (size_t)j * 8 * 131072 + so;
        o[0] = dd.x * A0 + bflo(ds); o[256] = dd.y * A1 + bfhi(ds);
    }
}

__device__ __forceinline__ void gla_g3(LAS unsigned char* lds, const Params& p, int j, int G, int bid) {
    const bf16_t* P = (const bf16_t*)(p.ws + OFF_P); const bf16_t* SB = (const bf16_t*)(p.ws + OFF_SB); const float* BB = (const float*)(p.ws + OFF_BB);
    bf16_t* AB = (bf16_t*)(p.ws + OFF_AB); const float* gn = p.in[13] + (size_t)j * 256;
    LAS bf16_t* qt = (LAS bf16_t*)lds;
    LAS bf16_t* kt = (LAS bf16_t*)(lds + 17408);
    LAS bf16_t* sc = (LAS bf16_t*)(lds + 34816);
    LAS bf16_t* vT = (LAS bf16_t*)(lds + 44032);
    LAS float* part = (LAS float*)(lds + 80896);
    LAS bf16_t* rl = (LAS bf16_t*)(lds + 82944);
    int tid_ = threadIdx.x; asm volatile("" : "+v"(tid_)); const int tid = tid_, wid = tid >> 6, lane = tid & 63, fr = lane & 15, fq = lane >> 4;
    const int kd = tid & 127, q4 = tid >> 7, vdv = tid & 255, hv = tid >> 8;
    for (int slot = bid; slot < NSLOT; slot += G) {
        int row0, len, h; gla_item(slot, row0, len, h);
        const bf16_t* Pr = P + (size_t)row0 * GLA_NP;
        {
            float btv[16]; unsigned short qr[16], kr[16];
#pragma unroll
            for (int i = 0; i < 16; ++i) {
                const unsigned t = 16u * q4 + i, tc = t < (unsigned)len ? t : 0u; const unsigned po = tc * (unsigned)GLA_NP + h * 128 + kd;
                btv[i] = BB[(size_t)row0 * 512 + tc * 512u + h * 128 + kd]; qr[i] = Pr[po]; kr[i] = Pr[po + 512u];
            }
            __builtin_amdgcn_sched_barrier(0);
#pragma unroll
            for (int i = 0; i < 16; ++i) {
                const unsigned t = 16u * q4 + i; const bool ok = t < (unsigned)len;
                const float qv = bf2f(qr[i]) * 0.08838834764831845f * __expf(btv[i]), kv = bf2f(kr[i]) * __expf(-btv[i]);
                qt[t * 136 + kd] = f2bf(ok ? qv : 0.f); kt[t * 136 + kd] = f2bf(ok ? kv : 0.f);
            }
        }
        {
            const bf16_t* vb = Pr + 1024 + h * 256;
#pragma nounroll
            for (int bt = 0; bt < 2; ++bt) {
                const unsigned tb = 32u * hv + 16u * bt; unsigned vr[8];
#pragma unroll
                for (int i = 0; i < 8; ++i) {
                    const unsigned ta = tb + 2u * i, ca = ta < (unsigned)len ? ta : 0u, cb = ta + 1u < (unsigned)len ? ta + 1u : 0u;
                    const bf16_t* pa = vb + ca * (unsigned)GLA_NP + vdv; const bf16_t* pb = vb + cb * (unsigned)GLA_NP + vdv;
                    const unsigned lo = pa[0], hi = pb[0];
                    rl[ta * 264 + vdv] = pa[1024]; rl[(ta + 1u) * 264 + vdv] = pb[1024];
                    vr[i] = (ta < (unsigned)len ? lo : 0u) | ((ta + 1u < (unsigned)len ? hi : 0u) << 16);
                }
                u32x4 w0, w1; w0.x = vr[0]; w0.y = vr[1]; w0.z = vr[2]; w0.w = vr[3]; w1.x = vr[4]; w1.y = vr[5]; w1.z = vr[6]; w1.w = vr[7];
                *(LAS u32x4*)(vT + vdv * 72 + tb) = w0; *(LAS u32x4*)(vT + vdv * 72 + tb + 8) = w1;
            }
        }
        __syncthreads();
        const bf16_t* sp = SB + (size_t)slot * 32768 + (size_t)(wid * 32 + fr) * 128 + fq * 8;
        bf16x8 spf[2][4];
#pragma unroll
        for (int c = 0; c < 2; ++c)
#pragma unroll
            for (int ks = 0; ks < 4; ++ks) spf[c][ks] = *(const bf16x8*)(sp + c * 2048 + ks * 32);
#pragma unroll
        for (int i = 0; i < 2; ++i) {
            const int ti = wid * 2 + i, rt = ti >> 2, ct = ti & 3;
            f32x4 a4 = (f32x4){0.f, 0.f, 0.f, 0.f};
            if (ct <= rt) {
#pragma unroll
                for (int ks = 0; ks < 4; ++ks) {
                    const bf16x8 a = *(const LAS bf16x8*)(qt + (rt * 16 + fr) * 136 + ks * 32 + fq * 8);
                    const bf16x8 b = *(const LAS bf16x8*)(kt + (ct * 16 + fr) * 136 + ks * 32 + fq * 8);
                    a4 = mfma16(a, b, a4);
                }
            }
#pragma unroll
            for (int jj = 0; jj < 4; ++jj) { const int t = rt * 16 + fq * 4 + jj, s = ct * 16 + fr; sc[t * 72 + s] = f2bf(s <= t ? a4[jj] : 0.f); }
        }
        __syncthreads();
        f32x4 acc[4][2];
#pragma unroll
        for (int r = 0; r < 4; ++r)
#pragma unroll
            for (int c = 0; c < 2; ++c) acc[r][c] = (f32x4){0.f, 0.f, 0.f, 0.f};
#pragma unroll
        for (int ks = 0; ks < 2; ++ks) {
            bf16x8 b[2];
#pragma unroll
            for (int c = 0; c < 2; ++c) b[c] = *(const LAS bf16x8*)(vT + (wid * 32 + c * 16 + fr) * 72 + ks * 32 + fq * 8);
#pragma unroll
            for (int r = 0; r < 4; ++r) {
                const bf16x8 a = *(const LAS bf16x8*)(sc + (r * 16 + fr) * 72 + ks * 32 + fq * 8);
#pragma unroll
                for (int c = 0; c < 2; ++c) acc[r][c] = mfma16(a, b[c], acc[r][c]);
            }
        }
#pragma unroll
        for (int ks = 0; ks < 4; ++ks) {
            bf16x8 b[2];
#pragma unroll
            for (int c = 0; c < 2; ++c) b[c] = spf[c][ks];
#pragma unroll
            for (int r = 0; r < 4; ++r) {
                const bf16x8 a = *(const LAS bf16x8*)(qt + (r * 16 + fr) * 136 + ks * 32 + fq * 8);
#pragma unroll
                for (int c = 0; c < 2; ++c) acc[r][c] = mfma16(a, b[c], acc[r][c]);
            }
        }
#pragma unroll
        for (int r = 0; r < 4; ++r)
#pragma unroll
            for (int jj = 0; jj < 4; ++jj) {
                float ss = acc[r][0][jj] * acc[r][0][jj] + acc[r][1][jj] * acc[r][1][jj];
                ss += __shfl_xor(ss, 1); ss += __shfl_xor(ss, 2); ss += __shfl_xor(ss, 4); ss += __shfl_xor(ss, 8);
                if (fr == 0) part[(r * 16 + fq * 4 + jj) * 8 + wid] = ss;
            }
        __syncthreads();
        const float gn0 = gn[wid * 32 + fr], gn1 = gn[wid * 32 + 16 + fr];
#pragma unroll
        for (int r = 0; r < 4; ++r)
#pragma unroll
            for (int jj = 0; jj < 4; ++jj) {
                const int t = r * 16 + fq * 4 + jj;
                const f32x4 p0 = *(const LAS f32x4*)(part + t * 8), p1 = *(const LAS f32x4*)(part + t * 8 + 4);
                const float tot = ((p0[0] + p0[1]) + (p0[2] + p0[3])) + ((p1[0] + p1[1]) + (p1[2] + p1[3]));
                const float rinv = __builtin_amdgcn_rsqf(tot * (1.0f / 256.0f) + LN_EPS);
                LAS bf16_t* ro = rl + t * 264 + wid * 32 + fr;
                ro[0] = f2bf(acc[r][0][jj] * rinv * gn0 * silu_f(bf2f(ro[0])));
                ro[16] = f2bf(acc[r][1][jj] * rinv * gn1 * silu_f(bf2f(ro[16])));
            }
        __syncthreads();
        for (int idx = tid; idx < len * 32; idx += NTHR) {
            const int t = idx >> 5, c16 = idx & 31;
            *(u32x4*)(AB + (size_t)(row0 + t) * D + h * 256 + c16 * 8) = *(const LAS u32x4*)(rl + t * 264 + c16 * 8);
        }
        __syncthreads();
    }
}

constexpr size_t OFF_VSTAT = OFF_BIG + (size_t)MT * 4096 * 2;
__device__ __forceinline__ void sg_phase(LAS unsigned char* lds, const Params& p, int j, int G, int bid) {
    bf16_t* U = (bf16_t*)(p.ws + OFF_BIG); const bf16_t* V = (const bf16_t*)(p.ws + OFF_BIG + (size_t)MT * 2048 * 2);
    const float* VS = (const float*)(p.ws + OFF_VSTAT);
    const float* lg = p.in[16] + (size_t)j * 2048; const float* lb = p.in[17] + (size_t)j * 2048;
    const float* wsp = p.in[18] + (size_t)j * 8 * 128 * 128; const float* bsp = p.in[19] + (size_t)j * 8 * 128;
    float* sgv = p.out + O_SGV + (size_t)j * 8 * 32 * 2048;
    LAS bf16_t* vnT = (LAS bf16_t*)lds;
    LAS bf16_t* wsA = (LAS bf16_t*)(lds + 69632);
    LAS float* stat = (LAS float*)(lds + 104448);
    LAS float* bsl = (LAS float*)(lds + 105472);
    int tid_ = threadIdx.x; asm volatile("" : "+v"(tid_)); const int tid = tid_, wid = tid >> 6, lane = tid & 63, fr = lane & 15, fq = lane >> 4;
    const int NIT = (128 + 8) * 8;
    for (int it = bid; it < NIT; it += G) {
        const int ci = it >> 3, g = it & 7; const bool samp = ci >= 128;
        const int row0 = samp ? MP + (ci - 128) * 32 : ci * 128, len = samp ? 32 : 128;
        if (tid < len) {
            const float4* sp = (const float4*)(VS + (size_t)(row0 + tid) * 64); float s = 0.f, q = 0.f;
#pragma unroll
            for (int i = 0; i < 16; ++i) { const float4 x = sp[i]; s += x.x + x.z; q += x.y + x.w; }
            const float mean = s * (1.0f / 2048.0f), var = q * (1.0f / 2048.0f) - mean * mean;
            stat[tid * 2] = mean; stat[tid * 2 + 1] = 1.0f / sqrtf(fmaxf(var, 0.f) + LN_EPS);
        }
        if (tid >= 384) bsl[tid - 384] = bsp[g * 128 + tid - 384];
        {
            const int tt = tid >> 2, s0 = (tid & 3) * 32; const float* wrow = wsp + (size_t)g * 16384 + tt * 128 + s0;
            float4 wa[4], wb[4];
#pragma unroll
            for (int i = 0; i < 4; ++i) { wa[i] = *(const float4*)(wrow + 8 * i); wb[i] = *(const float4*)(wrow + 8 * i + 4); }
            __builtin_amdgcn_sched_barrier(0);
#pragma unroll
            for (int i = 0; i < 4; ++i) {
                const float4 a = wa[i], b = wb[i]; const int sb = s0 + 8 * i;
                u32x4 w; w.x = pk2(sb + 0 <= tt ? a.x : 0.f, sb + 1 <= tt ? a.y : 0.f); w.y = pk2(sb + 2 <= tt ? a.z : 0.f, sb + 3 <= tt ? a.w : 0.f);
                w.z = pk2(sb + 4 <= tt ? b.x : 0.f, sb + 5 <= tt ? b.y : 0.f); w.w = pk2(sb + 6 <= tt ? b.z : 0.f, sb + 7 <= tt ? b.w : 0.f);
                *(LAS u32x4*)(wsA + tt * 136 + sb) = w;
            }
        }
        __syncthreads();
        {
            const int d = tid & 255, hh = tid >> 8; const float lgd = lg[g * 256 + d], lbd = lb[g * 256 + d];
            const bf16_t* vb = V + (size_t)row0 * 2048 + g * 256 + d;
#pragma nounroll
            for (int bt = 0; bt < 4; ++bt) {
                const unsigned sb = 64u * hh + 16u * bt; float vn[16];
#pragma unroll
                for (int i = 0; i < 16; ++i) {
                    const unsigned s = sb + i, sc_ = s < (unsigned)len ? s : 0u;
                    const float x = (bf2f(vb[sc_ * 2048u]) - stat[sc_ * 2]) * stat[sc_ * 2 + 1] * lgd + lbd;
                    vn[i] = s < (unsigned)len ? x : 0.f;
                }
                if (samp && sb < (unsigned)len) {
#pragma unroll
                    for (int i = 0; i < 16; ++i) sgv[(size_t)(row0 - MP + sb + i) * 2048 + g * 256 + d] = vn[i];
                }
                u32x4 w0, w1;
                w0.x = pk2(vn[0], vn[1]); w0.y = pk2(vn[2], vn[3]); w0.z = pk2(vn[4], vn[5]); w0.w = pk2(vn[6], vn[7]);
                w1.x = pk2(vn[8], vn[9]); w1.y = pk2(vn[10], vn[11]); w1.z = pk2(vn[12], vn[13]); w1.w = pk2(vn[14], vn[15]);
                *(LAS u32x4*)(vnT + d * 136 + sb) = w0; *(LAS u32x4*)(vnT + d * 136 + sb + 8) = w1;
            }
        }
        __syncthreads();
        f32x4 acc[8][2];
#pragma unroll
        for (int r = 0; r < 8; ++r)
#pragma unroll
            for (int c = 0; c < 2; ++c) acc[r][c] = (f32x4){0.f, 0.f, 0.f, 0.f};
#pragma unroll
        for (int ks = 0; ks < 4; ++ks) {
            bf16x8 b[2];
#pragma unroll
            for (int c = 0; c < 2; ++c) b[c] = *(const LAS bf16x8*)(vnT + (wid * 32 + c * 16 + fr) * 136 + ks * 32 + fq * 8);
#pragma unroll
            for (int r = 0; r < 8; ++r) {
                if (ks * 32 <= r * 16 + 15) {
                    const bf16x8 a = *(const LAS bf16x8*)(wsA + (r * 16 + fr) * 136 + ks * 32 + fq * 8);
#pragma unroll
                    for (int c = 0; c < 2; ++c) acc[r][c] = mfma16(a, b[c], acc[r][c]);
                }
            }
        }
        __syncthreads();
#pragma unroll
        for (int r = 0; r < 8; ++r)
#pragma unroll
            for (int jj = 0; jj < 4; ++jj) {
                const int t = r * 16 + fq * 4 + jj; const float bsv = bsl[t];
                LAS bf16_t* so = vnT + t * 264 + wid * 32 + fr;
                so[0] = f2bf(acc[r][0][jj] + bsv); so[16] = f2bf(acc[r][1][jj] + bsv);
            }
        __syncthreads();
        for (int idx = tid; idx < len * 32; idx += NTHR) {
            const int t = idx >> 5, c16 = idx & 31;
            bf16_t* up = U + (size_t)(row0 + t) * 2048 + g * 256 + c16 * 8;
            const u32x4 uw = *(const u32x4*)up, sw = *(const LAS u32x4*)(vnT + t * 264 + c16 * 8);
            u32x4 w; w.x = pk2(bflo(uw.x) * bflo(sw.x), bfhi(uw.x) * bfhi(sw.x)); w.y = pk2(bflo(uw.y) * bflo(sw.y), bfhi(uw.y) * bfhi(sw.y));
            w.z = pk2(bflo(uw.z) * bflo(sw.z), bfhi(uw.z) * bfhi(sw.z)); w.w = pk2(bflo(uw.w) * bflo(sw.w), bfhi(uw.w) * bfhi(sw.w));
            *(u32x4*)up = w;
        }
        __syncthreads();
    }
}

template <int K> __device__ __forceinline__ void skinny_out(LAS unsigned char* lds, const bf16_t* __restrict__ A, const bf16_t* __restrict__ Bt, float* X, bf16_t* XB, float alpha, float scale, bool yf32, int G, int bid) {
    int tid_ = threadIdx.x; asm volatile("" : "+v"(tid_)); const int tid = tid_, wid = tid >> 6, lane = tid & 63, fr = lane & 15, fq = lane >> 4;
    LAS float* part = (LAS float*)lds;
    constexpr int KW = K / 8;
    for (int it = bid; it < 256; it += G) {
        const int rf = it >> 4, cc = it & 15;
        const bf16_t* ap = A + (size_t)(MP + rf * 16 + fr) * K + wid * KW + fq * 8;
        const bf16_t* bp = Bt + (size_t)(cc * 64 + fr) * K + wid * KW + fq * 8;
        f32x4 acc[4];
#pragma unroll
        for (int c = 0; c < 4; ++c) acc[c] = (f32x4){0.f, 0.f, 0.f, 0.f};
        {
            constexpr int NB = (KW + 127) / 128;
            bf16x8 a[2][4], bq[2][4][4];
#define SK_LOAD(set, k0) _Pragma("unroll") for (int s = 0; s < 4; ++s) if ((k0) + s * 32 < KW) { a[set][s] = *(const bf16x8*)(ap + (k0) + s * 32); \
                _Pragma("unroll") for (int c = 0; c < 4; ++c) bq[set][s][c] = *(const bf16x8*)(bp + (size_t)c * 16 * K + (k0) + s * 32); }
#define SK_MMA(set, k0) _Pragma("unroll") for (int s = 0; s < 4; ++s) if ((k0) + s * 32 < KW) { _Pragma("unroll") for (int c = 0; c < 4; ++c) acc[c] = mfma16(a[set][s], bq[set][s][c], acc[c]); }
            SK_LOAD(0, 0)
#pragma unroll
            for (int ib = 0; ib < NB; ++ib) {
                if (ib + 1 < NB) { SK_LOAD((ib + 1) & 1, (ib + 1) * 128) }
                __builtin_amdgcn_sched_barrier(0);
                SK_MMA(ib & 1, ib * 128)
                __builtin_amdgcn_sched_barrier(0);
            }
#undef SK_LOAD
#undef SK_MMA
        }
#pragma unroll
        for (int c = 0; c < 4; ++c)
#pragma unroll
            for (int jj = 0; jj < 4; ++jj) part[(wid * 16 + fq * 4 + jj) * 64 + c * 16 + fr] = acc[c][jj];
        __syncthreads();
        for (int e = tid; e < 1024; e += NTHR) {
            const int r = e >> 6, c = e & 63; float s = 0.f;
#pragma unroll
            for (int w = 0; w < 8; ++w) s += part[(w * 16 + r) * 64 + c];
            const size_t xo = (size_t)(MP + rf * 16 + r) * D + cc * 64 + c;
            const float yv = alpha * bf2f(XB[xo]) + scale * s;
            if (yf32) X[xo] = yv; else XB[xo] = f2bf(yv);
        }
        __syncthreads();
    }
}

#ifndef PROBE_CLASS
#define PROBE_CLASS 0
#endif
#define PB(c) { if (PROBE_CLASS && ((PROBE_MASK >> (c)) & 1)) t0_ = wall_clock64(); }
#define PE(c) { if (PROBE_CLASS && ((PROBE_MASK >> (c)) & 1)) t_acc += wall_clock64() - t0_; }
#ifndef PROBE_MASK
#define PROBE_MASK 0
#endif
#define XB_TMO      128
#define XB_XCNT(j)  (256  + 64 * (j))
#define XB_XSUB(j)  (1280 + 64 * (j))
#define XB_XGEN(j)  (2304 + 64 * (j))
#define XB_TOP      3328
#define XB_TOPGEN   3392
#define XCD_BAR_WORDS 3456
#define XB_SPIN_CAP (1u << 18)

__device__ __forceinline__ unsigned xb_ld(unsigned* p)              { return __hip_atomic_load(p, __ATOMIC_RELAXED, __HIP_MEMORY_SCOPE_AGENT); }
__device__ __forceinline__ unsigned xb_add(unsigned* p, unsigned v) { return __hip_atomic_fetch_add(p, v, __ATOMIC_RELAXED, __HIP_MEMORY_SCOPE_AGENT); }
__device__ __forceinline__ unsigned xb_xcc_id() { return (unsigned)__builtin_amdgcn_s_getreg((3 << 11) | 20) & 0xFu; }
#define XB_SPIN(cond, bar) do { unsigned _sp = 0; while (cond) { __builtin_amdgcn_s_sleep(1); \
    if ((++_sp & 255u) == 0u) { if (xb_ld(&(bar)[XB_TMO])) break; if (_sp > XB_SPIN_CAP) { atomicAdd(&(bar)[XB_TMO], 1u); break; } } } } while (0)

struct XcdBarrier {
    unsigned* bar; unsigned x;
    volatile LAS unsigned* st;
};

__device__ __forceinline__ XcdBarrier xcd_barrier_post(unsigned* bar, volatile LAS unsigned* st) {
    XcdBarrier b; b.bar = bar; b.x = xb_xcc_id(); b.st = st;
    if (threadIdx.x == 0) (void)xb_add(&bar[XB_XCNT(b.x)], 1u);
    return b;
}
__device__ __forceinline__ void xcd_barrier_complete(unsigned* bar, unsigned x, unsigned& nloc, unsigned& nx) {
    const unsigned G = gridDim.x * gridDim.y * gridDim.z;
    unsigned sum, cnt, mine, sp = 0u;
    for (;;) {
        sum = 0u; cnt = 0u; mine = 0u;
#pragma unroll
        for (unsigned j = 0; j < 16; ++j) { const unsigned c = xb_ld(&bar[XB_XCNT(j)]); sum += c; cnt += (c > 0u) ? 1u : 0u; mine = (j == x) ? c : mine; }
        if (sum == G) break;
        __builtin_amdgcn_s_sleep(1);
        if ((++sp & 255u) == 0u) { if (xb_ld(&bar[XB_TMO])) break; if (sp > XB_SPIN_CAP) { atomicAdd(&bar[XB_TMO], 1u); break; } }
    }
    nloc = mine > 0u ? mine : 1u; nx = cnt > 0u ? cnt : 1u;
}

__device__ __forceinline__ void xcd_barrier(const XcdBarrier& b) {
    asm volatile("s_waitcnt vmcnt(0)" ::: "memory");
    __syncthreads();
    if (threadIdx.x == 0) {
        unsigned* bar = b.bar;
        __builtin_amdgcn_s_waitcnt(0);
        unsigned nloc = b.st[0], nx = b.st[1];
        if (nloc == 0u) { xcd_barrier_complete(bar, b.x, nloc, nx); b.st[0] = nloc; b.st[1] = nx; }
        const unsigned old = xb_add(&bar[XB_XSUB(b.x)], 1u);
        const unsigned gen = old / nloc;
        if (old + 1u == (gen + 1u) * nloc) {
            __builtin_amdgcn_fence(__ATOMIC_RELEASE, "agent");
            asm volatile("s_waitcnt vmcnt(0)" ::: "memory");
            const unsigned og = xb_add(&bar[XB_TOP], 1u);
            const unsigned tg = og / nx;
            if (og + 1u == (tg + 1u) * nx) xb_add(&bar[XB_TOPGEN], 1u);
            else XB_SPIN(xb_ld(&bar[XB_TOPGEN]) == tg, bar);
            __builtin_amdgcn_fence(__ATOMIC_ACQUIRE, "agent");
            xb_add(&bar[XB_XGEN(b.x)], 1u);
            asm volatile("s_waitcnt vmcnt(0)" ::: "memory");
        } else {
            XB_SPIN(xb_ld(&bar[XB_XGEN(b.x)]) == gen, bar);
            __builtin_amdgcn_fence(__ATOMIC_ACQUIRE, "agent");
            asm volatile("s_waitcnt vmcnt(0)" ::: "memory");
        }
    }
    __syncthreads();
}


#define XSYNC() { if (PROBE_CLASS && ((PROBE_MASK >> 11) & 1)) { t0_ = wall_clock64(); grid.sync(); t_acc += wall_clock64() - t0_; } }
__global__ void __launch_bounds__(NTHR, 2) mega(Params p) {
    extern __shared__ __attribute__((aligned(16))) unsigned char lds_raw[];
    LAS unsigned char* lds = (LAS unsigned char*)lds_raw;
    cg::grid_group grid = cg::this_grid();
    const int G = gridDim.x, bid = blockIdx.x;
    float* X = p.out + O_Y; bf16_t* XB = (bf16_t*)(p.ws + OFF_XB); bf16_t* WT = (bf16_t*)(p.ws + OFF_WT);
    bf16_t* BIG = (bf16_t*)(p.ws + OFF_BIG);

    unsigned long long t_acc = 0, t0_ = 0;
    volatile LAS unsigned* xb_st = (volatile LAS unsigned*)(lds + 135 * 1024);
    if (threadIdx.x < 4) xb_st[threadIdx.x] = 0u;
    __syncthreads();
    const XcdBarrier xbar = xcd_barrier_post((unsigned*)(p.ws + OFF_CTR), xb_st);
#define GB() { xcd_barrier(xbar); if (PROBE_CLASS && ((PROBE_MASK >> 11) & 1)) { t0_ = wall_clock64(); xcd_barrier(xbar); t_acc += wall_clock64() - t0_; } }
    PB(9);
    init_phase(p, G, bid);
    convert_layer(lds, p, 0, G, bid);
    if (p.ws == nullptr) grid.sync();
    GB();
    PE(9);

    for (int l = 0; l < 4; ++l) {
        const int mixer = l % 3, j = l / 3;
        for (int sub = 0; sub < 3; ++sub) {
            const bf16_t* Aout; const bf16_t* Wout; int Kout; float scale;
            if (sub != 1) {
                PB(1);
                pg8::Gemm g{XB, WT + (sub == 0 ? W_1IN : W_2IN), MT, 2 * DFF, D}; pg8::StaticOrder S; S.init(MT, 2 * DFF, G, bid);
                EpiPair<1> E{BIG, DFF};
                pg8::gemm_phase<EpiPair<1>, pg8::StaticOrder>(lds, g, S, E, nullptr);
                Aout = BIG; Wout = WT + (sub == 0 ? W_1OUT : W_2OUT); Kout = DFF; scale = 0.5f;
                GB();
                PE(1);
            } else if (mixer == 0) {
                PB(1);
                { pg8::Gemm g{XB, WT + W_MIN, MT, GLA_NP, D}; pg8::StaticOrder S; S.init(MT, GLA_NP, G, bid);
                  EpiBf<0> E{(bf16_t*)(p.ws + OFF_P), GLA_NP, 0, 0};
                  pg8::gemm_phase<EpiBf<0>, pg8::StaticOrder>(lds, g, S, E, nullptr); }
                GB();
                PE(1);
                PB(4);
                gla_g1(lds, p, j, G, bid);
                GB();
                PE(4);
                PB(5);
                gla_g2(p, j, G, bid);
                GB();
                PE(5);
                PB(6);
                gla_g3(lds, p, j, G, bid);
                GB();
                PE(6);
                Aout = (const bf16_t*)(p.ws + OFF_AB); Wout = WT + W_MOUT; Kout = D; scale = 1.0f;
            } else if (mixer == 1) {
                PB(1);
                { pg8::Gemm g{XB, WT + W_MIN, MT, 4096, D}; pg8::StaticOrder S; S.init(MT, 4096, G, bid);
                  EpiBf<1> E{BIG, 2048, 2048, (size_t)MT * 2048, (float*)(p.ws + OFF_VSTAT)};
                  pg8::gemm_phase<EpiBf<1>, pg8::StaticOrder>(lds, g, S, E, nullptr); }
                GB();
                PE(1);
                PB(7);
                sg_phase(lds, p, j, G, bid);
                GB();
                PE(7);
                Aout = BIG; Wout = WT + W_MOUT; Kout = 2048; scale = 1.0f;
            } else {
                PB(1);
                { pg8::Gemm g{XB, WT + W_MIN, MT, 3072, D}; pg8::StaticOrder S; S.init(MT, 3072, G, bid);
                  EpiConv E{BIG, BIG + (size_t)MT * D};
                  pg8::gemm_phase<EpiConv, pg8::StaticOrder>(lds, g, S, E, nullptr); }
                GB();
                PE(1);
                PB(8);
                conv_phase(p, j, G, bid);
                GB();
                PE(8);
                Aout = BIG + (size_t)MT * D; Wout = WT + W_MOUT; Kout = D; scale = 1.0f;
            }
            if (sub != 1) PB(2) else PB(10)
            { pg8::Gemm g{Aout, Wout, MP, D, Kout}; pg8::StaticOrder S; S.init(MP, D, G, bid);
              EpiRes E{X, XB, ALPHA, scale, sub == 2 && l == 3};
              if (sub != 1) PB(12)
              pg8::gemm_phase<EpiRes, pg8::StaticOrder>(lds, g, S, E, nullptr);
              if (sub != 1) PE(12) }
            if (sub != 1) PB(13)
            if (Kout == DFF) skinny_out<DFF>(lds, Aout, Wout, X, XB, ALPHA, scale, sub == 2 && l == 3, G, bid);
            else if (Kout == 2048) skinny_out<2048>(lds, Aout, Wout, X, XB, ALPHA, scale, sub == 2 && l == 3, G, bid);
            else skinny_out<1024>(lds, Aout, Wout, X, XB, ALPHA, scale, sub == 2 && l == 3, G, bid);
            if (sub != 1) PE(13)
            GB();
            if (sub != 1) PE(2) else PE(10)
            PB(3);
            ln_phase(X, XB, p.in[4] + (size_t)(l * 3 + sub) * D, p.in[5] + (size_t)(l * 3 + sub) * D, G, bid, sub == 2 && l == 3);
            if (sub == 2 && l < 3) convert_layer(lds, p, l + 1, G, bid);
            if (!(sub == 2 && l == 3)) GB();
            PE(3);
        }
    }
    if (PROBE_CLASS) { __syncthreads(); if (bid == 0 && threadIdx.x == 0) X[0] += (float)t_acc * (0.01f / 256.0f); }
}

extern "C" void kernel_launch(void* const* d_in, const int* in_sizes, int n_in, void* d_out, int out_size, void* d_ws, size_t ws_size, hipStream_t stream) {
    static int grid_blocks = 0;
    if (grid_blocks == 0) {
        if (n_in != 24 || ws_size < WS_END) { fprintf(stderr, "kernel_launch: unexpected n_in %d or ws_size %zu (< %zu)\n", n_in, ws_size, (size_t)WS_END); grid_blocks = -1; return; }
        int dev = 0, cus = 0, per_cu = 0;
        hipGetDevice(&dev);
        hipDeviceGetAttribute(&cus, hipDeviceAttributeMultiprocessorCount, dev);
        if (hipFuncSetAttribute((const void*)mega, hipFuncAttributeMaxDynamicSharedMemorySize, LDS_BYTES) != hipSuccess) { fprintf(stderr, "kernel_launch: hipFuncSetAttribute failed\n"); grid_blocks = -1; return; }
        if (hipOccupancyMaxActiveBlocksPerMultiprocessor(&per_cu, (const void*)mega, NTHR, LDS_BYTES) != hipSuccess || per_cu < 1) { fprintf(stderr, "kernel_launch: occupancy query says %d\n", per_cu); per_cu = 1; }
        (void)hipGetLastError();
        grid_blocks = cus * 1;
    }
    if (grid_blocks < 0) return;
    Params p{};
    for (int i = 0; i < 24; ++i) p.in[i] = (const float*)d_in[i];
    p.out = (float*)d_out; p.ws = (unsigned char*)d_ws;
    if (hipMemsetAsync((char*)d_ws + OFF_CTR, 0, 16384, stream) != hipSuccess) { fprintf(stderr, "kernel_launch: memset of the barrier counter failed\n"); return; }
    void* args[] = {&p};
    hipError_t e = hipLaunchCooperativeKernel((const void*)mega, dim3(grid_blocks), dim3(NTHR), args, LDS_BYTES, stream);
    if (e != hipSuccess) fprintf(stderr, "cooperative launch failed: %s (grid %d)\n", hipGetErrorString(e), grid_blocks);
}
```
